# Optimizing an MI355X kernel written in HIP

```python
import jax
import jax.numpy as jnp
from jax import lax
import numpy as np

D_MODEL = 1024
BATCH = 8
SEQ = 2048
DEPTH = 2

MEM_LEN = 256
EPS = 1e-6
CONV_W = 4
D_RNN = D_MODEL
RNN_BLOCKS = 16
RNN_BLOCK = D_RNN // RNN_BLOCKS
LRU_C = 8.0
ML_HEADS = 4
ML_DHEAD = D_MODEL // ML_HEADS
D_ML = ML_HEADS * ML_DHEAD
ML_CHUNK = 128
XA_HEADS = 4
XA_DHEAD = D_MODEL // XA_HEADS
D_FF = 3 * D_MODEL
FFN_CONV_W = 3
IN_SPLIT_SIZES = (D_RNN, D_RNN, 2 * D_ML, D_ML, D_ML, 2 * ML_HEADS, D_MODEL, D_MODEL)
D_IN = 2 * D_RNN + 4 * D_ML + 2 * ML_HEADS + 2 * D_MODEL

kernel_name = 'hybrid_rglru_mlstm_xattn_convffn'


def rms_norm(x, g):
    xf = x.astype(jnp.float32)
    y = xf * lax.rsqrt(jnp.mean(xf * xf, axis=-1, keepdims=True) + EPS)
    return (y * g.astype(jnp.float32)).astype(x.dtype)


def causal_dwconv(x, w, b):
    k_w, s = w.shape[0], x.shape[1]
    xp = jnp.pad(x, ((0, 0), (k_w - 1, 0), (0, 0)))
    out = xp[:, 0:s] * w[0] + b
    for j in range(1, k_w):
        out = out + xp[:, j:j + s] * w[j]
    return out


def rg_lru(x, w_a, b_a, w_x, b_x, lam):
    bsz, s, _ = x.shape
    xb = x.reshape(bsz, s, RNN_BLOCKS, RNN_BLOCK)
    r = jax.nn.sigmoid(jnp.einsum('bsgi,gij->bsgj', xb, w_a) + b_a.reshape(RNN_BLOCKS, RNN_BLOCK))
    i = jax.nn.sigmoid(jnp.einsum('bsgi,gij->bsgj', xb, w_x) + b_x.reshape(RNN_BLOCKS, RNN_BLOCK))
    r = r.reshape(bsz, s, D_RNN).astype(jnp.float32)
    i = i.reshape(bsz, s, D_RNN).astype(jnp.float32)
    log_a = -LRU_C * r * jax.nn.softplus(-lam.astype(jnp.float32))
    a = jnp.exp(log_a)
    u = jnp.sqrt(-jnp.expm1(2.0 * log_a)) * (i * x.astype(jnp.float32))

    def combine(left, right):
        a1, b1 = left
        a2, b2 = right
        return a1 * a2, a2 * b1 + b2

    _, h = lax.associative_scan(combine, (a, u), axis=1)
    return h.astype(x.dtype)


def _to_chunks(t, n_chunks):
    bsz, s, h = t.shape[:3]
    t = t.reshape(bsz, n_chunks, s // n_chunks, h, *t.shape[3:])
    return jnp.moveaxis(t, (1, 3), (0, 2))


def mlstm(q, k, v, i_pre, f_pre):
    bsz, s, nh, dh = q.shape
    n_chunks = s // ML_CHUNK
    f32 = jnp.float32
    q = q.astype(f32)
    k = k.astype(f32) * (dh ** -0.5)
    v = v.astype(f32)
    log_i = i_pre.astype(f32)
    log_f = jax.nn.log_sigmoid(f_pre.astype(f32))
    xs = (_to_chunks(q, n_chunks), _to_chunks(k, n_chunks), _to_chunks(v, n_chunks),
          _to_chunks(log_i, n_chunks), _to_chunks(log_f, n_chunks))
    causal = jnp.tril(jnp.ones((ML_CHUNK, ML_CHUNK), dtype=bool))

    def step(carry, inp):
        c_st, n_st, m_st = carry
        qc, kc, vc, li, lf = inp
        b = jnp.cumsum(lf, axis=-1)
        a_inter = b + m_st[..., None]
        d = b[..., :, None] - b[..., None, :] + li[..., None, :]
        d = jnp.where(causal, d, -jnp.inf)
        m_t = jnp.maximum(a_inter, jnp.max(d, axis=-1))
        w_inter = jnp.exp(a_inter - m_t)
        sc = jnp.einsum('bhtd,bhsd->bhts', qc, kc) * jnp.exp(d - m_t[..., None])
        num = (w_inter[..., None] * jnp.einsum('bhtd,bhde->bhte', qc, c_st)
               + jnp.einsum('bhts,bhse->bhte', sc, vc))
        den = w_inter * jnp.einsum('bhtd,bhd->bht', qc, n_st) + jnp.sum(sc, axis=-1)
        h = num / jnp.maximum(jnp.abs(den), jnp.exp(-m_t))[..., None]
        g = b[..., -1]
        u = g[..., None] - b + li
        m_next = jnp.maximum(g + m_st, jnp.max(u, axis=-1))
        decay = jnp.exp(g + m_st - m_next)
        wk = kc * jnp.exp(u - m_next[..., None])[..., None]
        c_next = decay[..., None, None] * c_st + jnp.einsum('bhsd,bhse->bhde', wk, vc)
        n_next = decay[..., None] * n_st + jnp.sum(wk, axis=2)
        return (c_next, n_next, m_next), h

    init = (jnp.zeros((bsz, nh, dh, dh), f32), jnp.zeros((bsz, nh, dh), f32),
            jnp.zeros((bsz, nh), f32))
    _, hs = lax.scan(step, init, xs)
    hs = jnp.moveaxis(hs, (0, 2), (1, 3))
    return hs.reshape(bsz, s, nh * dh)


def head_norm(h, g, n_heads):
    bsz, s, w = h.shape
    hh = h.reshape(bsz, s, n_heads, w // n_heads)
    mu = jnp.mean(hh, axis=-1, keepdims=True)
    var = jnp.mean(jnp.square(hh - mu), axis=-1, keepdims=True)
    hh = (hh - mu) * lax.rsqrt(var + EPS)
    return hh.reshape(bsz, s, w) * g.astype(jnp.float32)


def hybrid_mixer(xn, w_in, rnn_conv_w, rnn_conv_b, lru_wa, lru_ba, lru_wx, lru_bx, lru_lambda,
                 ml_conv_w, ml_conv_b, ml_if_b, ml_norm_g, w_branch_a, w_branch_b, w_mix_out):
    bsz, s, _ = xn.shape
    proj = xn @ w_in
    idx = np.cumsum(IN_SPLIT_SIZES)[:-1].tolist()
    xr, gr, qk, v, o, ifg, ga, gb = jnp.split(proj, idx, axis=-1)
    xr = causal_dwconv(xr, rnn_conv_w, rnn_conv_b)
    ya = jax.nn.gelu(gr) * rg_lru(xr, lru_wa, lru_ba, lru_wx, lru_bx, lru_lambda)
    qk = jax.nn.silu(causal_dwconv(qk, ml_conv_w, ml_conv_b))
    q, k = jnp.split(qk, 2, axis=-1)
    ifg = ifg + ml_if_b
    i_pre, f_pre = jnp.split(ifg, 2, axis=-1)
    shp = (bsz, s, ML_HEADS, ML_DHEAD)
    hm = mlstm(q.reshape(shp), k.reshape(shp), v.reshape(shp), i_pre, f_pre)
    yb = (jax.nn.sigmoid(o.astype(jnp.float32)) * head_norm(hm, ml_norm_g, ML_HEADS)).astype(xn.dtype)
    y = jax.nn.sigmoid(ga) * (ya @ w_branch_a) + jax.nn.sigmoid(gb) * (yb @ w_branch_b)
    return y @ w_mix_out


def cross_attention(xn, memn, w_q, w_kv, w_o):
    bsz, s, _ = xn.shape
    m = memn.shape[1]
    q = (xn @ w_q).reshape(bsz, s, XA_HEADS, XA_DHEAD)
    k, v = jnp.split(memn @ w_kv, 2, axis=-1)
    k = k.reshape(bsz, m, XA_HEADS, XA_DHEAD)
    v = v.reshape(bsz, m, XA_HEADS, XA_DHEAD)
    sc = jnp.einsum('bshd,bmhd->bhsm', q, k).astype(jnp.float32) * (XA_DHEAD ** -0.5)
    p = jax.nn.softmax(sc, axis=-1).astype(v.dtype)
    out = jnp.einsum('bhsm,bmhd->bshd', p, v).reshape(bsz, s, XA_HEADS * XA_DHEAD)
    return out @ w_o


def conv_ffn(xn, w_up, conv_w, conv_b, w_down):
    h = causal_dwconv(xn @ w_up, conv_w, conv_b)
    g, u = jnp.split(h, 2, axis=-1)
    return (jax.nn.gelu(g) * u) @ w_down


def setup_inputs(seed: int = 0) -> dict:
    key = jax.random.key(seed)
    ks = iter(jax.random.split(key, 40))
    f32 = jnp.float32

    def nrm(shape, scale):
        return jax.random.normal(next(ks), shape, f32) * scale

    def gain(shape):
        return 1.0 + nrm(shape, 0.02)

    x = nrm((BATCH, SEQ, D_MODEL), 1.0)
    mem = nrm((BATCH, MEM_LEN, D_MODEL), 1.0)
    norm_mix_g = gain((DEPTH, D_MODEL))
    w_in = nrm((DEPTH, D_MODEL, D_IN), D_MODEL ** -0.5)
    rnn_conv_w = nrm((DEPTH, CONV_W, D_RNN), CONV_W ** -0.5)
    rnn_conv_b = nrm((DEPTH, D_RNN), 0.01)
    lru_wa = nrm((DEPTH, RNN_BLOCKS, RNN_BLOCK, RNN_BLOCK), RNN_BLOCK ** -0.5)
    lru_ba = nrm((DEPTH, D_RNN), 0.01)
    lru_wx = nrm((DEPTH, RNN_BLOCKS, RNN_BLOCK, RNN_BLOCK), RNN_BLOCK ** -0.5)
    lru_bx = nrm((DEPTH, D_RNN), 0.01)
    a_c = jax.random.uniform(next(ks), (DEPTH, D_RNN), f32, 0.9, 0.999)
    a0 = a_c ** (1.0 / LRU_C)
    lru_lambda = jnp.log(a0) - jnp.log1p(-a0)
    ml_conv_w = nrm((DEPTH, CONV_W, 2 * D_ML), CONV_W ** -0.5)
    ml_conv_b = nrm((DEPTH, 2 * D_ML), 0.01)
    i_bias = nrm((DEPTH, ML_HEADS), 0.1)
    f_bias = jnp.linspace(3.0, 6.0, ML_HEADS, dtype=f32)[None, :] + nrm((DEPTH, ML_HEADS), 0.1)
    ml_if_b = jnp.concatenate([i_bias, f_bias], axis=-1)
    ml_norm_g = gain((DEPTH, D_ML))
    w_branch_a = nrm((DEPTH, D_RNN, D_MODEL), D_RNN ** -0.5)
    w_branch_b = nrm((DEPTH, D_ML, D_MODEL), D_ML ** -0.5)
    w_mix_out = nrm((DEPTH, D_MODEL, D_MODEL), D_MODEL ** -0.5)
    norm_xa_g = gain((DEPTH, D_MODEL))
    xa_wq = nrm((DEPTH, D_MODEL, XA_HEADS * XA_DHEAD), D_MODEL ** -0.5)
    xa_wkv = nrm((DEPTH, D_MODEL, 2 * XA_HEADS * XA_DHEAD), D_MODEL ** -0.5)
    xa_wo = nrm((DEPTH, XA_HEADS * XA_DHEAD, D_MODEL), (XA_HEADS * XA_DHEAD) ** -0.5)
    norm_ffn_g = gain((DEPTH, D_MODEL))
    ffn_w_up = nrm((DEPTH, D_MODEL, 2 * D_FF), D_MODEL ** -0.5)
    ffn_conv_w = nrm((DEPTH, FFN_CONV_W, 2 * D_FF), FFN_CONV_W ** -0.5)
    ffn_conv_b = nrm((DEPTH, 2 * D_FF), 0.01)
    ffn_w_down = nrm((DEPTH, D_FF, D_MODEL), D_FF ** -0.5)
    mem_norm_g = gain((D_MODEL,))
    final_norm_g = gain((D_MODEL,))
    return {'x': x, 'mem': mem, 'norm_mix_g': norm_mix_g, 'w_in': w_in,
            'rnn_conv_w': rnn_conv_w, 'rnn_conv_b': rnn_conv_b,
            'lru_wa': lru_wa, 'lru_ba': lru_ba, 'lru_wx': lru_wx, 'lru_bx': lru_bx,
            'lru_lambda': lru_lambda, 'ml_conv_w': ml_conv_w, 'ml_conv_b': ml_conv_b,
            'ml_if_b': ml_if_b, 'ml_norm_g': ml_norm_g, 'w_branch_a': w_branch_a,
            'w_branch_b': w_branch_b, 'w_mix_out': w_mix_out, 'norm_xa_g': norm_xa_g,
            'xa_wq': xa_wq, 'xa_wkv': xa_wkv, 'xa_wo': xa_wo, 'norm_ffn_g': norm_ffn_g,
            'ffn_w_up': ffn_w_up, 'ffn_conv_w': ffn_conv_w, 'ffn_conv_b': ffn_conv_b,
            'ffn_w_down': ffn_w_down, 'mem_norm_g': mem_norm_g, 'final_norm_g': final_norm_g}


def reference(x, mem, norm_mix_g, w_in, rnn_conv_w, rnn_conv_b, lru_wa, lru_ba, lru_wx, lru_bx,
              lru_lambda, ml_conv_w, ml_conv_b, ml_if_b, ml_norm_g, w_branch_a, w_branch_b,
              w_mix_out, norm_xa_g, xa_wq, xa_wkv, xa_wo, norm_ffn_g, ffn_w_up, ffn_conv_w,
              ffn_conv_b, ffn_w_down, mem_norm_g, final_norm_g):
    memn = rms_norm(mem, mem_norm_g)
    h = x
    for l in range(DEPTH):
        h = h + hybrid_mixer(rms_norm(h, norm_mix_g[l]), w_in[l], rnn_conv_w[l], rnn_conv_b[l],
                             lru_wa[l], lru_ba[l], lru_wx[l], lru_bx[l], lru_lambda[l],
                             ml_conv_w[l], ml_conv_b[l], ml_if_b[l], ml_norm_g[l],
                             w_branch_a[l], w_branch_b[l], w_mix_out[l])
        h = h + cross_attention(rms_norm(h, norm_xa_g[l]), memn, xa_wq[l], xa_wkv[l], xa_wo[l])
        h = h + conv_ffn(rms_norm(h, norm_ffn_g[l]), ffn_w_up[l], ffn_conv_w[l], ffn_conv_b[l],
                         ffn_w_down[l])
    return rms_norm(h, final_norm_g)
```

```cpp
#include <hip/hip_runtime.h>
#include <hip/hip_cooperative_groups.h>
#include <cstdio>
namespace cg = cooperative_groups;
namespace pg8 {
#define PG8_LAS __attribute__((address_space(3)))
typedef unsigned short bf16_t;
typedef short bf16x8 __attribute__((ext_vector_type(8)));
typedef float f32x4 __attribute__((ext_vector_type(4)));
typedef unsigned u32x4 __attribute__((ext_vector_type(4)));
constexpr int BM = 256, BK = 64, HALF = 128, HTB = HALF * BK * 2  , STAGE_BYTES = 8 * HTB, NXCD = 8, WGM = 8;

__host__ __device__ __forceinline__ int lds_byte(int r, int c) { const int st = (r >> 4) * 2 + (c >> 5), rr = r & 15, cc = c & 31, ob = rr * 64 + cc * 2; return st * 1024 + (ob ^ (((ob >> 9) & 1) << 5)); }
__host__ __device__ __forceinline__ void stage_rc(int b, int& R, int& C) { const int st = b / 1024, sb = b % 1024, swz = sb ^ (((sb >> 9) & 1) << 5); R = (st >> 1) * 16 + swz / 64; C = (st & 1) * 32 + (swz % 64) / 2; }
__host__ __device__ __forceinline__ int perm32(int rho) { const int n = rho >> 4, i = rho & 15; return 8 * (i >> 2) + 4 * n + (i & 3); }

struct Unit { int pm, pn; };
struct Gemm { const bf16_t* A; const bf16_t* Bt; int M, N, K; };

struct StaticOrder {
    int nM, nN, nwg, G, c;
    __host__ __device__ void init(int M, int N, int G_, int c_) { nM = M / BM; nN = N / BM; nwg = nM * nN; G = G_; c = c_; }
    __host__ __device__ bool next(int i, Unit& u) const {
        const long L = (long)i * G + c; if (L >= nwg) return false;
        int wgid = (int)L; { const int q = nwg / NXCD, r = nwg % NXCD, xcd = wgid % NXCD, off = wgid / NXCD; wgid = (xcd < r ? xcd * (q + 1) : r * (q + 1) + (xcd - r) * q) + off; }
        const int nig = WGM * nN, gid = wgid / nig, fm = gid * WGM, gsz = (nM - fm) < WGM ? (nM - fm) : WGM;
        u.pm = fm + ((wgid % nig) % gsz); u.pn = (wgid % nig) / gsz; return true;
    }
    __device__ __forceinline__ void a_ready(const Unit&) const {}
    __device__ __forceinline__ void done(const Unit&) const {}
};
__device__ __forceinline__ unsigned cvt_pk_bf16(float lo, float hi) { unsigned r; asm volatile("v_cvt_pk_bf16_f32 %0, %1, %2" : "=v"(r) : "v"(lo), "v"(hi)); return r; }
typedef float f32x2 __attribute__((ext_vector_type(2)));
template <class Epi, class Sched, bool STAMP = false>
__device__ __forceinline__ void gemm_phase(int mk_tid, PG8_LAS unsigned char* lds, const Gemm g, const Sched& S, const Epi& E, unsigned long long* stamps) {
    const int tid = mk_tid, wid = __builtin_amdgcn_readfirstlane(tid >> 6), lane = tid & 63, wr = wid >> 2, wc = wid & 3, fr = lane & 15, fq = lane >> 4;
    const int K = g.K, nt = K / BK;
    int ts_lo = 0, ts_hi = 0, nts = 0; const unsigned long long rt_entry = STAMP ? (unsigned long long)wall_clock64() : 0ull;
#define PG8_STAMP() do { if (STAMP && wid == 0 && nts < 64) { const unsigned long long _c = (unsigned long long)clock64(); \
        ts_lo = (lane == nts) ? (int)(unsigned)_c : ts_lo; ts_hi = (lane == nts) ? (int)(unsigned)(_c >> 32) : ts_hi; ++nts; } } while (0)
    PG8_STAMP();
    unsigned voffA[2], voffB[2];
#pragma unroll
    for (int i = 0; i < 2; ++i) { int R, C; stage_rc(tid * 16 + i * 8192, R, C); const int Rb = E.perm ? ((R & ~31) + perm32(R & 31)) : R;
        voffA[i] = (unsigned)(R * K + C) * 2u; voffB[i] = (unsigned)(Rb * K + C) * 2u; }
    const size_t kstep = (size_t)(BK * 2);
    const size_t hstep = (size_t)HALF * K * 2;
    const size_t tstep = 2 * hstep;
    const unsigned ldsw = (unsigned)wid * 1024u;
    const int aoff = lds_byte(wr * 64 + fr, fq * 8), boff = lds_byte(wc * 32 + fr, fq * 8);
#define PG8_SA(b, h) (((b) * 2 + (h)) * HTB)
#define PG8_SB(b, h) ((4 + (b) * 2 + (h)) * HTB)
#define PG8_STAGE(bufoff, gbase, voff) do { _Pragma("unroll") for (int _i = 0; _i < 2; ++_i) \
        __builtin_amdgcn_global_load_lds((const unsigned*)((const char*)(gbase) + (voff)[_i]), (PG8_LAS unsigned*)(lds + (bufoff) + ldsw + _i * 8192), 16, 0, 0); } while (0)
#define PG8_LDA(dst, b, h) do { _Pragma("unroll") for (int m = 0; m < 4; ++m) _Pragma("unroll") for (int k = 0; k < 2; ++k) dst[m][k] = *(const PG8_LAS bf16x8*)(lds + PG8_SA(b, h) + aoff + m * 2048 + k * 1024); } while (0)
#define PG8_LDB(dst, b, h) do { _Pragma("unroll") for (int n = 0; n < 2; ++n) _Pragma("unroll") for (int k = 0; k < 2; ++k) dst[n][k] = *(const PG8_LAS bf16x8*)(lds + PG8_SB(b, h) + boff + n * 2048 + k * 1024); } while (0)
#define PG8_MMA(ai, bj, At, Bt) do { __builtin_amdgcn_s_setprio(1); _Pragma("unroll") for (int m = 0; m < 4; ++m) _Pragma("unroll") for (int n = 0; n < 2; ++n) _Pragma("unroll") for (int k = 0; k < 2; ++k) \
        acc[ai][bj][m][n] = __builtin_amdgcn_mfma_f32_16x16x32_bf16(Bt[n][k], At[m][k], acc[ai][bj][m][n], 0, 0, 0); __builtin_amdgcn_s_setprio(0); } while (0)
#define PG8_WAIT_V(n) asm volatile("s_waitcnt vmcnt(" #n ")" ::: "memory")
#define PG8_WAIT_L(n) asm volatile("s_waitcnt lgkmcnt(" #n ")" ::: "memory")
#define PG8_BAR __builtin_amdgcn_s_barrier()
#define PG8_SCHED __builtin_amdgcn_sched_barrier(0)
    Unit cur, nxt; int ui = 0;
    if (!S.next(0, cur)) return;
    f32x4 acc[2][2][4][2];
#pragma unroll
    for (int a = 0; a < 2; ++a)
#pragma unroll
        for (int b = 0; b < 2; ++b)
#pragma unroll
            for (int m = 0; m < 4; ++m)
#pragma unroll
                for (int n = 0; n < 2; ++n) acc[a][b][m][n] = (f32x4){0.f, 0.f, 0.f, 0.f};
    bf16x8 At[4][2], B0[2][2], B1[2][2];
    const char* cA = (const char*)g.A + (size_t)cur.pm * tstep; const char* cB = (const char*)g.Bt + (size_t)cur.pn * tstep;
    S.a_ready(cur);
    PG8_STAGE(PG8_SB(0, 0), cB, voffB); PG8_STAGE(PG8_SA(0, 0), cA, voffA); PG8_STAGE(PG8_SB(0, 1), cB + hstep, voffB); PG8_STAGE(PG8_SA(0, 1), cA + hstep, voffA);
    if (wr == 1) PG8_BAR;
    PG8_WAIT_V(4); PG8_BAR;
    PG8_STAGE(PG8_SB(1, 0), cB + kstep, voffB); PG8_STAGE(PG8_SA(1, 0), cA + kstep, voffA); PG8_STAGE(PG8_SB(1, 1), cB + hstep + kstep, voffB);
    PG8_WAIT_V(6); PG8_BAR;
    PG8_STAMP();
    for (;;) {
        const bool has_next = S.next(ui + 1, nxt);
        const char* nA = has_next ? (const char*)g.A + (size_t)nxt.pm * tstep : cA; const char* nB = has_next ? (const char*)g.Bt + (size_t)nxt.pn * tstep : cB;
        for (int t = 0; t < nt; t += 2) {
            const bool last = (t == nt - 2);
            const char* a1 = cA + (size_t)(t + 1) * kstep;
            const char* a2 = last ? nA : cA + (size_t)(t + 2) * kstep; const char* b2 = last ? nB : cB + (size_t)(t + 2) * kstep;
            const char* a3 = a2 + kstep; const char* b3 = b2 + kstep;
            if (last && has_next) S.a_ready(nxt);
            PG8_LDB(B0, 0, 0); PG8_SCHED; PG8_LDA(At, 0, 0); PG8_STAGE(PG8_SA(1, 1), a1 + hstep, voffA);
            PG8_WAIT_L(8); PG8_BAR; PG8_WAIT_L(0); PG8_MMA(0, 0, At, B0); PG8_BAR; PG8_SCHED;
            PG8_LDB(B1, 0, 1); PG8_STAGE(PG8_SB(0, 0), b2, voffB);
            PG8_BAR; PG8_WAIT_L(0); PG8_MMA(0, 1, At, B1); PG8_BAR;
            PG8_LDA(At, 0, 1); PG8_STAGE(PG8_SA(0, 0), a2, voffA);
            PG8_BAR; PG8_WAIT_L(0); PG8_MMA(1, 0, At, B0); PG8_BAR; PG8_SCHED;
            PG8_STAGE(PG8_SB(0, 1), b2 + hstep, voffB);
            PG8_WAIT_V(6); PG8_BAR; PG8_MMA(1, 1, At, B1); PG8_BAR;
            PG8_LDB(B0, 1, 0); PG8_SCHED; PG8_LDA(At, 1, 0); PG8_STAGE(PG8_SA(0, 1), a2 + hstep, voffA);
            PG8_WAIT_L(8); PG8_BAR; PG8_WAIT_L(0); PG8_MMA(0, 0, At, B0); PG8_BAR; PG8_SCHED;
            PG8_LDB(B1, 1, 1); PG8_STAGE(PG8_SB(1, 0), b3, voffB);
            PG8_BAR; PG8_WAIT_L(0); PG8_MMA(0, 1, At, B1); PG8_BAR;
            PG8_LDA(At, 1, 1); PG8_STAGE(PG8_SA(1, 0), a3, voffA);
            PG8_BAR; PG8_WAIT_L(0); PG8_MMA(1, 0, At, B0); PG8_BAR; PG8_SCHED;
            PG8_STAGE(PG8_SB(1, 1), b3 + hstep, voffB);
            PG8_WAIT_V(6); PG8_BAR; PG8_MMA(1, 1, At, B1); PG8_BAR;
        }
        PG8_STAMP();
        if constexpr (!Epi::AFTER_DRAIN) { E(acc, cur, wr, wc, fr, fq); S.done(cur); }
        PG8_STAMP();
        if (!has_next) break;
#pragma unroll
        for (int a = 0; a < 2; ++a)
#pragma unroll
            for (int b = 0; b < 2; ++b)
#pragma unroll
                for (int m = 0; m < 4; ++m)
#pragma unroll
                    for (int n = 0; n < 2; ++n) acc[a][b][m][n] = (f32x4){0.f, 0.f, 0.f, 0.f};
        cur = nxt; cA = nA; cB = nB; ++ui;
    }
    PG8_WAIT_V(0);
    if (wr == 0) PG8_BAR;
    PG8_BAR;

    PG8_STAMP();
    if (STAMP && wid == 0) { stamps[lane] = lane < nts ? (((unsigned long long)(unsigned)ts_hi << 32) | (unsigned)ts_lo) : 0ull;
        if (lane == 62) stamps[62] = rt_entry; if (lane == 63) stamps[63] = (unsigned long long)wall_clock64(); }
#undef PG8_STAMP
#undef PG8_SA
#undef PG8_SB
#undef PG8_STAGE
#undef PG8_LDA
#undef PG8_LDB
#undef PG8_MMA
#undef PG8_WAIT_V
#undef PG8_WAIT_L
#undef PG8_BAR
#undef PG8_SCHED
}
}

using namespace pg8;
#define DI __device__ __forceinline__
#define LAS PG8_LAS
typedef unsigned short u16;
typedef unsigned u32x2 __attribute__((ext_vector_type(2)));
typedef short s16x4 __attribute__((ext_vector_type(4)));

constexpr int T = 16384, SEQ = 2048;
constexpr int LDS_BYTES = 147456;
constexpr size_t U = (size_t)T * 1024 * 2;
constexpr size_t WS_WT = 7 * U;
constexpr size_t WS_MEMN = WS_WT + (size_t)11264 * 2048;
constexpr size_t WS_KMEM = WS_MEMN + 4194304;
constexpr size_t WS_VTM = WS_KMEM + 4194304;
constexpr size_t WS_IFG = WS_VTM + 4194304;
constexpr size_t WS_GZ = WS_IFG + (size_t)T * 8 * 4;
constexpr size_t WS_GM = WS_GZ + 262144;
constexpr size_t WS_GE = WS_GM + 262144;
constexpr size_t WS_GMS = WS_GE + 262144;
constexpr size_t WS_GML = WS_GMS + 2048;
constexpr size_t WS_NVEC = WS_GML + 2048;
constexpr size_t WS_END = WS_NVEC + 524288;
constexpr int NPH = 41;

struct Args { const float* in[29]; float* out; unsigned char* ws; int ph_lo, ph_hi; };

DI float bf2f(u16 v) { return __uint_as_float(((unsigned)v) << 16); }
DI float bflo(unsigned v) { return __uint_as_float(v << 16); }
DI float bfhi(unsigned v) { return __uint_as_float(v & 0xffff0000u); }
DI u16 f2bf(float f) { unsigned u = __float_as_uint(f); u += 0x7fffu + ((u >> 16) & 1u); return (u16)(u >> 16); }
DI unsigned pk2(float lo, float hi) { return (unsigned)f2bf(lo) | ((unsigned)f2bf(hi) << 16); }
DI float sigm(float x) { return 1.f / (1.f + __expf(-x)); }
DI float gelu_t(float x) { const float u = 1.5957691216f * (x + 0.044715f * x * x * x); return x / (1.f + __expf(-u)); }
DI float wsum(float v) { v += __shfl_xor(v, 1); v += __shfl_xor(v, 2); v += __shfl_xor(v, 4); v += __shfl_xor(v, 8); v += __shfl_xor(v, 16); v += __shfl_xor(v, 32); return v; }
DI void unpack8(const u32x4 r, float* f) { f[0] = bflo(r.x); f[1] = bfhi(r.x); f[2] = bflo(r.y); f[3] = bfhi(r.y); f[4] = bflo(r.z); f[5] = bfhi(r.z); f[6] = bflo(r.w); f[7] = bfhi(r.w); }
DI f32x4 mfma16(bf16x8 a, bf16x8 b, f32x4 c) { return __builtin_amdgcn_mfma_f32_16x16x32_bf16(a, b, c, 0, 0, 0); }

struct UE {
    static constexpr bool AFTER_DRAIN = false;
    int perm, kind; u16* O; int ldc, split; const u16* gate; float* F; const float* Fin;
    DI void operator()(const f32x4 (&acc)[2][2][4][2], const Unit& u, int wr, int wc, int fr, int fq) const {
        const int row0 = u.pm * 256 + wr * 64 + fr;
        if (kind == 0) {
            const int col0 = u.pn * 256 + wc * 32 + 8 * fq;
#pragma unroll
            for (int ai = 0; ai < 2; ++ai)
#pragma unroll
                for (int m = 0; m < 4; ++m) { const int row = row0 + ai * 128 + m * 16;
#pragma unroll
                    for (int bj = 0; bj < 2; ++bj) { const int col = col0 + bj * 128;
                        u16* p = split ? O + (size_t)(col >> 10) * ((size_t)T * 1024) + (size_t)row * 1024 + (col & 1023) : O + (size_t)row * ldc + col;
                        const f32x4 v0 = acc[ai][bj][m][0], v1 = acc[ai][bj][m][1];
                        u32x4 w; w.x = cvt_pk_bf16(v0[0], v0[1]); w.y = cvt_pk_bf16(v0[2], v0[3]); w.z = cvt_pk_bf16(v1[0], v1[1]); w.w = cvt_pk_bf16(v1[2], v1[3]);
                        *(u32x4*)p = w; } }
        } else {
            const int col0 = u.pn * 256 + wc * 32 + 4 * fq;
#pragma unroll
            for (int ai = 0; ai < 2; ++ai)
#pragma unroll
                for (int m = 0; m < 4; ++m) { const int row = row0 + ai * 128 + m * 16;
#pragma unroll
                    for (int bj = 0; bj < 2; ++bj)
#pragma unroll
                        for (int n = 0; n < 2; ++n) { const size_t idx = (size_t)row * 1024 + col0 + bj * 128 + n * 16; const f32x4 v = acc[ai][bj][m][n];
                            if (kind == 3) { const f32x4 b = *(const f32x4*)(Fin + idx); *(f32x4*)(F + idx) = b + v; }
                            else { const u32x2 gr = *(const u32x2*)(gate + idx);
                                f32x4 s; s[0] = sigm(bflo(gr.x)); s[1] = sigm(bfhi(gr.x)); s[2] = sigm(bflo(gr.y)); s[3] = sigm(bfhi(gr.y));
                                if (kind == 1) { *(f32x4*)(F + idx) = s * v; }
                                else { const f32x4 b = *(const f32x4*)(Fin + idx); const f32x4 r = b + s * v; u32x2 w; w.x = cvt_pk_bf16(r[0], r[1]); w.y = cvt_pk_bf16(r[2], r[3]); *(u32x2*)(O + idx) = w; } } } }
        }
    }
};
struct GD { const u16* A; const u16* Bt; int M, N, K, cshift; UE e; };

DI void cvt_w(int mk_tid, LAS unsigned char* lds, const float* W, int ldw, int col0, int ncols, int K, u16* dst, int& tb) {
    LAS float* tile = (LAS float*)lds;
    const int tid = mk_tid, G = gridDim.x; const int ntn = ncols >> 6, nt = ntn * (K >> 6);
    int i0 = ((int)blockIdx.x - tb) % G; if (i0 < 0) i0 += G;
    for (int i = i0; i < nt; i += G) {
        const int tn = i % ntn, tk = i / ntn;
        __syncthreads();
        for (int e = tid; e < 4096; e += 512) { const int r = e >> 6, c = e & 63; tile[r * 65 + c] = W[(size_t)(tk * 64 + r) * ldw + col0 + tn * 64 + c]; }
        __syncthreads();
        for (int e = tid; e < 2048; e += 512) { const int n = e >> 5, k2 = (e & 31) * 2; *(unsigned*)(dst + (size_t)(tn * 64 + n) * K + tk * 64 + k2) = pk2(tile[k2 * 65 + n], tile[(k2 + 1) * 65 + n]); }
    }
    tb = (tb + nt) % G;
}

DI void norm_rows(int mk_tid, const float* src, const float* g, u16* dst, int nrows, const LAS float* sW, const float* ifb, float* ifg) {
    const int lane = mk_tid & 63, gw = blockIdx.x * 8 + (mk_tid >> 6), nw = gridDim.x * 8;
    float4 gv[4];
#pragma unroll
    for (int i = 0; i < 4; ++i) gv[i] = *(const float4*)(g + i * 256 + lane * 4);
    for (int row = gw; row < nrows; row += nw) {
        const float* p = src + (size_t)row * 1024; float4 v[4]; float ss = 0.f;
#pragma unroll
        for (int i = 0; i < 4; ++i) { v[i] = *(const float4*)(p + i * 256 + lane * 4); ss += v[i].x * v[i].x + v[i].y * v[i].y + v[i].z * v[i].z + v[i].w * v[i].w; }
        ss = wsum(ss); const float rinv = rsqrtf(ss * (1.f / 1024.f) + 1e-6f);
#pragma unroll
        for (int i = 0; i < 4; ++i) { v[i].x *= rinv * gv[i].x; v[i].y *= rinv * gv[i].y; v[i].z *= rinv * gv[i].z; v[i].w *= rinv * gv[i].w;
            u32x2 w; w.x = pk2(v[i].x, v[i].y); w.y = pk2(v[i].z, v[i].w); *(u32x2*)(dst + (size_t)row * 1024 + i * 256 + lane * 4) = w; }
        if (sW) {
            float a0 = 0, a1 = 0, a2 = 0, a3 = 0, a4 = 0, a5 = 0, a6 = 0, a7 = 0;
#pragma unroll
            for (int i = 0; i < 4; ++i) { const float y[4] = {v[i].x, v[i].y, v[i].z, v[i].w};
#pragma unroll
                for (int e = 0; e < 4; ++e) { const int k = i * 256 + lane * 4 + e; const LAS f32x4* wp = (const LAS f32x4*)(sW + k * 8); const f32x4 w0 = wp[0], w1 = wp[1];
                    a0 += y[e] * w0.x; a1 += y[e] * w0.y; a2 += y[e] * w0.z; a3 += y[e] * w0.w; a4 += y[e] * w1.x; a5 += y[e] * w1.y; a6 += y[e] * w1.z; a7 += y[e] * w1.w; } }
            a0 = wsum(a0); a1 = wsum(a1); a2 = wsum(a2); a3 = wsum(a3); a4 = wsum(a4); a5 = wsum(a5); a6 = wsum(a6); a7 = wsum(a7);
            if (lane == 0) { float4 o0, o1; o0.x = a0 + ifb[0]; o0.y = a1 + ifb[1]; o0.z = a2 + ifb[2]; o0.w = a3 + ifb[3]; o1.x = a4 + ifb[4]; o1.y = a5 + ifb[5]; o1.z = a6 + ifb[6]; o1.w = a7 + ifb[7];
                *(float4*)(ifg + (size_t)row * 8) = o0; *(float4*)(ifg + (size_t)row * 8 + 4) = o1; }
        }
    }
}
DI void final_norm(int mk_tid, float* h, const float* g) {
    const int lane = mk_tid & 63, gw = blockIdx.x * 8 + (mk_tid >> 6), nw = gridDim.x * 8;
    for (int row = gw; row < T; row += nw) {
        float* p = h + (size_t)row * 1024; float4 v[4]; float ss = 0.f;
#pragma unroll
        for (int i = 0; i < 4; ++i) { v[i] = *(const float4*)(p + i * 256 + lane * 4); ss += v[i].x * v[i].x + v[i].y * v[i].y + v[i].z * v[i].z + v[i].w * v[i].w; }
        ss = wsum(ss); const float rinv = rsqrtf(ss * (1.f / 1024.f) + 1e-6f);
#pragma unroll
        for (int i = 0; i < 4; ++i) { const float4 gv = *(const float4*)(g + i * 256 + lane * 4); float4 o; o.x = v[i].x * rinv * gv.x; o.y = v[i].y * rinv * gv.y; o.z = v[i].z * rinv * gv.z; o.w = v[i].w * rinv * gv.w; *(float4*)(p + i * 256 + lane * 4) = o; }
    }
}

DI void conv_qk_phase(int mk_tid, const u16* qk, const float* cw, const float* cb, u16* qc, u16* kc) {
    const int gtid = blockIdx.x * 512 + mk_tid, nth = gridDim.x * 512;
    for (int item = gtid; item < 256 * 1024; item += nth) {
        const int co = item & 255, tb = item >> 8, c0 = co * 8, t0 = tb * 16;
        float w0[8], w1[8], w2[8], w3[8], bb[8];
#pragma unroll
        for (int e = 0; e < 8; ++e) { w0[e] = cw[c0 + e]; w1[e] = cw[2048 + c0 + e]; w2[e] = cw[4096 + c0 + e]; w3[e] = cw[6144 + c0 + e]; bb[e] = cb[c0 + e]; }
        float x0[8], x1[8], x2[8], x3[8];
        if ((t0 & (SEQ - 1)) == 0) {
#pragma unroll
            for (int e = 0; e < 8; ++e) { x0[e] = 0.f; x1[e] = 0.f; x2[e] = 0.f; }
        } else {
            unpack8(*(const u32x4*)(qk + (size_t)(t0 - 3) * 2048 + c0), x0); unpack8(*(const u32x4*)(qk + (size_t)(t0 - 2) * 2048 + c0), x1); unpack8(*(const u32x4*)(qk + (size_t)(t0 - 1) * 2048 + c0), x2);
        }
        u16* dstp = (c0 < 1024) ? qc + c0 : kc + (c0 - 1024); const float sc = (c0 < 1024) ? 1.f : 0.0625f;
        for (int tt = 0; tt < 16; ++tt) {
            unpack8(*(const u32x4*)(qk + (size_t)(t0 + tt) * 2048 + c0), x3);
            float o[8];
#pragma unroll
            for (int e = 0; e < 8; ++e) { const float v = bb[e] + w0[e] * x0[e] + w1[e] * x1[e] + w2[e] * x2[e] + w3[e] * x3[e]; o[e] = sc * v * sigm(v); x0[e] = x1[e]; x1[e] = x2[e]; x2[e] = x3[e]; }
            u32x4 r; r.x = pk2(o[0], o[1]); r.y = pk2(o[2], o[3]); r.z = pk2(o[4], o[5]); r.w = pk2(o[6], o[7]);
            *(u32x4*)(dstp + (size_t)(t0 + tt) * 1024) = r;
        }
    }
}

DI float logsig(float x) { return fminf(x, 0.f) - log1pf(__expf(-fabsf(x))); }
DI void gate_prepass(int mk_tid, int bh, const float* ifg, float* gz, float* gM, float* gE, float* gms, float* gMl) {
    const int lane = mk_tid & 63, b = bh >> 2, h = bh & 3;
    float m_st = 0.f;
    for (int c = 0; c < 16; ++c) {
        const int s0 = c * 128 + 2 * lane; const size_t t = (size_t)b * SEQ + s0;
        const float i0 = ifg[t * 8 + h], f0 = ifg[t * 8 + 4 + h], i1 = ifg[t * 8 + 8 + h], f1 = ifg[t * 8 + 12 + h];
        const float lf0 = logsig(f0), lf1 = logsig(f1), s1 = lf0 + lf1;
        float inc = s1;
#pragma unroll
        for (int d = 1; d < 64; d <<= 1) { const float o = __shfl_up(inc, d); if (lane >= d) inc += o; }
        const float exc = inc - s1, b0 = exc + lf0, b1 = exc + s1, z0 = i0 - b0, z1 = i1 - b1;
        float incm = fmaxf(z0, z1);
#pragma unroll
        for (int d = 1; d < 64; d <<= 1) { const float o = __shfl_up(incm, d); if (lane >= d) incm = fmaxf(incm, o); }
        float excm = __shfl_up(incm, 1); if (lane == 0) excm = -3.0e38f;
        const float M0 = fmaxf(m_st, fmaxf(excm, z0)), M1 = fmaxf(m_st, incm);
        const size_t gi = (size_t)bh * SEQ + s0;
        *(float2*)(gz + gi) = make_float2(z0, z1); *(float2*)(gM + gi) = make_float2(M0, M1); *(float2*)(gE + gi) = make_float2(__expf(-(b0 + M0)), __expf(-(b1 + M1)));
        const float gtot = __shfl(inc, 63), Ml = __shfl(M1, 63);
        if (lane == 0) { gms[bh * 16 + c] = m_st; gMl[bh * 16 + c] = Ml; }
        m_st = gtot + Ml;
    }
}

DI void mlstm_state_phase(int mk_tid, const u16* kc, const u16* vT, const float* gz, const float* gms, const float* gMl, u16* CT, float* nvec) {
    const int tid = mk_tid, lane = tid & 63, wid = tid >> 6, fr = lane & 15, fq = lane >> 4;
    for (int item = blockIdx.x; item < 256; item += gridDim.x) {
        const int bh = item >> 3, eb = item & 7, b = bh >> 2, h = bh & 3;
        f32x4 acc[2][2]; float nacc[2] = {0.f, 0.f};
#pragma unroll
        for (int dm = 0; dm < 2; ++dm)
#pragma unroll
            for (int en = 0; en < 2; ++en) acc[dm][en] = (f32x4){0.f, 0.f, 0.f, 0.f};
        for (int c = 0; c < 16; ++c) {
            u16* ct = CT + ((size_t)(bh * 16 + c) << 16);
#pragma unroll
            for (int dm = 0; dm < 2; ++dm) {
#pragma unroll
                for (int en = 0; en < 2; ++en) { const int e = eb * 32 + en * 16 + fr, d = wid * 32 + dm * 16 + 4 * fq; u32x2 w; w.x = pk2(acc[dm][en][0], acc[dm][en][1]); w.y = pk2(acc[dm][en][2], acc[dm][en][3]); *(u32x2*)(ct + e * 256 + d) = w; }
                float r = nacc[dm]; r += __shfl_xor(r, 16); r += __shfl_xor(r, 32);
                if (eb == 0 && fq == 0) nvec[(size_t)(bh * 16 + c) * 256 + wid * 32 + dm * 16 + fr] = r;
            }
            if (c == 15) break;
            const float Ml = gMl[bh * 16 + c], dec = __expf(gms[bh * 16 + c] - Ml);
#pragma unroll
            for (int dm = 0; dm < 2; ++dm) { nacc[dm] *= dec;
#pragma unroll
                for (int en = 0; en < 2; ++en) acc[dm][en] *= dec; }
            const size_t tbase = (size_t)b * SEQ + c * 128;
#pragma unroll
            for (int ks = 0; ks < 4; ++ks) {
                const int s0 = ks * 32 + 8 * fq;
                const float4 z0 = *(const float4*)(gz + (size_t)bh * SEQ + c * 128 + s0), z1 = *(const float4*)(gz + (size_t)bh * SEQ + c * 128 + s0 + 4);
                float w[8] = {__expf(z0.x - Ml), __expf(z0.y - Ml), __expf(z0.z - Ml), __expf(z0.w - Ml), __expf(z1.x - Ml), __expf(z1.y - Ml), __expf(z1.z - Ml), __expf(z1.w - Ml)};
                bf16x8 bfr[2], afr[2];
#pragma unroll
                for (int en = 0; en < 2; ++en) { float v[8]; unpack8(*(const u32x4*)(vT + (size_t)(h * 256 + eb * 32 + en * 16 + fr) * T + tbase + s0), v);
                    u32x4 pk; pk.x = pk2(v[0] * w[0], v[1] * w[1]); pk.y = pk2(v[2] * w[2], v[3] * w[3]); pk.z = pk2(v[4] * w[4], v[5] * w[5]); pk.w = pk2(v[6] * w[6], v[7] * w[7]); bfr[en] = __builtin_bit_cast(bf16x8, pk); }
#pragma unroll
                for (int dm = 0; dm < 2; ++dm) { const int d = h * 256 + wid * 32 + dm * 16 + fr; float ns = 0.f; bf16x8 a;
#pragma unroll
                    for (int j = 0; j < 8; ++j) { const u16 kv = kc[(tbase + s0 + j) * 1024 + d]; a[j] = (short)kv; ns += w[j] * bf2f(kv); }
                    afr[dm] = a; nacc[dm] += ns; }
#pragma unroll
                for (int dm = 0; dm < 2; ++dm)
#pragma unroll
                    for (int en = 0; en < 2; ++en) acc[dm][en] = mfma16(afr[dm], bfr[en], acc[dm][en]);
            }
        }
    }
}

DI void mlstm_out_phase(int mk_tid, LAS unsigned char* lds, u16* qy, const u16* kc, const u16* vT, const u16* CT, const float* nvec, const u16* og,
                        const float* gz, const float* gM, const float* gE, const float* gms, const float* ng) {
    const int tid = mk_tid, lane = tid & 63, wid = __builtin_amdgcn_readfirstlane(tid >> 6), fr = lane & 15, fq = lane >> 4;
    LAS u16* Ksh = (LAS u16*)lds;
    LAS u16* Vsh = (LAS u16*)(lds + 67584);
    for (int item = blockIdx.x; item < 512; item += gridDim.x) {
        const int bh = item >> 4, c = item & 15, b = bh >> 2, h = bh & 3; const size_t tbase = (size_t)b * SEQ + c * 128;
        __syncthreads();
        for (int e = tid; e < 4096; e += 512) { const int r = e >> 5, p = e & 31; *(LAS u32x4*)(Ksh + r * 264 + p * 8) = *(const u32x4*)(kc + (tbase + r) * 1024 + h * 256 + p * 8); }
        for (int e = tid; e < 4096; e += 512) { const int r = e >> 4, p = e & 15; *(LAS u32x4*)(Vsh + r * 136 + p * 8) = *(const u32x4*)(vT + (size_t)(h * 256 + r) * T + tbase + p * 8); }
        __syncthreads();
        const int tl = wid * 16 + fr; const size_t tok = tbase + tl;
        bf16x8 qf[8];
#pragma unroll
        for (int ks = 0; ks < 8; ++ks) qf[ks] = *(const bf16x8*)(qy + tok * 1024 + h * 256 + ks * 32 + 8 * fq);
        const size_t gi = (size_t)bh * SEQ + c * 128;
        const float Mt = gM[gi + tl], en_t = gE[gi + tl], winter = __expf(gms[bh * 16 + c] - Mt);
        bf16x8 pf[4]; float dsum = 0.f;
#pragma unroll
        for (int sp = 0; sp < 4; ++sp) {
            u32x4 pk = (u32x4){0u, 0u, 0u, 0u};
#pragma unroll
            for (int hh = 0; hh < 2; ++hh) { const int si = sp * 2 + hh;
                if (si <= wid) {
                    f32x4 st = (f32x4){0.f, 0.f, 0.f, 0.f};
#pragma unroll
                    for (int ks = 0; ks < 8; ++ks) { const bf16x8 a = *(const LAS bf16x8*)(Ksh + (si * 16 + fr) * 264 + ks * 32 + 8 * fq); st = mfma16(a, qf[ks], st); }
                    const float4 z = *(const float4*)(gz + gi + si * 16 + 4 * fq); const float zz[4] = {z.x, z.y, z.z, z.w}; float pv[4];
#pragma unroll
                    for (int j = 0; j < 4; ++j) { const int s = si * 16 + 4 * fq + j; const float p = (s <= tl) ? st[j] * __expf(zz[j] - Mt) : 0.f; dsum += p; pv[j] = p; }
                    if (hh == 0) { pk.x = pk2(pv[0], pv[1]); pk.y = pk2(pv[2], pv[3]); } else { pk.z = pk2(pv[0], pv[1]); pk.w = pk2(pv[2], pv[3]); }
                } }
            pf[sp] = __builtin_bit_cast(bf16x8, pk);
        }
        const u16* ct = CT + ((size_t)(bh * 16 + c) << 16);
        f32x4 o[16];
        bf16x8 cfn[8];
#pragma unroll
        for (int ks = 0; ks < 8; ++ks) cfn[ks] = *(const bf16x8*)(ct + fr * 256 + ks * 32 + 8 * fq);
#pragma unroll
        for (int et = 0; et < 16; ++et) { f32x4 a = (f32x4){0.f, 0.f, 0.f, 0.f}; bf16x8 cf[8];
#pragma unroll
            for (int ks = 0; ks < 8; ++ks) cf[ks] = cfn[ks];
            if (et < 15) {
#pragma unroll
                for (int ks = 0; ks < 8; ++ks) cfn[ks] = *(const bf16x8*)(ct + ((et + 1) * 16 + fr) * 256 + ks * 32 + 8 * fq); }
#pragma unroll
            for (int ks = 0; ks < 8; ++ks) a = mfma16(cf[ks], qf[ks], a);
            o[et] = a * winter; __builtin_amdgcn_sched_barrier(0); }
        const float* nv = nvec + (size_t)(bh * 16 + c) * 256; float qn = 0.f;
#pragma unroll
        for (int ks = 0; ks < 8; ++ks) { const float4 n0 = *(const float4*)(nv + ks * 32 + 8 * fq), n1 = *(const float4*)(nv + ks * 32 + 8 * fq + 4); const float nn[8] = {n0.x, n0.y, n0.z, n0.w, n1.x, n1.y, n1.z, n1.w};
#pragma unroll
            for (int j = 0; j < 8; ++j) qn += bf2f((u16)qf[ks][j]) * nn[j]; }
        qn += __shfl_xor(qn, 16); qn += __shfl_xor(qn, 32); dsum += __shfl_xor(dsum, 16); dsum += __shfl_xor(dsum, 32);
        const int nsp = (wid >> 1) + 1;
#pragma unroll
        for (int et = 0; et < 16; ++et) { __builtin_amdgcn_sched_barrier(0);
#pragma unroll
            for (int sp = 0; sp < 4; ++sp) if (sp < nsp) {
                const s16x4 lo = *(const LAS s16x4*)(Vsh + (et * 16 + fr) * 136 + sp * 32 + 4 * fq), hi = *(const LAS s16x4*)(Vsh + (et * 16 + fr) * 136 + sp * 32 + 16 + 4 * fq);
                const bf16x8 a = __builtin_shufflevector(lo, hi, 0, 1, 2, 3, 4, 5, 6, 7); o[et] = mfma16(a, pf[sp], o[et]); } }
        const float den = winter * qn + dsum, inv = 1.f / fmaxf(fabsf(den), en_t);
        float sum = 0.f;
#pragma unroll
        for (int et = 0; et < 16; ++et) { o[et] *= inv; sum += (o[et][0] + o[et][1]) + (o[et][2] + o[et][3]); }
        sum += __shfl_xor(sum, 16); sum += __shfl_xor(sum, 32); const float mu = sum * (1.f / 256.f);
        float var = 0.f;
#pragma unroll
        for (int et = 0; et < 16; ++et) { o[et] -= mu; var += (o[et][0] * o[et][0] + o[et][1] * o[et][1]) + (o[et][2] * o[et][2] + o[et][3] * o[et][3]); }
        var += __shfl_xor(var, 16); var += __shfl_xor(var, 32); const float rstd = rsqrtf(var * (1.f / 256.f) + 1e-6f);
#pragma unroll
        for (int et = 0; et < 16; ++et) { const int e = h * 256 + et * 16 + 4 * fq; const u32x2 ogr = *(const u32x2*)(og + tok * 1024 + e); const float4 g4 = *(const float4*)(ng + e);
            u32x2 w; w.x = pk2(sigm(bflo(ogr.x)) * o[et][0] * rstd * g4.x, sigm(bfhi(ogr.x)) * o[et][1] * rstd * g4.y); w.y = pk2(sigm(bflo(ogr.y)) * o[et][2] * rstd * g4.z, sigm(bfhi(ogr.y)) * o[et][3] * rstd * g4.w);
            *(u32x2*)(qy + tok * 1024 + e) = w; }
    }
}

DI void xattn_phase(int mk_tid, LAS unsigned char* lds, const u16* q, const u16* kmem, const u16* vTm, u16* ao) {
    const int tid = mk_tid, lane = tid & 63, wid = tid >> 6, fr = lane & 15, fq = lane >> 4;
    LAS u16* Ksh = (LAS u16*)lds;
    int cur_bh = -1;
    for (int base = blockIdx.x * 2; base < 512; base += gridDim.x * 2)
        for (int jj = 0; jj < 2; ++jj) {
            const int item = base + jj, bh = item >> 4, qb = item & 15, b = bh >> 2, h = bh & 3;
            if (bh != cur_bh) {
                __syncthreads();
                for (int e = tid; e < 8192; e += 512) { const int r = e >> 5, p = e & 31; *(LAS u32x4*)(Ksh + r * 264 + p * 8) = *(const u32x4*)(kmem + (size_t)(b * 256 + r) * 1024 + h * 256 + p * 8); }
                __syncthreads(); cur_bh = bh;
            }
            const size_t tok = (size_t)b * SEQ + qb * 128 + wid * 16 + fr;
            bf16x8 qf[8];
#pragma unroll
            for (int ks = 0; ks < 8; ++ks) qf[ks] = *(const bf16x8*)(q + tok * 1024 + h * 256 + ks * 32 + 8 * fq);
            f32x4 st[16]; float mx = -3.0e38f;
#pragma unroll
            for (int mi = 0; mi < 16; ++mi) { f32x4 a = (f32x4){0.f, 0.f, 0.f, 0.f};
#pragma unroll
                for (int ks = 0; ks < 8; ++ks) { const bf16x8 kf = *(const LAS bf16x8*)(Ksh + (mi * 16 + fr) * 264 + ks * 32 + 8 * fq); a = mfma16(kf, qf[ks], a); }
                st[mi] = a; mx = fmaxf(mx, fmaxf(fmaxf(a[0], a[1]), fmaxf(a[2], a[3]))); }
            mx = fmaxf(mx, __shfl_xor(mx, 16)); mx = fmaxf(mx, __shfl_xor(mx, 32));
            bf16x8 pf[8]; float sum = 0.f;
#pragma unroll
            for (int sp = 0; sp < 8; ++sp) { float p[8];
#pragma unroll
                for (int j = 0; j < 4; ++j) { p[j] = __expf((st[2 * sp][j] - mx) * 0.0625f); p[4 + j] = __expf((st[2 * sp + 1][j] - mx) * 0.0625f); sum += p[j] + p[4 + j]; }
                u32x4 pk; pk.x = pk2(p[0], p[1]); pk.y = pk2(p[2], p[3]); pk.z = pk2(p[4], p[5]); pk.w = pk2(p[6], p[7]); pf[sp] = __builtin_bit_cast(bf16x8, pk); }
            sum += __shfl_xor(sum, 16); sum += __shfl_xor(sum, 32); const float inv = 1.f / sum;
            const u16* vp = vTm + (size_t)(h * 256 + fr) * 2048 + b * 256 + 4 * fq;
            s16x4 vlo[8], vhi[8];
#pragma unroll
            for (int sp = 0; sp < 8; ++sp) { vlo[sp] = *(const s16x4*)(vp + sp * 32); vhi[sp] = *(const s16x4*)(vp + sp * 32 + 16); }
#pragma unroll 1
            for (int et = 0; et < 16; ++et) {
                s16x4 clo[8], chi[8];
#pragma unroll
                for (int sp = 0; sp < 8; ++sp) { clo[sp] = vlo[sp]; chi[sp] = vhi[sp]; }
                if (et < 15) { const u16* vn = vp + (size_t)(et + 1) * 16 * 2048;
#pragma unroll
                    for (int sp = 0; sp < 8; ++sp) { vlo[sp] = *(const s16x4*)(vn + sp * 32); vhi[sp] = *(const s16x4*)(vn + sp * 32 + 16); } }
                f32x4 o = (f32x4){0.f, 0.f, 0.f, 0.f};
#pragma unroll
                for (int sp = 0; sp < 8; ++sp) { const bf16x8 a = __builtin_shufflevector(clo[sp], chi[sp], 0, 1, 2, 3, 4, 5, 6, 7); o = mfma16(a, pf[sp], o); }
                u32x2 w; w.x = pk2(o[0] * inv, o[1] * inv); w.y = pk2(o[2] * inv, o[3] * inv); *(u32x2*)(ao + tok * 1024 + h * 256 + et * 16 + 4 * fq) = w; }
        }
}

DI void rglru_phase(int mk_tid, LAS unsigned char* lds, const u16* xr, const u16* gr, const float* cw, const float* cb, const float* wa, const float* ba, const float* wx, const float* bx, const float* lam, u16* ya) {
    const int tid = mk_tid, lane = tid & 63, wid = tid >> 6, fr = lane & 15, fq = lane >> 4;
    if (wid >= 2) return;
    LAS u16* xs = (LAS u16*)(lds + wid * 8192);
    LAS float* xf = (LAS float*)(lds + wid * 8192 + 2560);
    const int tp = lane >> 3, co = lane & 7;
    for (int item = blockIdx.x * 2 + wid; item < 512; item += gridDim.x * 2) {
        const int b = item >> 6, g = (item >> 2) & 15, nt = item & 3, cch = g * 64 + nt * 16 + fr, ccol = g * 64 + co * 8;
        bf16x8 wfa[2], wfx[2];
#pragma unroll
        for (int ks = 0; ks < 2; ++ks) { bf16x8 fa, fx;
#pragma unroll
            for (int j = 0; j < 8; ++j) { const int i = ks * 32 + 8 * fq + j; fa[j] = (short)f2bf(wa[(size_t)(g * 64 + i) * 64 + nt * 16 + fr]); fx[j] = (short)f2bf(wx[(size_t)(g * 64 + i) * 64 + nt * 16 + fr]); }
            wfa[ks] = fa; wfx[ks] = fx; }
        const float bav = ba[cch], bxv = bx[cch], c8 = -8.f * log1pf(__expf(-lam[cch]));
        float w0[8], w1[8], w2[8], w3[8], bb[8];
#pragma unroll
        for (int e = 0; e < 8; ++e) { w0[e] = cw[ccol + e]; w1[e] = cw[1024 + ccol + e]; w2[e] = cw[2048 + ccol + e]; w3[e] = cw[3072 + ccol + e]; bb[e] = cb[ccol + e]; }
        const size_t tb0 = (size_t)b * SEQ;
        float carry = 0.f;
        u32x4 rows[5]; u16 grv[4];
#pragma unroll
        for (int r = 0; r < 5; ++r) { const int srow = 2 * tp - 3 + r; rows[r] = (srow >= 0) ? *(const u32x4*)(xr + (tb0 + srow) * 1024 + ccol) : (u32x4){0u, 0u, 0u, 0u}; }
#pragma unroll
        for (int j = 0; j < 4; ++j) grv[j] = gr[(tb0 + 4 * fq + j) * 1024 + cch];
        for (int st = 0; st < 128; ++st) {
            u32x4 cur[5]; u16 gcur[4];
#pragma unroll
            for (int r = 0; r < 5; ++r) cur[r] = rows[r];
#pragma unroll
            for (int j = 0; j < 4; ++j) gcur[j] = grv[j];
            const int t0 = st * 16;
            if (st + 1 < 128) {
#pragma unroll
                for (int r = 0; r < 5; ++r) rows[r] = *(const u32x4*)(xr + (tb0 + t0 + 16 + 2 * tp - 3 + r) * 1024 + ccol);
#pragma unroll
                for (int j = 0; j < 4; ++j) grv[j] = gr[(tb0 + t0 + 16 + 4 * fq + j) * 1024 + cch];
            }
            float r0[8], r1[8], r2[8], r3[8], r4[8], oa[8], ob[8];
            unpack8(cur[0], r0); unpack8(cur[1], r1); unpack8(cur[2], r2); unpack8(cur[3], r3); unpack8(cur[4], r4);
#pragma unroll
            for (int e = 0; e < 8; ++e) { oa[e] = bb[e] + w0[e] * r0[e] + w1[e] * r1[e] + w2[e] * r2[e] + w3[e] * r3[e]; ob[e] = bb[e] + w0[e] * r1[e] + w1[e] * r2[e] + w2[e] * r3[e] + w3[e] * r4[e]; }
            { u32x4 pa, pb; pa.x = pk2(oa[0], oa[1]); pa.y = pk2(oa[2], oa[3]); pa.z = pk2(oa[4], oa[5]); pa.w = pk2(oa[6], oa[7]); pb.x = pk2(ob[0], ob[1]); pb.y = pk2(ob[2], ob[3]); pb.z = pk2(ob[4], ob[5]); pb.w = pk2(ob[6], ob[7]);
              *(LAS u32x4*)(xs + (2 * tp) * 72 + co * 8) = pa; *(LAS u32x4*)(xs + (2 * tp + 1) * 72 + co * 8) = pb;
              *(LAS f32x4*)(xf + (2 * tp) * 68 + co * 8) = (f32x4){oa[0], oa[1], oa[2], oa[3]}; *(LAS f32x4*)(xf + (2 * tp) * 68 + co * 8 + 4) = (f32x4){oa[4], oa[5], oa[6], oa[7]};
              *(LAS f32x4*)(xf + (2 * tp + 1) * 68 + co * 8) = (f32x4){ob[0], ob[1], ob[2], ob[3]}; *(LAS f32x4*)(xf + (2 * tp + 1) * 68 + co * 8 + 4) = (f32x4){ob[4], ob[5], ob[6], ob[7]}; }
            __builtin_amdgcn_fence(__ATOMIC_RELEASE, "wavefront"); __builtin_amdgcn_wave_barrier(); __builtin_amdgcn_fence(__ATOMIC_ACQUIRE, "wavefront");
            f32x4 aa = (f32x4){0.f, 0.f, 0.f, 0.f}, ax = (f32x4){0.f, 0.f, 0.f, 0.f};
#pragma unroll
            for (int ks = 0; ks < 2; ++ks) { const bf16x8 af = *(const LAS bf16x8*)(xs + fr * 72 + ks * 32 + 8 * fq); aa = mfma16(af, wfa[ks], aa); ax = mfma16(af, wfx[ks], ax); }
            float hl[4], pa4[4]; float Al = 1.f, Hl = 0.f;
#pragma unroll
            for (int j = 0; j < 4; ++j) { const float xc = xf[(4 * fq + j) * 68 + nt * 16 + fr]; const float rr = sigm(aa[j] + bav), ii = sigm(ax[j] + bxv), la = c8 * rr, av = __expf(la), mult = sqrtf(fmaxf(-expm1f(2.f * la), 0.f)), uu = mult * ii * xc;
                Hl = av * Hl + uu; Al *= av; hl[j] = Hl; pa4[j] = Al; }
            __builtin_amdgcn_fence(__ATOMIC_RELEASE, "wavefront"); __builtin_amdgcn_wave_barrier(); __builtin_amdgcn_fence(__ATOMIC_ACQUIRE, "wavefront");
            const float A0 = __shfl(Al, fr), H0 = __shfl(Hl, fr), A1 = __shfl(Al, fr + 16), H1 = __shfl(Hl, fr + 16), A2 = __shfl(Al, fr + 32), H2 = __shfl(Hl, fr + 32), A3 = __shfl(Al, fr + 48), H3 = __shfl(Hl, fr + 48);
            const float c1 = A0 * carry + H0, c2 = A1 * c1 + H1, c3 = A2 * c2 + H2, c4 = A3 * c3 + H3;
            const float hin = (fq == 0) ? carry : (fq == 1) ? c1 : (fq == 2) ? c2 : c3;
            carry = c4;
#pragma unroll
            for (int j = 0; j < 4; ++j) { const float hv = hl[j] + pa4[j] * hin; ya[(tb0 + t0 + 4 * fq + j) * 1024 + cch] = f2bf(gelu_t(bf2f(gcur[j])) * hv); }
        }
    }
}

DI void ffn_act_phase(int mk_tid, const u16* up, const float* cw, const float* cb, u16* act, int part) {
    const int gtid = blockIdx.x * 512 + mk_tid, nth = gridDim.x * 512;
    for (int item = gtid; item < 192 * 1024; item += nth) {
        const int co = item % 192, tb = item / 192, c0 = co * 8, t0 = tb * 16, gc = part * 1536 + c0;
        float wg0[8], wg1[8], wg2[8], wu0[8], wu1[8], wu2[8], bg[8], bu[8];
#pragma unroll
        for (int e = 0; e < 8; ++e) { wg0[e] = cw[gc + e]; wg1[e] = cw[6144 + gc + e]; wg2[e] = cw[12288 + gc + e]; wu0[e] = cw[3072 + gc + e]; wu1[e] = cw[6144 + 3072 + gc + e]; wu2[e] = cw[12288 + 3072 + gc + e]; bg[e] = cb[gc + e]; bu[e] = cb[3072 + gc + e]; }
        float g0[8], g1[8], g2[8], u0[8], u1[8], u2[8];
        if ((t0 & (SEQ - 1)) == 0) {
#pragma unroll
            for (int e = 0; e < 8; ++e) { g0[e] = 0.f; g1[e] = 0.f; u0[e] = 0.f; u1[e] = 0.f; }
        } else {
            unpack8(*(const u32x4*)(up + (size_t)(t0 - 2) * 3072 + c0), g0); unpack8(*(const u32x4*)(up + (size_t)(t0 - 1) * 3072 + c0), g1);
            unpack8(*(const u32x4*)(up + (size_t)(t0 - 2) * 3072 + 1536 + c0), u0); unpack8(*(const u32x4*)(up + (size_t)(t0 - 1) * 3072 + 1536 + c0), u1);
        }
        for (int tt = 0; tt < 16; ++tt) {
            unpack8(*(const u32x4*)(up + (size_t)(t0 + tt) * 3072 + c0), g2); unpack8(*(const u32x4*)(up + (size_t)(t0 + tt) * 3072 + 1536 + c0), u2);
            float o[8];
#pragma unroll
            for (int e = 0; e < 8; ++e) { const float gv = bg[e] + wg0[e] * g0[e] + wg1[e] * g1[e] + wg2[e] * g2[e], uv = bu[e] + wu0[e] * u0[e] + wu1[e] * u1[e] + wu2[e] * u2[e]; o[e] = gelu_t(gv) * uv; g0[e] = g1[e]; g1[e] = g2[e]; u0[e] = u1[e]; u1[e] = u2[e]; }
            u32x4 r; r.x = pk2(o[0], o[1]); r.y = pk2(o[2], o[3]); r.z = pk2(o[4], o[5]); r.w = pk2(o[6], o[7]);
            *(u32x4*)(act + (size_t)(t0 + tt) * 3072 + gc) = r;
        }
    }
}

DI UE ue_bf16(u16* O, int ldc, int split) { UE e; e.perm = 1; e.kind = 0; e.O = O; e.ldc = ldc; e.split = split; e.gate = nullptr; e.F = nullptr; e.Fin = nullptr; return e; }
DI GD mkgd(const u16* A, const u16* Bt, int M, int N, int K, int cshift, UE e) { GD d; d.A = A; d.Bt = Bt; d.M = M; d.N = N; d.K = K; d.cshift = cshift; d.e = e; return d; }

DI int gemm_count(int sub) { return (sub == 1 || sub == 6 || sub == 9 || sub == 13 || sub == 15 || sub == 17 || sub == 19) ? 1 : (sub == 3 || sub == 8) ? 2 : (sub == 11) ? 3 : 0; }
DI GD get_gd(const Args& a, int l, int sub, int i) {
    unsigned char* ws = a.ws;
    u16* A0 = (u16*)ws; u16* A1 = (u16*)(ws + U); u16* A2 = (u16*)(ws + 2 * U); u16* A3 = (u16*)(ws + 3 * U); u16* A4 = (u16*)(ws + 4 * U); u16* A5 = (u16*)(ws + 5 * U); u16* A6 = (u16*)(ws + 6 * U);
    u16* WT = (u16*)(ws + WS_WT); u16* MEMN = (u16*)(ws + WS_MEMN); u16* KMEM = (u16*)(ws + WS_KMEM); u16* VTM = (u16*)(ws + WS_VTM);
    const size_t MW = (size_t)1024 * 1024;
    UE er = ue_bf16(nullptr, 1024, 0); er.perm = 0; er.kind = 3; er.Fin = (l == 0 && sub == 9) ? a.in[0] : a.out; er.F = a.out;
    switch (sub) {
    case 1: return mkgd(A0, WT, T, 2048, 1024, 0, ue_bf16(A1, 2048, 0));
    case 3: return i == 0 ? mkgd(A0, WT + 2 * MW, T, 1024, 1024, 0, ue_bf16(A1, 1024, 0)) : mkgd(WT + 3 * MW, A0, 1024, T, 1024, 0, ue_bf16(A2, T, 0));
    case 6: return mkgd(A0, WT + 4 * MW, T, 4096, 1024, 0, ue_bf16(A1, 1024, 1));
    case 8: { UE e1 = ue_bf16(nullptr, 1024, 0); e1.perm = 0; e1.kind = 1; e1.gate = A3; e1.F = (float*)A1; UE e2 = e1; e2.kind = 2; e2.gate = A4; e2.Fin = (const float*)A1; e2.F = nullptr; e2.O = A0;
        return i == 0 ? mkgd(A5, WT + 8 * MW, T, 1024, 1024, 0, e1) : mkgd(A6, WT + 9 * MW, T, 1024, 1024, 0, e2); }
    case 9: return mkgd(A0, WT + 10 * MW, T, 1024, 1024, 0, er);
    case 11: return i == 0 ? mkgd(A0, WT, T, 1024, 1024, 0, ue_bf16(A1, 1024, 0)) : i == 1 ? mkgd(MEMN, WT + MW, 2048, 1024, 1024, 0, ue_bf16(KMEM, 1024, 0)) : mkgd(WT + 2 * MW, MEMN, 1024, 2048, 1024, 64, ue_bf16(VTM, 2048, 0));
    case 13: return mkgd(A2, WT + 3 * MW, T, 1024, 1024, 0, er);
    case 15: return mkgd(A0, WT, T, 3072, 1024, 0, ue_bf16(A1, 3072, 0));
    case 17: return mkgd(A0, WT + 3 * MW, T, 3072, 1024, 0, ue_bf16(A1, 3072, 0));
    default: return mkgd(A4, WT + 6 * MW, T, 1024, 3072, 0, er);
    }
}
DI int cvt_njobs(int sub) { return sub == 0 ? 8 : sub == 10 ? 3 : sub == 14 ? 5 : 0; }
DI void cvt_jobs(int mk_tid, LAS unsigned char* lds, const Args& a, int l, int sub) {
    u16* WT = (u16*)(a.ws + WS_WT); const size_t MW = (size_t)1024 * 1024; int tb = 0; const int nj = cvt_njobs(sub);
    for (int j = 0; j < nj; ++j) {
        const float* W; int ldw, col0, ncols, K = 1024; u16* dst;
        if (sub == 0) { const float* win = a.in[3] + (size_t)l * 1024 * 8200;
            if (j < 5) { W = win; ldw = 8200; col0 = (j == 0) ? 2048 : (j == 1) ? 5120 : (j == 2) ? 4096 : (j == 3) ? 0 : 6152; ncols = (j == 1 || j == 2) ? 1024 : 2048; dst = WT + ((j == 0) ? 0 : (j == 1) ? 2 : (j == 2) ? 3 : (j == 3) ? 4 : 6) * MW; }
            else { W = a.in[15 + (j - 5)] + l * MW; ldw = 1024; col0 = 0; ncols = 1024; dst = WT + (8 + (j - 5)) * MW; } }
        else if (sub == 10) { W = (j == 0) ? a.in[19] + l * MW : (j == 1) ? a.in[20] + l * 2 * MW : a.in[21] + l * MW; ldw = (j == 1) ? 2048 : 1024; col0 = 0; ncols = (j == 1) ? 2048 : 1024; dst = WT + ((j == 0) ? 0 : (j == 1) ? 1 : 3) * MW; }
        else { if (j < 4) { W = a.in[23] + (size_t)l * 6 * MW; ldw = 6144; col0 = (j == 0) ? 0 : (j == 1) ? 3072 : (j == 2) ? 1536 : 4608; ncols = 1536; dst = WT + (size_t)j * 1536 * 1024; }
               else { W = a.in[26] + (size_t)l * 3 * MW; ldw = 1024; col0 = 0; ncols = 1024; K = 3072; dst = WT + 6 * MW; } }
        cvt_w(mk_tid, lds, W, ldw, col0, ncols, K, dst, tb);
    }
}
DI void other_phase(int mk_tid, LAS unsigned char* lds, const Args& a, int l, int sub) {
    unsigned char* ws = a.ws;
    u16* A0 = (u16*)ws; u16* A1 = (u16*)(ws + U); u16* A2 = (u16*)(ws + 2 * U); u16* A3 = (u16*)(ws + 3 * U); u16* A4 = (u16*)(ws + 4 * U); u16* A5 = (u16*)(ws + 5 * U); u16* A6 = (u16*)(ws + 6 * U);
    u16* WT = (u16*)(ws + WS_WT); u16* MEMN = (u16*)(ws + WS_MEMN); u16* KMEM = (u16*)(ws + WS_KMEM); u16* VTM = (u16*)(ws + WS_VTM);
    float* IFG = (float*)(ws + WS_IFG); float* GZ = (float*)(ws + WS_GZ); float* GM = (float*)(ws + WS_GM); float* GE = (float*)(ws + WS_GE); float* GMS = (float*)(ws + WS_GMS); float* GML = (float*)(ws + WS_GML); float* NVEC = (float*)(ws + WS_NVEC);
    const int tid = mk_tid, wid = tid >> 6;
    const size_t MW = (size_t)1024 * 1024;
    const float* hsrc = (l == 0 && sub <= 9) ? a.in[0] : a.out;
    switch (sub) {
    case 0: {
        const float* win = a.in[3] + (size_t)l * 1024 * 8200;
        cvt_jobs(mk_tid, lds, a, l, sub);
        __syncthreads();
        LAS float* sW = (LAS float*)(lds + 32768);
        for (int e = tid; e < 8192; e += 512) sW[e] = win[(size_t)(e >> 3) * 8200 + 6144 + (e & 7)];
        __syncthreads();
        norm_rows(mk_tid, hsrc, a.in[2] + l * 1024, A0, T, sW, a.in[13] + l * 8, IFG);
        if (l == 0) norm_rows(mk_tid, a.in[1], a.in[27], MEMN, 2048, nullptr, nullptr, nullptr);
    } break;
    case 2: {
        if (wid == 0) for (int bh = blockIdx.x; bh < 32; bh += gridDim.x) gate_prepass(mk_tid, bh, IFG, GZ, GM, GE, GMS, GML);
        conv_qk_phase(mk_tid, A1, a.in[11] + l * 8192, a.in[12] + l * 2048, A6, A5);
    } break;
    case 4: mlstm_state_phase(mk_tid, A5, A2, GZ, GMS, GML, A3, NVEC); break;
    case 5: mlstm_out_phase(mk_tid, lds, A6, A5, A2, A3, NVEC, A1, GZ, GM, GE, GMS, a.in[14] + l * 1024); break;
    case 7: rglru_phase(mk_tid, lds, A1, A2, a.in[4] + l * 4096, a.in[5] + l * 1024, a.in[6] + l * 65536, a.in[7] + l * 1024, a.in[8] + l * 65536, a.in[9] + l * 1024, a.in[10] + l * 1024, A5); break;
    case 10: {
        cvt_jobs(mk_tid, lds, a, l, sub);
        norm_rows(mk_tid, a.out, a.in[18] + l * 1024, A0, T, nullptr, nullptr, nullptr);
    } break;
    case 12: xattn_phase(mk_tid, lds, A1, KMEM, VTM, A2); break;
    case 14: {
        cvt_jobs(mk_tid, lds, a, l, sub);
        norm_rows(mk_tid, a.out, a.in[22] + l * 1024, A0, T, nullptr, nullptr, nullptr);
    } break;
    case 16: ffn_act_phase(mk_tid, A1, a.in[24] + l * 18432, a.in[25] + l * 6144, A4, 0); break;
    case 18: ffn_act_phase(mk_tid, A1, a.in[24] + l * 18432, a.in[25] + l * 6144, A4, 1); break;
    default: break;
    }
}

__global__ void __launch_bounds__(512, 2) mk_fwd(Args a) {
    extern __shared__ __attribute__((aligned(16))) unsigned char shm[];
    LAS unsigned char* lds = (LAS unsigned char*)shm;
    cg::grid_group grid = cg::this_grid();
    for (int ph = a.ph_lo; ph < a.ph_hi; ++ph) {
        if (ph > a.ph_lo) grid.sync();
        if (ph == 40) { int mk_tid = threadIdx.x; asm volatile("" : "+v"(mk_tid)); final_norm(mk_tid, a.out, a.in[28]); continue; }
        int mk_tid = threadIdx.x; asm volatile("" : "+v"(mk_tid));
        const int l = ph / 20, sub = ph % 20;
        const int ng = gemm_count(sub);
        if (ng == 0) other_phase(mk_tid, lds, a, l, sub);
        for (int i = 0; i < ng; ++i) {
            const GD d = get_gd(a, l, sub, i);
            __syncthreads();
            Gemm g; g.A = d.A; g.Bt = d.Bt; g.M = d.M; g.N = d.N; g.K = d.K;
            StaticOrder S; S.init(d.M, d.N, (int)gridDim.x, (int)((blockIdx.x + d.cshift) % gridDim.x));
            gemm_phase<UE, StaticOrder, false>(mk_tid, lds, g, S, d.e, nullptr);
        }
    }
}

extern "C" void kernel_launch(void* const* d_in, const int* in_sizes, int n_in, void* d_out, int out_size, void* d_ws, size_t ws_size, hipStream_t stream) {
    static int grid = 0;
    if (grid == 0) {
        if (n_in != 29 || out_size != T * 1024 || ws_size < WS_END) { fprintf(stderr, "kernel_launch: unexpected shapes (n_in %d out %d ws %zu need %zu)\n", n_in, out_size, ws_size, (size_t)WS_END); grid = -1; return; }
        int dev = 0, cus = 0, per_cu = 0;
        hipGetDevice(&dev); hipDeviceGetAttribute(&cus, hipDeviceAttributeMultiprocessorCount, dev);
        hipFuncSetAttribute((const void*)mk_fwd, hipFuncAttributeMaxDynamicSharedMemorySize, LDS_BYTES);
        hipOccupancyMaxActiveBlocksPerMultiprocessor(&per_cu, (const void*)mk_fwd, 512, LDS_BYTES);
        if (per_cu < 1) per_cu = 1;
        grid = cus * per_cu;
        (void)hipGetLastError();
    }
    if (grid < 0) return;
    Args a{};
    for (int i = 0; i < 29; ++i) a.in[i] = (const float*)d_in[i];
    a.out = (float*)d_out; a.ws = (unsigned char*)d_ws;
#if defined(MK_PER_PHASE)
    for (int ph = 0; ph < NPH; ++ph) { a.ph_lo = ph; a.ph_hi = ph + 1; hipLaunchKernelGGL(mk_fwd, dim3(grid), dim3(512), LDS_BYTES, stream, a); }
#else
    a.ph_lo = 0; a.ph_hi = NPH;
    void* args[] = {&a};
    hipError_t e = hipLaunchCooperativeKernel((void*)mk_fwd, dim3(grid), dim3(512), args, LDS_BYTES, stream);
    if (e != hipSuccess) fprintf(stderr, "cooperative launch failed: %s (grid %d)\n", hipGetErrorString(e), grid);
#endif
}
```

```cpp
#include <hip/hip_runtime.h>
#include <hip/hip_cooperative_groups.h>
#include <cstdio>
namespace cg = cooperative_groups;
namespace pg8 {
#define PG8_LAS __attribute__((address_space(3)))
typedef unsigned short bf16_t;
typedef short bf16x8 __attribute__((ext_vector_type(8)));
typedef float f32x4 __attribute__((ext_vector_type(4)));
typedef unsigned u32x4 __attribute__((ext_vector_type(4)));
constexpr int BM = 256, BK = 64, HALF = 128, HTB = HALF * BK * 2  , STAGE_BYTES = 8 * HTB, NXCD = 8, WGM = 8;

__host__ __device__ __forceinline__ int lds_byte(int r, int c) { const int st = (r >> 4) * 2 + (c >> 5), rr = r & 15, cc = c & 31, ob = rr * 64 + cc * 2; return st * 1024 + (ob ^ (((ob >> 9) & 1) << 5)); }
__host__ __device__ __forceinline__ void stage_rc(int b, int& R, int& C) { const int st = b / 1024, sb = b % 1024, swz = sb ^ (((sb >> 9) & 1) << 5); R = (st >> 1) * 16 + swz / 64; C = (st & 1) * 32 + (swz % 64) / 2; }
__host__ __device__ __forceinline__ int perm32(int rho) { const int n = rho >> 4, i = rho & 15; return 8 * (i >> 2) + 4 * n + (i & 3); }

struct Unit { int pm, pn; };
struct Gemm { const bf16_t* A; const bf16_t* Bt; int M, N, K; };

struct StaticOrder {
    int nM, nN, nwg, G, c;
    __host__ __device__ void init(int M, int N, int G_, int c_) { nM = M / BM; nN = N / BM; nwg = nM * nN; G = G_; c = c_; }
    __host__ __device__ bool next(int i, Unit& u) const {
        const long L = (long)i * G + c; if (L >= nwg) return false;
        int wgid = (int)L; { const int q = nwg / NXCD, r = nwg % NXCD, xcd = wgid % NXCD, off = wgid / NXCD; wgid = (xcd < r ? xcd * (q + 1) : r * (q + 1) + (xcd - r) * q) + off; }
        const int nig = WGM * nN, gid = wgid / nig, fm = gid * WGM, gsz = (nM - fm) < WGM ? (nM - fm) : WGM;
        u.pm = fm + ((wgid % nig) % gsz); u.pn = (wgid % nig) / gsz; return true;
    }
    __device__ __forceinline__ void a_ready(const Unit&) const {}
    __device__ __forceinline__ void done(const Unit&) const {}
};
__device__ __forceinline__ unsigned cvt_pk_bf16(float lo, float hi) { unsigned r; asm volatile("v_cvt_pk_bf16_f32 %0, %1, %2" : "=v"(r) : "v"(lo), "v"(hi)); return r; }
typedef float f32x2 __attribute__((ext_vector_type(2)));
template <class Epi, class Sched, bool STAMP = false>
__device__ __forceinline__ void gemm_phase(int mk_tid, PG8_LAS unsigned char* lds, const Gemm g, const Sched& S, const Epi& E, unsigned long long* stamps) {
    const int tid = mk_tid, wid = __builtin_amdgcn_readfirstlane(tid >> 6), lane = tid & 63, wr = wid >> 2, wc = wid & 3, fr = lane & 15, fq = lane >> 4;
    const int K = g.K, nt = K / BK;
    int ts_lo = 0, ts_hi = 0, nts = 0; const unsigned long long rt_entry = STAMP ? (unsigned long long)wall_clock64() : 0ull;
#define PG8_STAMP() do { if (STAMP && wid == 0 && nts < 64) { const unsigned long long _c = (unsigned long long)clock64(); \
        ts_lo = (lane == nts) ? (int)(unsigned)_c : ts_lo; ts_hi = (lane == nts) ? (int)(unsigned)(_c >> 32) : ts_hi; ++nts; } } while (0)
    PG8_STAMP();
    unsigned voffA[2], voffB[2];
#pragma unroll
    for (int i = 0; i < 2; ++i) { int R, C; stage_rc(tid * 16 + i * 8192, R, C); const int Rb = E.perm ? ((R & ~31) + perm32(R & 31)) : R;
        voffA[i] = (unsigned)(R * K + C) * 2u; voffB[i] = (unsigned)(Rb * K + C) * 2u; }
    const size_t kstep = (size_t)(BK * 2);
    const size_t hstep = (size_t)HALF * K * 2;
    const size_t tstep = 2 * hstep;
    const unsigned ldsw = (unsigned)wid * 1024u;
    const int aoff = lds_byte(wr * 64 + fr, fq * 8), boff = lds_byte(wc * 32 + fr, fq * 8);
#define PG8_SA(b, h) (((b) * 2 + (h)) * HTB)
#define PG8_SB(b, h) ((4 + (b) * 2 + (h)) * HTB)
#define PG8_STAGE(bufoff, gbase, voff) do { _Pragma("unroll") for (int _i = 0; _i < 2; ++_i) \
        __builtin_amdgcn_global_load_lds((const unsigned*)((const char*)(gbase) + (voff)[_i]), (PG8_LAS unsigned*)(lds + (bufoff) + ldsw + _i * 8192), 16, 0, 0); } while (0)
#define PG8_LDA(dst, b, h) do { _Pragma("unroll") for (int m = 0; m < 4; ++m) _Pragma("unroll") for (int k = 0; k < 2; ++k) dst[m][k] = *(const PG8_LAS bf16x8*)(lds + PG8_SA(b, h) + aoff + m * 2048 + k * 1024); } while (0)
#define PG8_LDB(dst, b, h) do { _Pragma("unroll") for (int n = 0; n < 2; ++n) _Pragma("unroll") for (int k = 0; k < 2; ++k) dst[n][k] = *(const PG8_LAS bf16x8*)(lds + PG8_SB(b, h) + boff + n * 2048 + k * 1024); } while (0)
#define PG8_MMA(ai, bj, At, Bt) do { __builtin_amdgcn_s_setprio(1); _Pragma("unroll") for (int m = 0; m < 4; ++m) _Pragma("unroll") for (int n = 0; n < 2; ++n) _Pragma("unroll") for (int k = 0; k < 2; ++k) \
        acc[ai][bj][m][n] = __builtin_amdgcn_mfma_f32_16x16x32_bf16(Bt[n][k], At[m][k], acc[ai][bj][m][n], 0, 0, 0); __builtin_amdgcn_s_setprio(0); } while (0)
#define PG8_WAIT_V(n) asm volatile("s_waitcnt vmcnt(" #n ")" ::: "memory")
#define PG8_WAIT_L(n) asm volatile("s_waitcnt lgkmcnt(" #n ")" ::: "memory")
#define PG8_BAR __builtin_amdgcn_s_barrier()
#define PG8_SCHED __builtin_amdgcn_sched_barrier(0)
    Unit cur, nxt; int ui = 0;
    if (!S.next(0, cur)) return;
    f32x4 acc[2][2][4][2];
#pragma unroll
    for (int a = 0; a < 2; ++a)
#pragma unroll
        for (int b = 0; b < 2; ++b)
#pragma unroll
            for (int m = 0; m < 4; ++m)
#pragma unroll
                for (int n = 0; n < 2; ++n) acc[a][b][m][n] = (f32x4){0.f, 0.f, 0.f, 0.f};
    bf16x8 At[4][2], B0[2][2], B1[2][2];
    const char* cA = (const char*)g.A + (size_t)cur.pm * tstep; const char* cB = (const char*)g.Bt + (size_t)cur.pn * tstep;
    S.a_ready(cur);
    PG8_STAGE(PG8_SB(0, 0), cB, voffB); PG8_STAGE(PG8_SA(0, 0), cA, voffA); PG8_STAGE(PG8_SB(0, 1), cB + hstep, voffB); PG8_STAGE(PG8_SA(0, 1), cA + hstep, voffA);
    if (wr == 1) PG8_BAR;
    PG8_WAIT_V(4); PG8_BAR;
    PG8_STAGE(PG8_SB(1, 0), cB + kstep, voffB); PG8_STAGE(PG8_SA(1, 0), cA + kstep, voffA); PG8_STAGE(PG8_SB(1, 1), cB + hstep + kstep, voffB);
    PG8_WAIT_V(6); PG8_BAR;
    PG8_STAMP();
    for (;;) {
        const bool has_next = S.next(ui + 1, nxt);
        const char* nA = has_next ? (const char*)g.A + (size_t)nxt.pm * tstep : cA; const char* nB = has_next ? (const char*)g.Bt + (size_t)nxt.pn * tstep : cB;
        for (int t = 0; t < nt; t += 2) {
            const bool last = (t == nt - 2);
            const char* a1 = cA + (size_t)(t + 1) * kstep;
            const char* a2 = last ? nA : cA + (size_t)(t + 2) * kstep; const char* b2 = last ? nB : cB + (size_t)(t + 2) * kstep;
            const char* a3 = a2 + kstep; const char* b3 = b2 + kstep;
            if (last && has_next) S.a_ready(nxt);
            PG8_LDB(B0, 0, 0); PG8_SCHED; PG8_LDA(At, 0, 0); PG8_STAGE(PG8_SA(1, 1), a1 + hstep, voffA);
            PG8_WAIT_L(8); PG8_BAR; PG8_WAIT_L(0); PG8_MMA(0, 0, At, B0); PG8_BAR; PG8_SCHED;
            PG8_LDB(B1, 0, 1); PG8_STAGE(PG8_SB(0, 0), b2, voffB);
            PG8_BAR; PG8_WAIT_L(0); PG8_MMA(0, 1, At, B1); PG8_BAR;
            PG8_LDA(At, 0, 1); PG8_STAGE(PG8_SA(0, 0), a2, voffA);
            PG8_BAR; PG8_WAIT_L(0); PG8_MMA(1, 0, At, B0); PG8_BAR; PG8_SCHED;
            PG8_STAGE(PG8_SB(0, 1), b2 + hstep, voffB);
            PG8_WAIT_V(6); PG8_BAR; PG8_MMA(1, 1, At, B1); PG8_BAR;
            PG8_LDB(B0, 1, 0); PG8_SCHED; PG8_LDA(At, 1, 0); PG8_STAGE(PG8_SA(0, 1), a2 + hstep, voffA);
            PG8_WAIT_L(8); PG8_BAR; PG8_WAIT_L(0); PG8_MMA(0, 0, At, B0); PG8_BAR; PG8_SCHED;
            PG8_LDB(B1, 1, 1); PG8_STAGE(PG8_SB(1, 0), b3, voffB);
            PG8_BAR; PG8_WAIT_L(0); PG8_MMA(0, 1, At, B1); PG8_BAR;
            PG8_LDA(At, 1, 1); PG8_STAGE(PG8_SA(1, 0), a3, voffA);
            PG8_BAR; PG8_WAIT_L(0); PG8_MMA(1, 0, At, B0); PG8_BAR; PG8_SCHED;
            PG8_STAGE(PG8_SB(1, 1), b3 + hstep, voffB);
            PG8_WAIT_V(6); PG8_BAR; PG8_MMA(1, 1, At, B1); PG8_BAR;
        }
        PG8_STAMP();
        if constexpr (!Epi::AFTER_DRAIN) { E(acc, cur, wr, wc, fr, fq); S.done(cur); }
        PG8_STAMP();
        if (!has_next) break;
#pragma unroll
        for (int a = 0; a < 2; ++a)
#pragma unroll
            for (int b = 0; b < 2; ++b)
#pragma unroll
                for (int m = 0; m < 4; ++m)
#pragma unroll
                    for (int n = 0; n < 2; ++n) acc[a][b][m][n] = (f32x4){0.f, 0.f, 0.f, 0.f};
        cur = nxt; cA = nA; cB = nB; ++ui;
    }
    PG8_WAIT_V(0);
    if (wr == 0) PG8_BAR;
    PG8_BAR;

    if constexpr (Epi::AFTER_DRAIN) { E.fused(acc, cur, wr, wc, fr, fq, lds, wid, lane); }
    PG8_STAMP();
    if (STAMP && wid == 0) { stamps[lane] = lane < nts ? (((unsigned long long)(unsigned)ts_hi << 32) | (unsigned)ts_lo) : 0ull;
        if (lane == 62) stamps[62] = rt_entry; if (lane == 63) stamps[63] = (unsigned long long)wall_clock64(); }
#undef PG8_STAMP
#undef PG8_SA
#undef PG8_SB
#undef PG8_STAGE
#undef PG8_LDA
#undef PG8_LDB
#undef PG8_MMA
#undef PG8_WAIT_V
#undef PG8_WAIT_L
#undef PG8_BAR
#undef PG8_SCHED
}
}

using namespace pg8;
#define DI __device__ __forceinline__
#define LAS PG8_LAS
typedef unsigned short u16;
typedef unsigned u32x2 __attribute__((ext_vector_type(2)));
typedef short s16x4 __attribute__((ext_vector_type(4)));

constexpr int T = 16384, SEQ = 2048;
constexpr int LDS_BYTES = 147456;
constexpr size_t U = (size_t)T * 1024 * 2;
constexpr size_t WS_WT = 7 * U;
constexpr size_t WS_MEMN = WS_WT + (size_t)14336 * 2048;
constexpr size_t WS_SS = WS_MEMN + 4194304;
constexpr size_t WS_SSP = WS_SS + (size_t)7 * T * 4;
constexpr size_t WS_CNT = WS_SSP + (size_t)T * 16 * 4;
constexpr size_t WS_IFG = WS_CNT + 4096;
constexpr size_t WS_GZ = WS_IFG + (size_t)T * 8 * 4;
constexpr size_t WS_GM = WS_GZ + 262144;
constexpr size_t WS_GE = WS_GM + 262144;
constexpr size_t WS_GMS = WS_GE + 262144;
constexpr size_t WS_GML = WS_GMS + 2048;
constexpr size_t WS_NVEC = WS_GML + 2048;
constexpr size_t WS_GW = WS_NVEC + 524288;
constexpr size_t WS_SUMA = WS_GW + 262144;
constexpr size_t WS_SUMH = WS_SUMA + 524288;
constexpr size_t WS_BAR = WS_SUMH + 524288;
constexpr size_t WS_HBQ = WS_BAR + 16384;
constexpr size_t WS_END = WS_HBQ + (size_t)64 * 6 * 2048 * 4;
enum { S_GQK = 0, S_STATE, S_OUT, S_GXR, S_RG0, S_RG1, S_GAB, S_GMIX, S_GQKV, S_ATT, S_GWO, S_GUP, S_GDOWN, PL };
constexpr int NPH = 2 * PL + 2;
#ifndef PROBE_DUP
#define PROBE_DUP 0
#endif

struct Args { const float* in[29]; float* out; unsigned char* ws; int ph_lo, ph_hi; };

DI float bf2f(u16 v) { return __uint_as_float(((unsigned)v) << 16); }
DI float bflo(unsigned v) { return __uint_as_float(v << 16); }
DI float bfhi(unsigned v) { return __uint_as_float(v & 0xffff0000u); }
DI u16 f2bf(float f) { unsigned r; asm("v_cvt_pk_bf16_f32 %0, %1, %1" : "=v"(r) : "v"(f)); return (u16)r; }
DI unsigned pk2(float lo, float hi) { unsigned r; asm("v_cvt_pk_bf16_f32 %0, %1, %2" : "=v"(r) : "v"(lo), "v"(hi)); return r; }
DI float sigm(float x) { return __builtin_amdgcn_rcpf(1.f + __expf(-x)); }
DI float gelu_t(float x) { const float u = 1.5957691216f * (x + 0.044715f * x * x * x); return x * __builtin_amdgcn_rcpf(1.f + __expf(-u)); }
DI float wsum(float v) { v += __shfl_xor(v, 1); v += __shfl_xor(v, 2); v += __shfl_xor(v, 4); v += __shfl_xor(v, 8); v += __shfl_xor(v, 16); v += __shfl_xor(v, 32); return v; }
DI void unpack8(const u32x4 r, float* f) { f[0] = bflo(r.x); f[1] = bfhi(r.x); f[2] = bflo(r.y); f[3] = bfhi(r.y); f[4] = bflo(r.z); f[5] = bfhi(r.z); f[6] = bflo(r.w); f[7] = bfhi(r.w); }
DI f32x4 mfma16(bf16x8 a, bf16x8 b, f32x4 c) { return __builtin_amdgcn_mfma_f32_16x16x32_bf16(a, b, c, 0, 0, 0); }

struct UE {
    static constexpr bool AFTER_DRAIN = false;
    int perm, kind; u16* O; int ldc, split; const u16* gate; float* F; const float* Fin; const float* ss; int smode; u16* HBo; float* sso; float* ssp; unsigned* cnt; int rflags;
    DI void operator()(const f32x4 (&acc)[2][2][4][2], const Unit& u, int wr, int wc, int fr, int fq) const {
        const int row0 = u.pm * 256 + wr * 64 + fr;
        if (kind == 4) return;
        const int col0 = u.pn * 256 + wc * 32 + 8 * fq;
        if (kind == 0) {
            float rs[2][4]; f32x4 cf[2][2];
#pragma unroll
            for (int ai = 0; ai < 2; ++ai)
#pragma unroll
                for (int m = 0; m < 4; ++m) rs[ai][m] = (smode == 1) ? ss[row0 + ai * 128 + m * 16] : 1024.f - 1e-6f * 1024.f;
#pragma unroll
            for (int bj = 0; bj < 2; ++bj)
#pragma unroll
                for (int n = 0; n < 2; ++n) cf[bj][n] = (smode == 2) ? *(const f32x4*)(ss + col0 + bj * 128 + n * 4) : (f32x4){1024.f - 1e-6f * 1024.f, 1024.f - 1e-6f * 1024.f, 1024.f - 1e-6f * 1024.f, 1024.f - 1e-6f * 1024.f};
#pragma unroll
            for (int ai = 0; ai < 2; ++ai)
#pragma unroll
                for (int m = 0; m < 4; ++m) rs[ai][m] = rsqrtf(rs[ai][m] * (1.f / 1024.f) + 1e-6f);
#pragma unroll
            for (int bj = 0; bj < 2; ++bj)
#pragma unroll
                for (int n = 0; n < 2; ++n)
#pragma unroll
                    for (int j = 0; j < 4; ++j) cf[bj][n][j] = rsqrtf(cf[bj][n][j] * (1.f / 1024.f) + 1e-6f);
            __builtin_amdgcn_sched_barrier(0);
#pragma unroll
            for (int ai = 0; ai < 2; ++ai)
#pragma unroll
                for (int m = 0; m < 4; ++m) { const int row = row0 + ai * 128 + m * 16;
#pragma unroll
                    for (int bj = 0; bj < 2; ++bj) { const int col = col0 + bj * 128;
                        u16* p = split ? O + (size_t)(col >> 10) * ((size_t)T * 1024) + (size_t)row * 1024 + (col & 1023) : O + (size_t)row * ldc + col;
                        const f32x4 v0 = acc[ai][bj][m][0] * rs[ai][m] * cf[bj][0], v1 = acc[ai][bj][m][1] * rs[ai][m] * cf[bj][1];
                        u32x4 w; w.x = cvt_pk_bf16(v0[0], v0[1]); w.y = cvt_pk_bf16(v0[2], v0[3]); w.z = cvt_pk_bf16(v1[0], v1[1]); w.w = cvt_pk_bf16(v1[2], v1[3]);
                        *(u32x4*)p = w; } }
        } else {
#pragma unroll
            for (int aim = 0; aim < 4; ++aim) { const int ai = aim >> 1, mb = (aim & 1) * 2;
                f32x4 ld[4][2][2];
#pragma unroll
                for (int m = mb; m < mb + 2; ++m)
#pragma unroll
                    for (int bj = 0; bj < 2; ++bj) { const size_t idx = (size_t)(row0 + ai * 128 + m * 16) * 1024 + col0 + bj * 128;
                        if (kind == 3) { if (rflags & 1) { ld[m][bj][0] = *(const f32x4*)((const u16*)Fin + idx); ld[m][bj][1] = (f32x4){0.f, 0.f, 0.f, 0.f}; } else { ld[m][bj][0] = *(const f32x4*)(Fin + idx); ld[m][bj][1] = *(const f32x4*)(Fin + idx + 4); } }
                        else { ld[m][bj][0] = *(const f32x4*)(gate + idx); ld[m][bj][1] = (kind == 2) ? *(const f32x4*)((const u16*)Fin + idx) : (f32x4){0.f, 0.f, 0.f, 0.f}; } }
                __builtin_amdgcn_sched_barrier(0);
#pragma unroll
                for (int m = mb; m < mb + 2; ++m) { const int row = row0 + ai * 128 + m * 16; float psq = 0.f;
#pragma unroll
                    for (int bj = 0; bj < 2; ++bj) { const size_t idx = (size_t)row * 1024 + col0 + bj * 128; const f32x4 v0 = acc[ai][bj][m][0], v1 = acc[ai][bj][m][1];
                        if (kind == 3) { f32x4 b0 = ld[m][bj][0], b1 = ld[m][bj][1];
                            if (rflags & 1) { const u32x4 rb = __builtin_bit_cast(u32x4, ld[m][bj][0]); b0 = (f32x4){bflo(rb.x), bfhi(rb.x), bflo(rb.y), bfhi(rb.y)}; b1 = (f32x4){bflo(rb.z), bfhi(rb.z), bflo(rb.w), bfhi(rb.w)}; }
                            const f32x4 h0 = b0 + v0, h1 = b1 + v1; if (rflags & 2) { *(f32x4*)(F + idx) = h0; *(f32x4*)(F + idx + 4) = h1; }
                            u32x4 hw; hw.x = cvt_pk_bf16(h0[0], h0[1]); hw.y = cvt_pk_bf16(h0[2], h0[3]); hw.z = cvt_pk_bf16(h1[0], h1[1]); hw.w = cvt_pk_bf16(h1[2], h1[3]); *(u32x4*)(HBo + idx) = hw;
                            psq += (h0[0] * h0[0] + h0[1] * h0[1]) + (h0[2] * h0[2] + h0[3] * h0[3]) + (h1[0] * h1[0] + h1[1] * h1[1]) + (h1[2] * h1[2] + h1[3] * h1[3]); }
                        else { const u32x4 gr = __builtin_bit_cast(u32x4, ld[m][bj][0]);
                            f32x4 s0, s1; s0[0] = sigm(bflo(gr.x)); s0[1] = sigm(bfhi(gr.x)); s0[2] = sigm(bflo(gr.y)); s0[3] = sigm(bfhi(gr.y)); s1[0] = sigm(bflo(gr.z)); s1[1] = sigm(bfhi(gr.z)); s1[2] = sigm(bflo(gr.w)); s1[3] = sigm(bfhi(gr.w));
                            f32x4 r0 = s0 * v0, r1 = s1 * v1;
                            if (kind == 2) { const u32x4 yb = __builtin_bit_cast(u32x4, ld[m][bj][1]);
                                r0[0] += bflo(yb.x); r0[1] += bfhi(yb.x); r0[2] += bflo(yb.y); r0[3] += bfhi(yb.y); r1[0] += bflo(yb.z); r1[1] += bfhi(yb.z); r1[2] += bflo(yb.w); r1[3] += bfhi(yb.w); }
                            u32x4 w; w.x = cvt_pk_bf16(r0[0], r0[1]); w.y = cvt_pk_bf16(r0[2], r0[3]); w.z = cvt_pk_bf16(r1[0], r1[1]); w.w = cvt_pk_bf16(r1[2], r1[3]);
                            *(u32x4*)(O + idx) = w; } }
                    if (kind == 3) { psq += __shfl_xor(psq, 16); psq += __shfl_xor(psq, 32); if (fq == 0) __hip_atomic_store(ssp + (size_t)row * 16 + u.pn * 4 + wc, psq, __ATOMIC_RELAXED, __HIP_MEMORY_SCOPE_AGENT); } }
                __builtin_amdgcn_sched_barrier(0);
            }
            if (kind == 3) {
                asm volatile("s_waitcnt vmcnt(0)" ::: "memory");
                const int lane = fq * 16 + fr; unsigned old = 0u;
                if (lane == 0) old = __hip_atomic_fetch_add(cnt + u.pm, 1u, __ATOMIC_RELAXED, __HIP_MEMORY_SCOPE_AGENT);
                old = (unsigned)__builtin_amdgcn_readfirstlane((int)old);
                if (old == 31u) {
                    for (int r = lane; r < 256; r += 64) { const size_t row = (size_t)u.pm * 256 + r; float t = 0.f;
#pragma unroll 4
                        for (int k = 0; k < 16; ++k) t += __hip_atomic_load(ssp + row * 16 + k, __ATOMIC_RELAXED, __HIP_MEMORY_SCOPE_AGENT);
                        sso[row] = t; } }
            }
        }
    }
};
struct UE3 {
    static constexpr bool AFTER_DRAIN = true;
    int perm; const float* Fin; float* F; u16* HBo; u16* HB2; float* sso; float* ssp; unsigned* cnt; int rflags;
    DI void operator()(const f32x4 (&)[2][2][4][2], const Unit&, int, int, int, int) const {}
    DI void fused(const f32x4 (&acc)[2][2][4][2], const Unit& u, int wr, int wc, int fr, int fq, LAS unsigned char* lds, int wid, int lane) const {
        LAS float* P = (LAS float*)lds;
        LAS unsigned* flag = (LAS unsigned*)(lds + 8192);
        const int tid = wid * 64 + lane, row0 = u.pm * 256 + wr * 64 + fr, col0 = u.pn * 256 + wc * 32 + 8 * fq;
#pragma unroll
        for (int aim = 0; aim < 4; ++aim) { const int ai = aim >> 1, mb = (aim & 1) * 2;
            f32x4 ld[4][2][2];
#pragma unroll
            for (int m = mb; m < mb + 2; ++m)
#pragma unroll
                for (int bj = 0; bj < 2; ++bj) { const size_t idx = (size_t)(row0 + ai * 128 + m * 16) * 1024 + col0 + bj * 128;
                    if (rflags & 1) { ld[m][bj][0] = *(const f32x4*)((const u16*)Fin + idx); ld[m][bj][1] = (f32x4){0.f, 0.f, 0.f, 0.f}; } else { ld[m][bj][0] = *(const f32x4*)(Fin + idx); ld[m][bj][1] = *(const f32x4*)(Fin + idx + 4); } }
            __builtin_amdgcn_sched_barrier(0);
#pragma unroll
            for (int m = mb; m < mb + 2; ++m) { const int row = row0 + ai * 128 + m * 16; float psq = 0.f;
#pragma unroll
                for (int bj = 0; bj < 2; ++bj) { const size_t idx = (size_t)row * 1024 + col0 + bj * 128; const f32x4 v0 = acc[ai][bj][m][0], v1 = acc[ai][bj][m][1];
                    f32x4 b0 = ld[m][bj][0], b1 = ld[m][bj][1];
                    if (rflags & 1) { const u32x4 rb = __builtin_bit_cast(u32x4, ld[m][bj][0]); b0 = (f32x4){bflo(rb.x), bfhi(rb.x), bflo(rb.y), bfhi(rb.y)}; b1 = (f32x4){bflo(rb.z), bfhi(rb.z), bflo(rb.w), bfhi(rb.w)}; }
                    const f32x4 h0 = b0 + v0, h1 = b1 + v1; if (rflags & 2) { *(f32x4*)(F + idx) = h0; *(f32x4*)(F + idx + 4) = h1; }
                    u32x4 hw; hw.x = cvt_pk_bf16(h0[0], h0[1]); hw.y = cvt_pk_bf16(h0[2], h0[3]); hw.z = cvt_pk_bf16(h1[0], h1[1]); hw.w = cvt_pk_bf16(h1[2], h1[3]); *(u32x4*)(HBo + idx) = hw; if (HB2) *(u32x4*)(HB2 + idx) = hw;
                    psq += (h0[0] * h0[0] + h0[1] * h0[1]) + (h0[2] * h0[2] + h0[3] * h0[3]) + (h1[0] * h1[0] + h1[1] * h1[1]) + (h1[2] * h1[2] + h1[3] * h1[3]); }
                psq += __shfl_xor(psq, 16); psq += __shfl_xor(psq, 32);
                if (fq == 0) P[(ai * 128 + wr * 64 + m * 16 + fr) * 4 + wc] = psq; }
            __builtin_amdgcn_sched_barrier(0);
        }
        __syncthreads();
        if (tid < 256) { const float t = (P[tid * 4] + P[tid * 4 + 1]) + (P[tid * 4 + 2] + P[tid * 4 + 3]); __hip_atomic_store(ssp + ((size_t)u.pm * 256 + tid) * 4 + u.pn, t, __ATOMIC_RELAXED, __HIP_MEMORY_SCOPE_AGENT); }
        asm volatile("s_waitcnt vmcnt(0)" ::: "memory");
        __syncthreads();
        if (tid == 0) flag[0] = __hip_atomic_fetch_add(cnt + u.pm, 1u, __ATOMIC_RELAXED, __HIP_MEMORY_SCOPE_AGENT);
        __syncthreads();
        if (flag[0] == 3u && tid < 256) { const size_t row = (size_t)u.pm * 256 + tid;
            const float t0 = __hip_atomic_load(ssp + row * 4, __ATOMIC_RELAXED, __HIP_MEMORY_SCOPE_AGENT), t1 = __hip_atomic_load(ssp + row * 4 + 1, __ATOMIC_RELAXED, __HIP_MEMORY_SCOPE_AGENT),
                        t2 = __hip_atomic_load(ssp + row * 4 + 2, __ATOMIC_RELAXED, __HIP_MEMORY_SCOPE_AGENT), t3 = __hip_atomic_load(ssp + row * 4 + 3, __ATOMIC_RELAXED, __HIP_MEMORY_SCOPE_AGENT);
            sso[row] = (t0 + t1) + (t2 + t3); }
        __syncthreads();
    }
};
struct OneUnit { Unit u; DI bool next(int i, Unit& o) const { if (i != 0) return false; o = u; return true; } DI void a_ready(const Unit&) const {} DI void done(const Unit&) const {} };
struct UE5 {
    static constexpr bool AFTER_DRAIN = true;
    int perm; u16* act; float* HB; const float* cw; const float* cb; const float* ss;
    DI void operator()(const f32x4 (&)[2][2][4][2], const Unit&, int, int, int, int) const {}
    DI void fused(const f32x4 (&acc)[2][2][4][2], const Unit& u, int wr, int wc, int fr, int fq, LAS unsigned char* lds, int wid, int lane) const {
        LAS float* tl = (LAS float*)lds;
        LAS float* side = (LAS float*)(lds + 133120);
        const int tid = wid * 64 + lane, q = tid & 31, rsub = tid >> 5, ch = u.pn * 128 + q * 4;
        const f32x4 g0 = *(const f32x4*)(cw + ch), g1 = *(const f32x4*)(cw + 6144 + ch), g2 = *(const f32x4*)(cw + 12288 + ch), gb = *(const f32x4*)(cb + ch);
        const f32x4 u0 = *(const f32x4*)(cw + 3072 + ch), u1 = *(const f32x4*)(cw + 6144 + 3072 + ch), u2 = *(const f32x4*)(cw + 12288 + 3072 + ch), ub = *(const f32x4*)(cb + 3072 + ch);
#pragma unroll
        for (int ai = 0; ai < 2; ++ai) {
            if (ai == 1) {
                __syncthreads();
            }
#pragma unroll
            for (int m = 0; m < 4; ++m) { const float rs = rsqrtf(ss[u.pm * 256 + ai * 128 + wr * 64 + m * 16 + fr] * (1.f / 1024.f) + 1e-6f);
#pragma unroll
                for (int bj = 0; bj < 2; ++bj)
#pragma unroll
                    for (int n = 0; n < 2; ++n) *(LAS f32x4*)(tl + (wr * 64 + m * 16 + fr) * 260 + bj * 128 + wc * 32 + n * 16 + 4 * fq) = acc[ai][bj][m][n] * rs; }
            __syncthreads();
            if (ai == 0) {
                if (tid < 128) { const int rr = tid >> 6, cq = tid & 63; const f32x4 v = *(const LAS f32x4*)(tl + rr * 260 + cq * 4);
                    *(f32x4*)(HB + ((size_t)u.pm * 4 + rr) * 6144 + (cq < 32 ? u.pn * 128 + cq * 4 : 3072 + u.pn * 128 + (cq - 32) * 4)) = v; }
            } else {
                if (tid < 128) { const int rr = tid >> 6, cq = tid & 63; const f32x4 v = *(const LAS f32x4*)(tl + (126 + rr) * 260 + cq * 4);
                    *(f32x4*)(HB + ((size_t)u.pm * 4 + 2 + rr) * 6144 + (cq < 32 ? u.pn * 128 + cq * 4 : 3072 + u.pn * 128 + (cq - 32) * 4)) = v; }
            }
#pragma unroll 2
            for (int it = 0; it < 8; ++it) {
                const int row = it * 16 + rsub;
                const f32x4 xg = *(const LAS f32x4*)(tl + row * 260 + q * 4), xu = *(const LAS f32x4*)(tl + row * 260 + 128 + q * 4);
                f32x4 p1g, p1u, p2g, p2u; bool ok = true;
                if (row >= 2) { p1g = *(const LAS f32x4*)(tl + (row - 1) * 260 + q * 4); p1u = *(const LAS f32x4*)(tl + (row - 1) * 260 + 128 + q * 4); p2g = *(const LAS f32x4*)(tl + (row - 2) * 260 + q * 4); p2u = *(const LAS f32x4*)(tl + (row - 2) * 260 + 128 + q * 4); }
                else if (ai == 1) {
                    if (row == 1) { p1g = *(const LAS f32x4*)(tl + q * 4); p1u = *(const LAS f32x4*)(tl + 128 + q * 4); p2g = *(const LAS f32x4*)(side + 260 + q * 4); p2u = *(const LAS f32x4*)(side + 260 + 128 + q * 4); }
                    else { p1g = *(const LAS f32x4*)(side + 260 + q * 4); p1u = *(const LAS f32x4*)(side + 260 + 128 + q * 4); p2g = *(const LAS f32x4*)(side + q * 4); p2u = *(const LAS f32x4*)(side + 128 + q * 4); }
                } else { ok = false; p1g = xg; p1u = xu; p2g = xg; p2u = xu; }
                const f32x4 gv = gb + g0 * p2g + g1 * p1g + g2 * xg, uv = ub + u0 * p2u + u1 * p1u + u2 * xu;
                if (ok) { u32x2 w; w.x = cvt_pk_bf16(gelu_t(gv[0]) * uv[0], gelu_t(gv[1]) * uv[1]); w.y = cvt_pk_bf16(gelu_t(gv[2]) * uv[2], gelu_t(gv[3]) * uv[3]);
                    *(u32x2*)(act + ((size_t)u.pm * 256 + ai * 128 + row) * 3072 + ch) = w; }
            }
            if (ai == 0) {
                if (tid < 128) { const int rr = tid >> 6, cq = tid & 63; *(LAS f32x4*)(side + rr * 260 + cq * 4) = *(const LAS f32x4*)(tl + (126 + rr) * 260 + cq * 4); }
            }
        }
        __syncthreads();
    }
};
DI void ffn_fix_tile(int mk_tid, const float* HB, const float* cw, const float* cb, u16* act, int pm) {
    for (int item = mk_tid; item < 2 * 768; item += 512) {
        const int cq = item % 768, j = item / 768, ch = cq * 4; const bool hp = (pm & 7) != 0;
        const f32x4 z4 = (f32x4){0.f, 0.f, 0.f, 0.f};
        const float* cur = HB + ((size_t)pm * 4 + j) * 6144 + ch; const float* f0 = HB + ((size_t)pm * 4) * 6144 + ch;
        const float* l0 = HB + ((size_t)(pm - 1) * 4 + 2) * 6144 + ch; const float* l1 = HB + ((size_t)(pm - 1) * 4 + 3) * 6144 + ch;
        const f32x4 xg = *(const f32x4*)cur, xu = *(const f32x4*)(cur + 3072);
        f32x4 p1g, p1u, p2g, p2u;
        if (j == 1) { p1g = *(const f32x4*)f0; p1u = *(const f32x4*)(f0 + 3072); p2g = hp ? *(const f32x4*)l1 : z4; p2u = hp ? *(const f32x4*)(l1 + 3072) : z4; }
        else { p1g = hp ? *(const f32x4*)l1 : z4; p1u = hp ? *(const f32x4*)(l1 + 3072) : z4; p2g = hp ? *(const f32x4*)l0 : z4; p2u = hp ? *(const f32x4*)(l0 + 3072) : z4; }
        const f32x4 wg0 = *(const f32x4*)(cw + ch), wg1 = *(const f32x4*)(cw + 6144 + ch), wg2 = *(const f32x4*)(cw + 12288 + ch), bg = *(const f32x4*)(cb + ch);
        const f32x4 wu0 = *(const f32x4*)(cw + 3072 + ch), wu1 = *(const f32x4*)(cw + 6144 + 3072 + ch), wu2 = *(const f32x4*)(cw + 12288 + 3072 + ch), bu = *(const f32x4*)(cb + 3072 + ch);
        const f32x4 gv = bg + wg0 * p2g + wg1 * p1g + wg2 * xg, uv = bu + wu0 * p2u + wu1 * p1u + wu2 * xu;
        u32x2 w; w.x = pk2(gelu_t(gv[0]) * uv[0], gelu_t(gv[1]) * uv[1]); w.y = pk2(gelu_t(gv[2]) * uv[2], gelu_t(gv[3]) * uv[3]);
        *(u32x2*)(act + ((size_t)pm * 256 + j) * 3072 + ch) = w;
    }
}

struct UE6 {
    static constexpr bool AFTER_DRAIN = true;
    int perm; u16* qc; u16* kc; float* HB; const float* cw; const float* cb; const float* ss;
    DI void operator()(const f32x4 (&)[2][2][4][2], const Unit&, int, int, int, int) const {}
    DI void fused(const f32x4 (&acc)[2][2][4][2], const Unit& u, int wr, int wc, int fr, int fq, LAS unsigned char* lds, int wid, int lane) const {
        LAS float* tl = (LAS float*)lds;
        LAS float* side = (LAS float*)(lds + 133120);
        const int tid = wid * 64 + lane, q = tid & 63, rsub = tid >> 6, ch = u.pn * 256 + q * 4;
        const f32x4 w0 = *(const f32x4*)(cw + ch), w1 = *(const f32x4*)(cw + 2048 + ch), w2 = *(const f32x4*)(cw + 4096 + ch), w3 = *(const f32x4*)(cw + 6144 + ch), bb = *(const f32x4*)(cb + ch);
        u16* dst = (ch < 1024) ? qc + ch : kc + (ch - 1024); const float sc = (ch < 1024) ? 1.f : 0.0625f;
#pragma unroll
        for (int ai = 0; ai < 2; ++ai) {
            if (ai == 1) __syncthreads();
#pragma unroll
            for (int m = 0; m < 4; ++m) { const float rs = rsqrtf(ss[u.pm * 256 + ai * 128 + wr * 64 + m * 16 + fr] * (1.f / 1024.f) + 1e-6f);
#pragma unroll
                for (int bj = 0; bj < 2; ++bj)
#pragma unroll
                    for (int n = 0; n < 2; ++n) *(LAS f32x4*)(tl + (wr * 64 + m * 16 + fr) * 260 + bj * 128 + wc * 32 + n * 16 + 4 * fq) = acc[ai][bj][m][n] * rs; }
            __syncthreads();
            if (tid < 192) { const int rr = tid >> 6, cq = tid & 63; const f32x4 v = *(const LAS f32x4*)(tl + ((ai == 0 ? 0 : 125) + rr) * 260 + cq * 4);
                *(f32x4*)(HB + ((size_t)u.pm * 6 + (ai == 0 ? 0 : 3) + rr) * 2048 + u.pn * 256 + cq * 4) = v; }
#pragma unroll 2
            for (int it = 0; it < 16; ++it) {
                const int row = it * 8 + rsub;
                const f32x4 x = *(const LAS f32x4*)(tl + row * 260 + q * 4);
                f32x4 p1, p2, p3; bool ok = true;
                if (row >= 3) { p1 = *(const LAS f32x4*)(tl + (row - 1) * 260 + q * 4); p2 = *(const LAS f32x4*)(tl + (row - 2) * 260 + q * 4); p3 = *(const LAS f32x4*)(tl + (row - 3) * 260 + q * 4); }
                else if (ai == 1) {
                    p1 = (row >= 1) ? *(const LAS f32x4*)(tl + (row - 1) * 260 + q * 4) : *(const LAS f32x4*)(side + 2 * 260 + q * 4);
                    p2 = (row >= 2) ? *(const LAS f32x4*)(tl + (row - 2) * 260 + q * 4) : *(const LAS f32x4*)(side + (1 + row) * 260 + q * 4);
                    p3 = *(const LAS f32x4*)(side + row * 260 + q * 4);
                } else { ok = false; p1 = x; p2 = x; p3 = x; }
                const f32x4 v = bb + w0 * p3 + w1 * p2 + w2 * p1 + w3 * x;
                if (ok) { u32x2 w; w.x = cvt_pk_bf16(sc * v[0] * sigm(v[0]), sc * v[1] * sigm(v[1])); w.y = cvt_pk_bf16(sc * v[2] * sigm(v[2]), sc * v[3] * sigm(v[3]));
                    *(u32x2*)(dst + ((size_t)u.pm * 256 + ai * 128 + row) * 1024) = w; }
            }
            if (ai == 0) { if (tid < 192) { const int rr = tid >> 6, cq = tid & 63; *(LAS f32x4*)(side + rr * 260 + cq * 4) = *(const LAS f32x4*)(tl + (125 + rr) * 260 + cq * 4); } }
        }
        __syncthreads();
    }
};
DI void qk_fix_local(int mk_tid, const float* HB, const float* cw, const float* cb, u16* dst, int chg, int pm0, int npm) {
    for (int item = mk_tid; item < npm * 3 * 64; item += 512) {
        const int cq = item & 63, rr = item >> 6, pmi = rr / 3, j = rr - pmi * 3, pm = pm0 + pmi, ch = chg + cq * 4; const bool hp = (pm & 7) != 0;
        const f32x4 z4 = (f32x4){0.f, 0.f, 0.f, 0.f};
        const float* me = HB + (size_t)pm * 6 * 2048 + ch; const float* pv = HB + (size_t)(pm - 1) * 6 * 2048 + ch;
        const f32x4 x = *(const f32x4*)(me + j * 2048);
        f32x4 p[3];
#pragma unroll
        for (int k = 1; k <= 3; ++k) { const int r = j - k; p[k - 1] = (r >= 0) ? *(const f32x4*)(me + r * 2048) : (hp ? *(const f32x4*)(pv + (6 + r) * 2048) : z4); }
        const f32x4 w0 = *(const f32x4*)(cw + ch), w1 = *(const f32x4*)(cw + 2048 + ch), w2 = *(const f32x4*)(cw + 4096 + ch), w3 = *(const f32x4*)(cw + 6144 + ch), bb = *(const f32x4*)(cb + ch);
        const f32x4 v = bb + w0 * p[2] + w1 * p[1] + w2 * p[0] + w3 * x;
        const float sc = (ch < 1024) ? 1.f : 0.0625f;
        u32x2 w; w.x = pk2(sc * v[0] * sigm(v[0]), sc * v[1] * sigm(v[1])); w.y = pk2(sc * v[2] * sigm(v[2]), sc * v[3] * sigm(v[3]));
        *(u32x2*)(dst + ((size_t)pm * 256 + j) * 1024 + (ch & 1023)) = w;
    }
}
DI void qk_fix_phase(int mk_tid, const float* HB, const float* cw, const float* cb, u16* qc, u16* kc) {
    const int gtid = blockIdx.x * 512 + mk_tid, nth = gridDim.x * 512;
    for (int item = gtid; item < 192 * 512; item += nth) {
        const int cq = item & 511, rr = item >> 9, pm = rr / 3, j = rr - pm * 3, ch = cq * 4; const bool hp = (pm & 7) != 0;
        const f32x4 z4 = (f32x4){0.f, 0.f, 0.f, 0.f};
        const float* me = HB + (size_t)pm * 6 * 2048 + ch; const float* pv = HB + (size_t)(pm - 1) * 6 * 2048 + ch;
        const f32x4 x = *(const f32x4*)(me + j * 2048);
        f32x4 p[3];
#pragma unroll
        for (int k = 1; k <= 3; ++k) { const int r = j - k; p[k - 1] = (r >= 0) ? *(const f32x4*)(me + r * 2048) : (hp ? *(const f32x4*)(pv + (6 + r) * 2048) : z4); }
        const f32x4 w0 = *(const f32x4*)(cw + ch), w1 = *(const f32x4*)(cw + 2048 + ch), w2 = *(const f32x4*)(cw + 4096 + ch), w3 = *(const f32x4*)(cw + 6144 + ch), bb = *(const f32x4*)(cb + ch);
        const f32x4 v = bb + w0 * p[2] + w1 * p[1] + w2 * p[0] + w3 * x;
        u16* dst = (ch < 1024) ? qc + ch : kc + (ch - 1024); const float sc = (ch < 1024) ? 1.f : 0.0625f;
        u32x2 w; w.x = pk2(sc * v[0] * sigm(v[0]), sc * v[1] * sigm(v[1])); w.y = pk2(sc * v[2] * sigm(v[2]), sc * v[3] * sigm(v[3]));
        *(u32x2*)(dst + ((size_t)pm * 256 + j) * 1024) = w;
    }
}

struct GD { const u16* A; const u16* Bt; int M, N, K, cshift; UE e; };

DI void cvt_w(int mk_tid, LAS unsigned char* lds, const float* W, int ldw, int col0, int ncols, int K, u16* dst, int& tb, int il, const float* gain) {
    LAS float* tile = (LAS float*)lds;
    const int tid = mk_tid, G = gridDim.x; const int ntn = ncols >> 8, nt = ntn * (K >> 6);
    int i0 = ((int)blockIdx.x - tb) % G; if (i0 < 0) i0 += G;
    for (int i = i0; i < nt; i += G) {
        const int tn = i % ntn, tk = i / ntn;
        __syncthreads();
        const float* src = W + (size_t)(tk * 64) * ldw + col0 + (il ? tn * 128 : tn * 256);
#pragma unroll 16
        for (int e = tid; e < 16384; e += 512) { const int r = e >> 8, c = e & 255; const int cs = (il && c >= 128) ? c + 3072 - 128 : c; tile[r * 257 + c] = src[(size_t)r * ldw + cs]; }
        __syncthreads();
        u16* dp = dst + (size_t)(tn * 256) * K + tk * 64; const float gk0 = gain ? gain[tk * 64 + (tid & 31) * 2] : 1.f, gk1 = gain ? gain[tk * 64 + (tid & 31) * 2 + 1] : 1.f;
#pragma unroll 4
        for (int e = tid; e < 8192; e += 512) { const int n = e >> 5, k2 = (e & 31) * 2; *(unsigned*)(dp + (size_t)n * K + k2) = pk2(tile[k2 * 257 + n] * gk0, tile[(k2 + 1) * 257 + n] * gk1); }
    }
    tb = (tb + nt) % G;
}

DI void norm_rows(int mk_tid, const float* src, const float* g, u16* dst, int nrows, const LAS float* sW, const float* ifb, float* ifg) {
    const int lane = mk_tid & 63, gw = blockIdx.x * 8 + (mk_tid >> 6), nw = gridDim.x * 8;
    for (int row0 = gw; row0 < nrows; row0 += 4 * nw) {
        float4 v[4][4];
#pragma unroll
        for (int r = 0; r < 4; ++r) { const int row = row0 + r * nw; if (row < nrows) {
#pragma unroll
            for (int i = 0; i < 4; ++i) v[r][i] = *(const float4*)(src + (size_t)row * 1024 + i * 256 + lane * 4); } }
        float4 gv[4];
#pragma unroll
        for (int i = 0; i < 4; ++i) gv[i] = *(const float4*)(g + i * 256 + lane * 4);
#pragma unroll
        for (int r = 0; r < 4; ++r) { const int row = row0 + r * nw; if (row < nrows) {
            float ss = 0.f;
#pragma unroll
            for (int i = 0; i < 4; ++i) ss += v[r][i].x * v[r][i].x + v[r][i].y * v[r][i].y + v[r][i].z * v[r][i].z + v[r][i].w * v[r][i].w;
            ss = wsum(ss); const float rinv = rsqrtf(ss * (1.f / 1024.f) + 1e-6f);
#pragma unroll
            for (int i = 0; i < 4; ++i) { v[r][i].x *= rinv * gv[i].x; v[r][i].y *= rinv * gv[i].y; v[r][i].z *= rinv * gv[i].z; v[r][i].w *= rinv * gv[i].w;
                u32x2 w; w.x = pk2(v[r][i].x, v[r][i].y); w.y = pk2(v[r][i].z, v[r][i].w); *(u32x2*)(dst + (size_t)row * 1024 + i * 256 + lane * 4) = w; }
            if (sW) {
                float a0 = 0, a1 = 0, a2 = 0, a3 = 0, a4 = 0, a5 = 0, a6 = 0, a7 = 0;
#pragma unroll
                for (int i = 0; i < 4; ++i) { const float y[4] = {v[r][i].x, v[r][i].y, v[r][i].z, v[r][i].w};
#pragma unroll
                    for (int e = 0; e < 4; ++e) { const int k = i * 256 + lane * 4 + e; const LAS f32x4* wp = (const LAS f32x4*)(sW + k * 8); const f32x4 w0 = wp[0], w1 = wp[1];
                        a0 += y[e] * w0.x; a1 += y[e] * w0.y; a2 += y[e] * w0.z; a3 += y[e] * w0.w; a4 += y[e] * w1.x; a5 += y[e] * w1.y; a6 += y[e] * w1.z; a7 += y[e] * w1.w; } __builtin_amdgcn_sched_barrier(0); }
                a0 = wsum(a0); a1 = wsum(a1); a2 = wsum(a2); a3 = wsum(a3); a4 = wsum(a4); a5 = wsum(a5); a6 = wsum(a6); a7 = wsum(a7);
                if (lane == 0) { float4 o0, o1; o0.x = a0 + ifb[0]; o0.y = a1 + ifb[1]; o0.z = a2 + ifb[2]; o0.w = a3 + ifb[3]; o1.x = a4 + ifb[4]; o1.y = a5 + ifb[5]; o1.z = a6 + ifb[6]; o1.w = a7 + ifb[7];
                    *(float4*)(ifg + (size_t)row * 8) = o0; *(float4*)(ifg + (size_t)row * 8 + 4) = o1; }
            } } __builtin_amdgcn_sched_barrier(0); }
    }
}
DI void final_norm(int mk_tid, const u16* hb, float* out, const float* g) {
    const int lane = mk_tid & 63, gw = blockIdx.x * 8 + (mk_tid >> 6), nw = gridDim.x * 8;
    float4 gv[4];
#pragma unroll
    for (int i = 0; i < 4; ++i) gv[i] = *(const float4*)(g + i * 256 + lane * 4);
    for (int row0 = gw; row0 < T; row0 += 4 * nw) {
        u32x2 v[4][4];
#pragma unroll
        for (int r = 0; r < 4; ++r)
#pragma unroll
            for (int i = 0; i < 4; ++i) v[r][i] = *(const u32x2*)(hb + (size_t)(row0 + r * nw) * 1024 + i * 256 + lane * 4);
        __builtin_amdgcn_sched_barrier(0);
#pragma unroll
        for (int r = 0; r < 4; ++r) { float* p = out + (size_t)(row0 + r * nw) * 1024; float ss = 0.f; float4 f[4];
#pragma unroll
            for (int i = 0; i < 4; ++i) { f[i].x = bflo(v[r][i].x); f[i].y = bfhi(v[r][i].x); f[i].z = bflo(v[r][i].y); f[i].w = bfhi(v[r][i].y); ss += f[i].x * f[i].x + f[i].y * f[i].y + f[i].z * f[i].z + f[i].w * f[i].w; }
            ss = wsum(ss); const float rinv = rsqrtf(ss * (1.f / 1024.f) + 1e-6f);
#pragma unroll
            for (int i = 0; i < 4; ++i) { float4 o; o.x = f[i].x * rinv * gv[i].x; o.y = f[i].y * rinv * gv[i].y; o.z = f[i].z * rinv * gv[i].z; o.w = f[i].w * rinv * gv[i].w; *(float4*)(p + i * 256 + lane * 4) = o; } }
    }
}

DI void conv_qk_phase(int mk_tid, const u16* qk, const float* cw, const float* cb, u16* qc, u16* kc) {
    const int gtid = blockIdx.x * 512 + mk_tid, nth = gridDim.x * 512;
    for (int item = gtid; item < 256 * 1024; item += nth) {
        const int co = item & 255, tb = item >> 8, c0 = co * 8, t0 = tb * 16;
        float w0[8], w1[8], w2[8], w3[8], bb[8];
#pragma unroll
        for (int e = 0; e < 8; ++e) { w0[e] = cw[c0 + e]; w1[e] = cw[2048 + c0 + e]; w2[e] = cw[4096 + c0 + e]; w3[e] = cw[6144 + c0 + e]; bb[e] = cb[c0 + e]; }
        float x0[8], x1[8], x2[8], x3[8];
        if ((t0 & (SEQ - 1)) == 0) {
#pragma unroll
            for (int e = 0; e < 8; ++e) { x0[e] = 0.f; x1[e] = 0.f; x2[e] = 0.f; }
        } else {
            unpack8(*(const u32x4*)(qk + (size_t)(t0 - 3) * 2048 + c0), x0); unpack8(*(const u32x4*)(qk + (size_t)(t0 - 2) * 2048 + c0), x1); unpack8(*(const u32x4*)(qk + (size_t)(t0 - 1) * 2048 + c0), x2);
        }
        u16* dstp = (c0 < 1024) ? qc + c0 : kc + (c0 - 1024); const float sc = (c0 < 1024) ? 1.f : 0.0625f;
        for (int tt = 0; tt < 16; ++tt) {
            unpack8(*(const u32x4*)(qk + (size_t)(t0 + tt) * 2048 + c0), x3);
            float o[8];
#pragma unroll
            for (int e = 0; e < 8; ++e) { const float v = bb[e] + w0[e] * x0[e] + w1[e] * x1[e] + w2[e] * x2[e] + w3[e] * x3[e]; o[e] = sc * v * sigm(v); x0[e] = x1[e]; x1[e] = x2[e]; x2[e] = x3[e]; }
            u32x4 r; r.x = pk2(o[0], o[1]); r.y = pk2(o[2], o[3]); r.z = pk2(o[4], o[5]); r.w = pk2(o[6], o[7]);
            *(u32x4*)(dstp + (size_t)(t0 + tt) * 1024) = r;
        }
    }
}

DI float logsig(float x) { return fminf(x, 0.f) - log1pf(__expf(-fabsf(x))); }
DI void gate_prepass(int mk_tid, LAS unsigned char* lds, int bh, const float* ifg, float* gz, float* gM, float* gE, float* gms, float* gMl, float* gW) {
    const int lane = mk_tid & 63, wid = mk_tid >> 6, b = bh >> 2, h = bh & 3;
    LAS float* G = (LAS float*)lds; LAS float* CM = G + 16;
    float z0[2], z1[2], b0[2], b1[2], excm[2], incm[2];
    __syncthreads();
#pragma unroll
    for (int cc = 0; cc < 2; ++cc) { const int c = wid * 2 + cc;
        const int s0 = c * 128 + 2 * lane; const size_t t = (size_t)b * SEQ + s0;
        const float i0 = ifg[t * 8 + h], f0 = ifg[t * 8 + 4 + h], i1 = ifg[t * 8 + 8 + h], f1 = ifg[t * 8 + 12 + h];
        const float lf0 = logsig(f0), lf1 = logsig(f1), s1 = lf0 + lf1;
        float inc = s1;
#pragma unroll
        for (int d = 1; d < 64; d <<= 1) { const float o = __shfl_up(inc, d); if (lane >= d) inc += o; }
        const float exc = inc - s1; b0[cc] = exc + lf0; b1[cc] = exc + s1; z0[cc] = i0 - b0[cc]; z1[cc] = i1 - b1[cc];
        float im = fmaxf(z0[cc], z1[cc]);
#pragma unroll
        for (int d = 1; d < 64; d <<= 1) { const float o = __shfl_up(im, d); if (lane >= d) im = fmaxf(im, o); }
        float em = __shfl_up(im, 1); if (lane == 0) em = -3.0e38f;
        incm[cc] = im; excm[cc] = em;
        if (lane == 63) { G[c] = inc; CM[c] = im; }
    }
    __syncthreads();
    float m = 0.f, mst[2] = {0.f, 0.f};
    for (int c = 0; c < wid * 2; ++c) m = G[c] + fmaxf(m, CM[c]);
    mst[0] = m; m = G[wid * 2] + fmaxf(m, CM[wid * 2]); mst[1] = m;
#pragma unroll
    for (int cc = 0; cc < 2; ++cc) { const int c = wid * 2 + cc; const float m_st = mst[cc];
        const float M0 = fmaxf(m_st, fmaxf(excm[cc], z0[cc])), M1 = fmaxf(m_st, incm[cc]), Ml = fmaxf(m_st, CM[c]);
        const size_t gi = (size_t)bh * SEQ + c * 128 + 2 * lane;
        *(float2*)(gz + gi) = make_float2(z0[cc], z1[cc]); *(float2*)(gM + gi) = make_float2(M0, M1); *(float2*)(gE + gi) = make_float2(__expf(-(b0[cc] + M0)), __expf(-(b1[cc] + M1)));
        *(float2*)(gW + gi) = make_float2(__expf(z0[cc] - Ml), __expf(z1[cc] - Ml));
        if (lane == 0) { gms[bh * 16 + c] = m_st; gMl[bh * 16 + c] = Ml; }
    }
    __syncthreads();
}

DI void mlstm_state_phase(int mk_tid, LAS unsigned char* lds, u16* kc, const u16* vT, float* gW, float* gms, float* gMl, u16* CT, float* nvec,
                          const float* ifg, float* gz, float* gM, float* gE, const float* HBQ, const float* cw, const float* cb) {
    const int tid = mk_tid, lane = tid & 63, wid = tid >> 6, fr = lane & 15, fq = lane >> 4;
    LAS unsigned* slab = (LAS unsigned*)(lds + wid * 9216);
    const unsigned trbase = (unsigned)(size_t)slab + (unsigned)((8 * fq + (fr >> 2)) * 72 + 8 * (fr & 3));
    const int lr = lane >> 2, lp = lane & 3;
    for (int item = blockIdx.x; item < 256; item += gridDim.x) {
        const int bh = item >> 3, eb = item & 7, b = bh >> 2, h = bh & 3;
        gate_prepass(mk_tid, lds, bh, ifg, gz, gM, gE, gms, gMl, gW);
        qk_fix_local(mk_tid, HBQ, cw, cb, kc, 1024 + h * 256, b * 8, 8);
        asm volatile("s_waitcnt vmcnt(0)" ::: "memory"); __syncthreads();
        f32x4 acc[2][2], nac4[2] = {(f32x4){0.f, 0.f, 0.f, 0.f}, (f32x4){0.f, 0.f, 0.f, 0.f}};
        const bf16x8 ones8 = __builtin_bit_cast(bf16x8, (u32x4){0x3F803F80u, 0x3F803F80u, 0x3F803F80u, 0x3F803F80u});
#pragma unroll
        for (int dm = 0; dm < 2; ++dm)
#pragma unroll
            for (int en = 0; en < 2; ++en) acc[dm][en] = (f32x4){0.f, 0.f, 0.f, 0.f};
        u32x4 kreg[8], vreg[4][2]; float wrow[8];
        {   const size_t tbase = (size_t)b * SEQ;
#pragma unroll
            for (int i = 0; i < 8; ++i) { kreg[i] = *(const u32x4*)(kc + (tbase + i * 16 + lr) * 1024 + h * 256 + wid * 32 + lp * 8); wrow[i] = gW[(size_t)bh * SEQ + i * 16 + lr]; }
#pragma unroll
            for (int ks = 0; ks < 4; ++ks)
#pragma unroll
                for (int en = 0; en < 2; ++en) vreg[ks][en] = *(const u32x4*)(vT + (size_t)(h * 256 + eb * 32 + en * 16 + fr) * T + tbase + ks * 32 + 8 * fq); }
        for (int c = 0; c < 16; ++c) {
            u16* ct = CT + ((size_t)(bh * 16 + c) << 16);
#pragma unroll
            for (int dm = 0; dm < 2; ++dm) {
#pragma unroll
                for (int en = 0; en < 2; ++en) { const int e = eb * 32 + en * 16 + fr, d = wid * 32 + dm * 16 + 4 * fq; u32x2 w; w.x = pk2(acc[dm][en][0], acc[dm][en][1]); w.y = pk2(acc[dm][en][2], acc[dm][en][3]); *(u32x2*)(ct + e * 256 + d) = w; }
                if (eb == 0 && fr == 0) *(f32x4*)(nvec + (size_t)(bh * 16 + c) * 256 + wid * 32 + dm * 16 + 4 * fq) = nac4[dm];
            }
            if (c == 15) break;
#pragma unroll
            for (int i = 0; i < 8; ++i) { float kf[8]; unpack8(kreg[i], kf); const float w = wrow[i]; LAS unsigned* dp = slab + (i * 16 + lr) * 18 + lp * 4;
                dp[0] = pk2(kf[0] * w, kf[1] * w); dp[1] = pk2(kf[2] * w, kf[3] * w); dp[2] = pk2(kf[4] * w, kf[5] * w); dp[3] = pk2(kf[6] * w, kf[7] * w); }
            bf16x8 bfr[4][2];
#pragma unroll
            for (int ks = 0; ks < 4; ++ks)
#pragma unroll
                for (int en = 0; en < 2; ++en) bfr[ks][en] = __builtin_bit_cast(bf16x8, vreg[ks][en]);
            if (c + 1 < 15) { const size_t tbase = (size_t)b * SEQ + (c + 1) * 128;
#pragma unroll
                for (int i = 0; i < 8; ++i) { kreg[i] = *(const u32x4*)(kc + (tbase + i * 16 + lr) * 1024 + h * 256 + wid * 32 + lp * 8); wrow[i] = gW[(size_t)bh * SEQ + (c + 1) * 128 + i * 16 + lr]; }
#pragma unroll
                for (int ks = 0; ks < 4; ++ks)
#pragma unroll
                    for (int en = 0; en < 2; ++en) vreg[ks][en] = *(const u32x4*)(vT + (size_t)(h * 256 + eb * 32 + en * 16 + fr) * T + tbase + ks * 32 + 8 * fq); }
            const float dec = __expf(gms[bh * 16 + c] - gMl[bh * 16 + c]);
#pragma unroll
            for (int dm = 0; dm < 2; ++dm) { nac4[dm] *= dec;
#pragma unroll
                for (int en = 0; en < 2; ++en) acc[dm][en] *= dec; }
            __builtin_amdgcn_fence(__ATOMIC_RELEASE, "wavefront"); __builtin_amdgcn_wave_barrier(); __builtin_amdgcn_fence(__ATOMIC_ACQUIRE, "wavefront");
#pragma unroll
            for (int ks = 0; ks < 4; ++ks) {
                bf16x8 afr[2];
                {
                    s16x4 a00, a01, a10, a11; const unsigned ad = trbase + (unsigned)(ks * 32 * 72);
                    asm volatile("s_waitcnt lgkmcnt(0)\n\tds_read_b64_tr_b16 %0, %4\n\tds_read_b64_tr_b16 %1, %4 offset:288\n\tds_read_b64_tr_b16 %2, %4 offset:32\n\tds_read_b64_tr_b16 %3, %4 offset:320\n\ts_waitcnt lgkmcnt(0)"
                                 : "=&v"(a00), "=&v"(a01), "=&v"(a10), "=&v"(a11) : "v"(ad) : "memory");
                    afr[0] = __builtin_shufflevector(a00, a01, 0, 1, 2, 3, 4, 5, 6, 7); afr[1] = __builtin_shufflevector(a10, a11, 0, 1, 2, 3, 4, 5, 6, 7); }
                nac4[0] = mfma16(afr[0], ones8, nac4[0]); nac4[1] = mfma16(afr[1], ones8, nac4[1]);
#pragma unroll
                for (int dm = 0; dm < 2; ++dm)
#pragma unroll
                    for (int en = 0; en < 2; ++en) acc[dm][en] = mfma16(afr[dm], bfr[ks][en], acc[dm][en]);
            }
            __builtin_amdgcn_fence(__ATOMIC_RELEASE, "wavefront"); __builtin_amdgcn_wave_barrier(); __builtin_amdgcn_fence(__ATOMIC_ACQUIRE, "wavefront");
        }
    }
}

DI void mlstm_out_phase(int mk_tid, LAS unsigned char* lds, u16* qy, const u16* kc, const u16* vT, const u16* CT, const float* nvec, const u16* og,
                        const float* gz, const float* gM, const float* gE, const float* gms, const float* ng, int nostore, const float* HBQ, const float* cw, const float* cb) {
    const int tid = mk_tid, lane = tid & 63, wid = __builtin_amdgcn_readfirstlane(tid >> 6), fr = lane & 15, fq = lane >> 4;
    LAS u16* Ksh = (LAS u16*)lds;
    LAS u16* Vsh = (LAS u16*)(lds + 67584);
    for (int item = blockIdx.x; item < 512; item += gridDim.x) {
        const int bh = item >> 4, c = item & 15, b = bh >> 2, h = bh & 3; const size_t tbase = (size_t)b * SEQ + c * 128;
        if ((c & 1) == 0) qk_fix_local(mk_tid, HBQ, cw, cb, qy, h * 256, (int)(tbase >> 8), 1);
        __syncthreads();
        for (int e = tid; e < 4096; e += 512) { const int r = e >> 5, p = e & 31; *(LAS u32x4*)(Ksh + r * 264 + p * 8) = *(const u32x4*)(kc + (tbase + r) * 1024 + h * 256 + p * 8); }
        for (int e = tid; e < 4096; e += 512) { const int r = e >> 4, p = e & 15; *(LAS u32x4*)(Vsh + r * 136 + p * 8) = *(const u32x4*)(vT + (size_t)(h * 256 + r) * T + tbase + p * 8); }
        asm volatile("s_waitcnt vmcnt(0)" ::: "memory");
        __syncthreads();
        const int tl = wid * 16 + fr; const size_t tok = tbase + tl;
        bf16x8 qf[8];
#pragma unroll
        for (int ks = 0; ks < 8; ++ks) qf[ks] = *(const bf16x8*)(qy + tok * 1024 + h * 256 + ks * 32 + 8 * fq);
        const size_t gi = (size_t)bh * SEQ + c * 128;
        const float Mt = gM[gi + tl], en_t = gE[gi + tl], winter = __expf(gms[bh * 16 + c] - Mt);
        const u16* ct = CT + ((size_t)(bh * 16 + c) << 16);
        u32x4 cpre[8];
#pragma unroll
        for (int i = 0; i < 8; ++i) { const int e = tid + i * 512, r = e >> 5, p = e & 31; cpre[i] = *(const u32x4*)(ct + (size_t)r * 256 + p * 8); }
        bf16x8 pf[4]; float dsum = 0.f;
#pragma unroll
        for (int sp = 0; sp < 4; ++sp) {
            u32x4 pk = (u32x4){0u, 0u, 0u, 0u};
#pragma unroll
            for (int hh = 0; hh < 2; ++hh) { const int si = sp * 2 + hh;
                if (si <= wid) {
                    f32x4 st = (f32x4){0.f, 0.f, 0.f, 0.f};
#pragma unroll
                    for (int ks = 0; ks < 8; ++ks) { const bf16x8 a = *(const LAS bf16x8*)(Ksh + (si * 16 + fr) * 264 + ks * 32 + 8 * fq); st = mfma16(a, qf[ks], st); }
                    const float4 z = *(const float4*)(gz + gi + si * 16 + 4 * fq); const float zz[4] = {z.x, z.y, z.z, z.w}; float pv[4];
#pragma unroll
                    for (int j = 0; j < 4; ++j) { const int s = si * 16 + 4 * fq + j; const float p = (s <= tl) ? st[j] * __expf(zz[j] - Mt) : 0.f; dsum += p; pv[j] = p; }
                    if (hh == 0) { pk.x = pk2(pv[0], pv[1]); pk.y = pk2(pv[2], pv[3]); } else { pk.z = pk2(pv[0], pv[1]); pk.w = pk2(pv[2], pv[3]); }
                } }
            pf[sp] = __builtin_bit_cast(bf16x8, pk);
        }
        f32x4 o[16];
#pragma unroll
        for (int half = 0; half < 2; ++half) {
            __syncthreads();
#pragma unroll
            for (int i = 0; i < 8; ++i) { const int e = tid + i * 512, r = e >> 5, p = e & 31; *(LAS u32x4*)(Ksh + r * 264 + p * 8) = cpre[i]; }
            if (half == 0) {
#pragma unroll
                for (int i = 0; i < 8; ++i) { const int e = tid + i * 512, r = e >> 5, p = e & 31; cpre[i] = *(const u32x4*)(ct + (size_t)(128 + r) * 256 + p * 8); } }
            __syncthreads();
#pragma unroll
            for (int e8 = 0; e8 < 8; ++e8) { f32x4 a = (f32x4){0.f, 0.f, 0.f, 0.f};
#pragma unroll
                for (int ks = 0; ks < 8; ++ks) { const bf16x8 cf = *(const LAS bf16x8*)(Ksh + (e8 * 16 + fr) * 264 + ks * 32 + 8 * fq); a = mfma16(cf, qf[ks], a); }
                o[half * 8 + e8] = a * winter; __builtin_amdgcn_sched_barrier(0); }
        }
        const float* nv = nvec + (size_t)(bh * 16 + c) * 256; float qn = 0.f;
#pragma unroll
        for (int ks = 0; ks < 8; ++ks) { const float4 n0 = *(const float4*)(nv + ks * 32 + 8 * fq), n1 = *(const float4*)(nv + ks * 32 + 8 * fq + 4); const float nn[8] = {n0.x, n0.y, n0.z, n0.w, n1.x, n1.y, n1.z, n1.w};
#pragma unroll
            for (int j = 0; j < 8; ++j) qn += bf2f((u16)qf[ks][j]) * nn[j]; }
        qn += __shfl_xor(qn, 16); qn += __shfl_xor(qn, 32); dsum += __shfl_xor(dsum, 16); dsum += __shfl_xor(dsum, 32);
        const int nsp = (wid >> 1) + 1;
#pragma unroll
        for (int et = 0; et < 16; ++et) { __builtin_amdgcn_sched_barrier(0);
#pragma unroll
            for (int sp = 0; sp < 4; ++sp) if (sp < nsp) {
                const s16x4 lo = *(const LAS s16x4*)(Vsh + (et * 16 + fr) * 136 + sp * 32 + 4 * fq), hi = *(const LAS s16x4*)(Vsh + (et * 16 + fr) * 136 + sp * 32 + 16 + 4 * fq);
                const bf16x8 a = __builtin_shufflevector(lo, hi, 0, 1, 2, 3, 4, 5, 6, 7); o[et] = mfma16(a, pf[sp], o[et]); } }
        const float den = winter * qn + dsum, inv = 1.f / fmaxf(fabsf(den), en_t);
        float sum = 0.f;
#pragma unroll
        for (int et = 0; et < 16; ++et) { o[et] *= inv; sum += (o[et][0] + o[et][1]) + (o[et][2] + o[et][3]); }
        sum += __shfl_xor(sum, 16); sum += __shfl_xor(sum, 32); const float mu = sum * (1.f / 256.f);
        float var = 0.f;
#pragma unroll
        for (int et = 0; et < 16; ++et) { o[et] -= mu; var += (o[et][0] * o[et][0] + o[et][1] * o[et][1]) + (o[et][2] * o[et][2] + o[et][3] * o[et][3]); }
        var += __shfl_xor(var, 16); var += __shfl_xor(var, 32); const float rstd = rsqrtf(var * (1.f / 256.f) + 1e-6f);
        u32x2 ogr[16]; float4 gg[16];
#pragma unroll
        for (int et = 0; et < 16; ++et) { ogr[et] = *(const u32x2*)(og + tok * 1024 + h * 256 + et * 16 + 4 * fq); gg[et] = *(const float4*)(ng + h * 256 + et * 16 + 4 * fq); }
        __builtin_amdgcn_sched_barrier(0);
#pragma unroll
        for (int et = 0; et < 16; ++et) { const int e = h * 256 + et * 16 + 4 * fq; const float4 g4 = gg[et];
            u32x2 w; w.x = pk2(sigm(bflo(ogr[et].x)) * o[et][0] * rstd * g4.x, sigm(bfhi(ogr[et].x)) * o[et][1] * rstd * g4.y); w.y = pk2(sigm(bflo(ogr[et].y)) * o[et][2] * rstd * g4.z, sigm(bfhi(ogr[et].y)) * o[et][3] * rstd * g4.w);
            if (!nostore) *(u32x2*)(qy + tok * 1024 + e) = w; }
    }
}

DI void xattn_phase(int mk_tid, LAS unsigned char* lds, const u16* q, const u16* kmem, const u16* vTm, u16* ao) {
    const int tid = mk_tid, lane = tid & 63, wid = tid >> 6, fr = lane & 15, fq = lane >> 4;
    LAS u16* Ksh = (LAS u16*)lds;
    for (int base = blockIdx.x * 2; base < 512; base += gridDim.x * 2) {
        const int bh = base >> 4, b = bh >> 2, h = bh & 3;
        __syncthreads();
        for (int e = tid; e < 8192; e += 512) { const int r = e >> 5, p = e & 31; *(LAS u32x4*)(Ksh + r * 264 + p * 8) = *(const u32x4*)(kmem + (size_t)(b * 256 + r) * 1024 + h * 256 + p * 8); }
        __syncthreads();
        const size_t tok0 = (size_t)b * SEQ + (base & 15) * 128 + wid * 16 + fr, tok1 = tok0 + 128;
        bf16x8 qa[8], qb8[8];
#pragma unroll
        for (int ks = 0; ks < 8; ++ks) { qa[ks] = *(const bf16x8*)(q + tok0 * 1024 + h * 256 + ks * 32 + 8 * fq); qb8[ks] = *(const bf16x8*)(q + tok1 * 1024 + h * 256 + ks * 32 + 8 * fq); }
        float mx0 = -3.0e38f, mx1 = -3.0e38f;
#pragma unroll
        for (int mi = 0; mi < 16; ++mi) { f32x4 a = (f32x4){0.f, 0.f, 0.f, 0.f}, c = (f32x4){0.f, 0.f, 0.f, 0.f};
#pragma unroll
            for (int ks = 0; ks < 8; ++ks) { const bf16x8 kf = *(const LAS bf16x8*)(Ksh + (mi * 16 + fr) * 264 + ks * 32 + 8 * fq); a = mfma16(kf, qa[ks], a); c = mfma16(kf, qb8[ks], c); }
            mx0 = fmaxf(mx0, fmaxf(fmaxf(a[0], a[1]), fmaxf(a[2], a[3]))); mx1 = fmaxf(mx1, fmaxf(fmaxf(c[0], c[1]), fmaxf(c[2], c[3]))); __builtin_amdgcn_sched_barrier(0); }
        mx0 = fmaxf(mx0, __shfl_xor(mx0, 16)); mx0 = fmaxf(mx0, __shfl_xor(mx0, 32)); mx1 = fmaxf(mx1, __shfl_xor(mx1, 16)); mx1 = fmaxf(mx1, __shfl_xor(mx1, 32));
        bf16x8 pf0[8], pf1[8]; float sum0 = 0.f, sum1 = 0.f;
#pragma unroll
        for (int sp = 0; sp < 8; ++sp) { f32x4 a0 = (f32x4){0.f, 0.f, 0.f, 0.f}, a1 = a0, c0 = a0, c1 = a0;
#pragma unroll
            for (int ks = 0; ks < 8; ++ks) { const bf16x8 k0 = *(const LAS bf16x8*)(Ksh + (sp * 32 + fr) * 264 + ks * 32 + 8 * fq), k1 = *(const LAS bf16x8*)(Ksh + (sp * 32 + 16 + fr) * 264 + ks * 32 + 8 * fq);
                a0 = mfma16(k0, qa[ks], a0); a1 = mfma16(k1, qa[ks], a1); c0 = mfma16(k0, qb8[ks], c0); c1 = mfma16(k1, qb8[ks], c1); }
            float p[8], r[8];
#pragma unroll
            for (int j = 0; j < 4; ++j) { p[j] = __expf((a0[j] - mx0) * 0.0625f); p[4 + j] = __expf((a1[j] - mx0) * 0.0625f); sum0 += p[j] + p[4 + j];
                                          r[j] = __expf((c0[j] - mx1) * 0.0625f); r[4 + j] = __expf((c1[j] - mx1) * 0.0625f); sum1 += r[j] + r[4 + j]; }
            u32x4 pk; pk.x = pk2(p[0], p[1]); pk.y = pk2(p[2], p[3]); pk.z = pk2(p[4], p[5]); pk.w = pk2(p[6], p[7]); pf0[sp] = __builtin_bit_cast(bf16x8, pk);
            u32x4 rk; rk.x = pk2(r[0], r[1]); rk.y = pk2(r[2], r[3]); rk.z = pk2(r[4], r[5]); rk.w = pk2(r[6], r[7]); pf1[sp] = __builtin_bit_cast(bf16x8, rk); __builtin_amdgcn_sched_barrier(0); }
        sum0 += __shfl_xor(sum0, 16); sum0 += __shfl_xor(sum0, 32); sum1 += __shfl_xor(sum1, 16); sum1 += __shfl_xor(sum1, 32);
        const float iv0 = 1.f / sum0, iv1 = 1.f / sum1;
        __syncthreads();
        for (int e = tid; e < 8192; e += 512) { const int r = e >> 5, p = e & 31; *(LAS u32x4*)(Ksh + r * 264 + p * 8) = *(const u32x4*)(vTm + (size_t)(h * 256 + r) * 2048 + b * 256 + p * 8); }
        __syncthreads();
#pragma unroll 2
        for (int et = 0; et < 16; ++et) {
            f32x4 o0 = (f32x4){0.f, 0.f, 0.f, 0.f}, o1 = o0;
#pragma unroll
            for (int sp = 0; sp < 8; ++sp) { const s16x4 lo = *(const LAS s16x4*)(Ksh + (et * 16 + fr) * 264 + sp * 32 + 4 * fq), hi = *(const LAS s16x4*)(Ksh + (et * 16 + fr) * 264 + sp * 32 + 16 + 4 * fq);
                const bf16x8 a = __builtin_shufflevector(lo, hi, 0, 1, 2, 3, 4, 5, 6, 7); o0 = mfma16(a, pf0[sp], o0); o1 = mfma16(a, pf1[sp], o1); }
            u32x2 w0, w1; w0.x = pk2(o0[0] * iv0, o0[1] * iv0); w0.y = pk2(o0[2] * iv0, o0[3] * iv0); w1.x = pk2(o1[0] * iv1, o1[1] * iv1); w1.y = pk2(o1[2] * iv1, o1[3] * iv1);
            *(u32x2*)(ao + tok0 * 1024 + h * 256 + et * 16 + 4 * fq) = w0; *(u32x2*)(ao + tok1 * 1024 + h * 256 + et * 16 + 4 * fq) = w1; __builtin_amdgcn_sched_barrier(0); }
    }
}

DI void rglru_phase(int mk_tid, LAS unsigned char* lds, const u16* xr, const u16* gr, const float* cw, const float* cb, const float* wa, const float* ba, const float* wx, const float* bx, const float* lam, u16* ya, int pass, float* sumA, float* sumH) {
    const int tid = mk_tid, lane = tid & 63, wid = tid >> 6, fr = lane & 15, fq = lane >> 4;
    LAS u16* xs = (LAS u16*)(lds + wid * 8192);
    LAS float* xf = (LAS float*)(lds + wid * 8192 + 2560);
    const int tp = lane >> 3, co = lane & 7;
    for (int item = blockIdx.x * 8 + wid; item < 2048; item += gridDim.x * 8) {
        const int b = item >> 8, g = (item >> 4) & 15, seg = item & 15, ccol = g * 64 + co * 8;
        LAS u16* Wsh = (LAS u16*)(lds + 65536);
        __syncthreads();
        for (int e = tid; e < 4096; e += 512) { const int i = e >> 6, j = e & 63; Wsh[j * 72 + i] = f2bf(wa[(size_t)(g * 64 + i) * 64 + j]); Wsh[4608 + j * 72 + i] = f2bf(wx[(size_t)(g * 64 + i) * 64 + j]); }
        __syncthreads();
        if (pass == 0 && seg == 15) continue;
        float bav[4], bxv[4], c8[4], carry[4], aprod[4];
#pragma unroll
        for (int nt = 0; nt < 4; ++nt) { const int cch = g * 64 + nt * 16 + fr;
            bav[nt] = ba[cch]; bxv[nt] = bx[cch]; c8[nt] = -8.f * log1pf(__expf(-lam[cch])); carry[nt] = 0.f; aprod[nt] = 1.f;
            if (pass == 1) for (int s2 = 0; s2 < seg; ++s2) carry[nt] = sumA[(size_t)(b * 16 + s2) * 1024 + cch] * carry[nt] + sumH[(size_t)(b * 16 + s2) * 1024 + cch]; }
        float w0[8], w1[8], w2[8], w3[8], bb[8];
#pragma unroll
        for (int e = 0; e < 8; ++e) { w0[e] = cw[ccol + e]; w1[e] = cw[1024 + ccol + e]; w2[e] = cw[2048 + ccol + e]; w3[e] = cw[3072 + ccol + e]; bb[e] = cb[ccol + e]; }
        const size_t tb0 = (size_t)b * SEQ; const int sb = seg * 128;
        u32x4 rows[5]; u16 grv[4][4];
#pragma unroll
        for (int r = 0; r < 5; ++r) { const int srow = sb + 2 * tp - 3 + r; rows[r] = (srow >= 0) ? *(const u32x4*)(xr + (tb0 + srow) * 1024 + ccol) : (u32x4){0u, 0u, 0u, 0u}; }
#pragma unroll
        for (int nt = 0; nt < 4; ++nt)
#pragma unroll
            for (int j = 0; j < 4; ++j) grv[nt][j] = (pass == 1) ? gr[(tb0 + sb + 4 * fq + j) * 1024 + g * 64 + nt * 16 + fr] : (u16)0;
        for (int st = 0; st < 8; ++st) {
            u32x4 cur[5]; u16 gcur[4][4];
#pragma unroll
            for (int r = 0; r < 5; ++r) cur[r] = rows[r];
#pragma unroll
            for (int nt = 0; nt < 4; ++nt)
#pragma unroll
                for (int j = 0; j < 4; ++j) gcur[nt][j] = grv[nt][j];
            const int t0 = sb + st * 16;
            if (st + 1 < 8) {
#pragma unroll
                for (int r = 0; r < 5; ++r) rows[r] = *(const u32x4*)(xr + (tb0 + t0 + 16 + 2 * tp - 3 + r) * 1024 + ccol);
                if (pass == 1) {
#pragma unroll
                    for (int nt = 0; nt < 4; ++nt)
#pragma unroll
                        for (int j = 0; j < 4; ++j) grv[nt][j] = gr[(tb0 + t0 + 16 + 4 * fq + j) * 1024 + g * 64 + nt * 16 + fr]; }
            }
            float r0[8], r1[8], r2[8], r3[8], r4[8], oa[8], ob[8];
            unpack8(cur[0], r0); unpack8(cur[1], r1); unpack8(cur[2], r2); unpack8(cur[3], r3); unpack8(cur[4], r4);
#pragma unroll
            for (int e = 0; e < 8; ++e) { oa[e] = bb[e] + w0[e] * r0[e] + w1[e] * r1[e] + w2[e] * r2[e] + w3[e] * r3[e]; ob[e] = bb[e] + w0[e] * r1[e] + w1[e] * r2[e] + w2[e] * r3[e] + w3[e] * r4[e]; }
            { u32x4 pa, pb; pa.x = pk2(oa[0], oa[1]); pa.y = pk2(oa[2], oa[3]); pa.z = pk2(oa[4], oa[5]); pa.w = pk2(oa[6], oa[7]); pb.x = pk2(ob[0], ob[1]); pb.y = pk2(ob[2], ob[3]); pb.z = pk2(ob[4], ob[5]); pb.w = pk2(ob[6], ob[7]);
              *(LAS u32x4*)(xs + (2 * tp) * 72 + co * 8) = pa; *(LAS u32x4*)(xs + (2 * tp + 1) * 72 + co * 8) = pb;
              *(LAS f32x4*)(xf + (2 * tp) * 68 + co * 8) = (f32x4){oa[0], oa[1], oa[2], oa[3]}; *(LAS f32x4*)(xf + (2 * tp) * 68 + co * 8 + 4) = (f32x4){oa[4], oa[5], oa[6], oa[7]};
              *(LAS f32x4*)(xf + (2 * tp + 1) * 68 + co * 8) = (f32x4){ob[0], ob[1], ob[2], ob[3]}; *(LAS f32x4*)(xf + (2 * tp + 1) * 68 + co * 8 + 4) = (f32x4){ob[4], ob[5], ob[6], ob[7]}; }
            __builtin_amdgcn_fence(__ATOMIC_RELEASE, "wavefront"); __builtin_amdgcn_wave_barrier(); __builtin_amdgcn_fence(__ATOMIC_ACQUIRE, "wavefront");
            const bf16x8 af0 = *(const LAS bf16x8*)(xs + fr * 72 + 8 * fq), af1 = *(const LAS bf16x8*)(xs + fr * 72 + 32 + 8 * fq);
#pragma unroll
            for (int nt = 0; nt < 4; ++nt) {
                f32x4 aa = (f32x4){0.f, 0.f, 0.f, 0.f}, ax = (f32x4){0.f, 0.f, 0.f, 0.f};
                { const LAS u16* wp = Wsh + (nt * 16 + fr) * 72 + 8 * fq; const bf16x8 wa0 = *(const LAS bf16x8*)wp, wa1 = *(const LAS bf16x8*)(wp + 32), wx0 = *(const LAS bf16x8*)(wp + 4608), wx1 = *(const LAS bf16x8*)(wp + 4608 + 32);
                  aa = mfma16(af0, wa0, aa); aa = mfma16(af1, wa1, aa); ax = mfma16(af0, wx0, ax); ax = mfma16(af1, wx1, ax); }
                float hl[4], pa4[4]; float Al = 1.f, Hl = 0.f;
#pragma unroll
                for (int j = 0; j < 4; ++j) { const float xc = xf[(4 * fq + j) * 68 + nt * 16 + fr]; const float rr = sigm(aa[j] + bav[nt]), ii = sigm(ax[j] + bxv[nt]), la = c8[nt] * rr, av = __expf(la), x2 = 2.f * la;
                    const float om = (x2 > -0.02f) ? -x2 * (1.f + x2 * (0.5f + x2 * (1.f / 6.f))) : 1.f - av * av;
                    const float uu = __builtin_amdgcn_sqrtf(fmaxf(om, 0.f)) * ii * xc;
                    Hl = av * Hl + uu; Al *= av; hl[j] = Hl; pa4[j] = Al; }
                const float A0 = __shfl(Al, fr), H0 = __shfl(Hl, fr), A1 = __shfl(Al, fr + 16), H1 = __shfl(Hl, fr + 16), A2 = __shfl(Al, fr + 32), H2 = __shfl(Hl, fr + 32), A3 = __shfl(Al, fr + 48), H3 = __shfl(Hl, fr + 48);
                const float cin = carry[nt], c1 = A0 * cin + H0, c2 = A1 * c1 + H1, c3 = A2 * c2 + H2, c4 = A3 * c3 + H3;
                const float hin = (fq == 0) ? cin : (fq == 1) ? c1 : (fq == 2) ? c2 : c3;
                carry[nt] = c4; aprod[nt] *= (A0 * A1) * (A2 * A3);
                if (pass == 1) {
#pragma unroll
                    for (int j = 0; j < 4; ++j) { const float hv = hl[j] + pa4[j] * hin; ya[(tb0 + t0 + 4 * fq + j) * 1024 + g * 64 + nt * 16 + fr] = f2bf(gelu_t(bf2f(gcur[nt][j])) * hv); } }
            }
            __builtin_amdgcn_fence(__ATOMIC_RELEASE, "wavefront"); __builtin_amdgcn_wave_barrier(); __builtin_amdgcn_fence(__ATOMIC_ACQUIRE, "wavefront");
        }
        if (pass == 0 && fq == 0) {
#pragma unroll
            for (int nt = 0; nt < 4; ++nt) { sumA[(size_t)(b * 16 + seg) * 1024 + g * 64 + nt * 16 + fr] = aprod[nt]; sumH[(size_t)(b * 16 + seg) * 1024 + g * 64 + nt * 16 + fr] = carry[nt]; } }
    }
}

DI void ffn_act_phase(int mk_tid, const u16* up, const float* cw, const float* cb, u16* act, int part) {
    const int gtid = blockIdx.x * 512 + mk_tid, nth = gridDim.x * 512;
    for (int item = gtid; item < 192 * 1024; item += nth) {
        const int co = item % 192, tb = item / 192, c0 = co * 8, t0 = tb * 16, gc = part * 1536 + c0;
        float wg0[8], wg1[8], wg2[8], wu0[8], wu1[8], wu2[8], bg[8], bu[8];
#pragma unroll
        for (int e = 0; e < 8; ++e) { wg0[e] = cw[gc + e]; wg1[e] = cw[6144 + gc + e]; wg2[e] = cw[12288 + gc + e]; wu0[e] = cw[3072 + gc + e]; wu1[e] = cw[6144 + 3072 + gc + e]; wu2[e] = cw[12288 + 3072 + gc + e]; bg[e] = cb[gc + e]; bu[e] = cb[3072 + gc + e]; }
        float g0[8], g1[8], g2[8], u0[8], u1[8], u2[8];
        if ((t0 & (SEQ - 1)) == 0) {
#pragma unroll
            for (int e = 0; e < 8; ++e) { g0[e] = 0.f; g1[e] = 0.f; u0[e] = 0.f; u1[e] = 0.f; }
        } else {
            unpack8(*(const u32x4*)(up + (size_t)(t0 - 2) * 3072 + c0), g0); unpack8(*(const u32x4*)(up + (size_t)(t0 - 1) * 3072 + c0), g1);
            unpack8(*(const u32x4*)(up + (size_t)(t0 - 2) * 3072 + 1536 + c0), u0); unpack8(*(const u32x4*)(up + (size_t)(t0 - 1) * 3072 + 1536 + c0), u1);
        }
        for (int tt = 0; tt < 16; ++tt) {
            unpack8(*(const u32x4*)(up + (size_t)(t0 + tt) * 3072 + c0), g2); unpack8(*(const u32x4*)(up + (size_t)(t0 + tt) * 3072 + 1536 + c0), u2);
            float o[8];
#pragma unroll
            for (int e = 0; e < 8; ++e) { const float gv = bg[e] + wg0[e] * g0[e] + wg1[e] * g1[e] + wg2[e] * g2[e], uv = bu[e] + wu0[e] * u0[e] + wu1[e] * u1[e] + wu2[e] * u2[e]; o[e] = gelu_t(gv) * uv; g0[e] = g1[e]; g1[e] = g2[e]; u0[e] = u1[e]; u1[e] = u2[e]; }
            u32x4 r; r.x = pk2(o[0], o[1]); r.y = pk2(o[2], o[3]); r.z = pk2(o[4], o[5]); r.w = pk2(o[6], o[7]);
            *(u32x4*)(act + (size_t)(t0 + tt) * 3072 + gc) = r;
        }
    }
}

DI UE ue_bf16(u16* O, int ldc, int split) { UE e; e.perm = 1; e.kind = 0; e.O = O; e.ldc = ldc; e.split = split; e.gate = nullptr; e.F = nullptr; e.Fin = nullptr; e.ss = nullptr; e.smode = 0; e.HBo = nullptr; e.sso = nullptr; e.ssp = nullptr; e.cnt = nullptr; e.rflags = 0; return e; }
DI GD mkgd(const u16* A, const u16* Bt, int M, int N, int K, int cshift, UE e) { GD d; d.A = A; d.Bt = Bt; d.M = M; d.N = N; d.K = K; d.cshift = cshift; d.e = e; return d; }

#define XB_TMO      128
#define XB_XCNT(j)  (256  + 64 * (j))
#define XB_XSUB(j)  (1280 + 64 * (j))
#define XB_XGEN(j)  (2304 + 64 * (j))
#define XB_TOP      3328
#define XB_TOPGEN   3392
#define XCD_BAR_WORDS 3456
#define XB_SPIN_CAP (1u << 18)

__device__ __forceinline__ unsigned xb_ld(unsigned* p)              { return __hip_atomic_load(p, __ATOMIC_RELAXED, __HIP_MEMORY_SCOPE_AGENT); }
__device__ __forceinline__ unsigned xb_add(unsigned* p, unsigned v) { return __hip_atomic_fetch_add(p, v, __ATOMIC_RELAXED, __HIP_MEMORY_SCOPE_AGENT); }
__device__ __forceinline__ unsigned xb_xcc_id() { return (unsigned)__builtin_amdgcn_s_getreg((3 << 11) | 20) & 0xFu; }
#define XB_SPIN(cond, bar) do { unsigned _sp = 0; while (cond) { __builtin_amdgcn_s_sleep(1); \
    if ((++_sp & 255u) == 0u) { if (xb_ld(&(bar)[XB_TMO])) break; if (_sp > XB_SPIN_CAP) { atomicAdd(&(bar)[XB_TMO], 1u); break; } } } } while (0)

struct XcdBarrier {
    unsigned* bar; unsigned x;
    volatile LAS unsigned* st;
};

__device__ __forceinline__ XcdBarrier xcd_barrier_post(unsigned* bar, volatile LAS unsigned* st) {
    XcdBarrier b; b.bar = bar; b.x = xb_xcc_id(); b.st = st;
    if (threadIdx.x == 0) (void)xb_add(&bar[XB_XCNT(b.x)], 1u);
    return b;
}
__device__ __forceinline__ void xcd_barrier_complete(unsigned* bar, unsigned x, unsigned& nloc, unsigned& nx) {
    const unsigned G = gridDim.x * gridDim.y * gridDim.z;
    unsigned sum, cnt, mine, sp = 0u;
    for (;;) {
        sum = 0u; cnt = 0u; mine = 0u;
#pragma unroll
        for (unsigned j = 0; j < 16; ++j) { const unsigned c = xb_ld(&bar[XB_XCNT(j)]); sum += c; cnt += (c > 0u) ? 1u : 0u; mine = (j == x) ? c : mine; }
        if (sum == G) break;
        __builtin_amdgcn_s_sleep(1);
        if ((++sp & 255u) == 0u) { if (xb_ld(&bar[XB_TMO])) break; if (sp > XB_SPIN_CAP) { atomicAdd(&bar[XB_TMO], 1u); break; } }
    }
    nloc = mine > 0u ? mine : 1u; nx = cnt > 0u ? cnt : 1u;
}

__device__ __forceinline__ void xcd_barrier(const XcdBarrier& b) {
    asm volatile("s_waitcnt vmcnt(0)" ::: "memory");
    __syncthreads();
    if (threadIdx.x == 0) {
        unsigned* bar = b.bar;
        __builtin_amdgcn_s_waitcnt(0);
        unsigned nloc = b.st[0], nx = b.st[1];
        if (nloc == 0u) { xcd_barrier_complete(bar, b.x, nloc, nx); b.st[0] = nloc; b.st[1] = nx; }
        const unsigned old = xb_add(&bar[XB_XSUB(b.x)], 1u);
        const unsigned gen = old / nloc;
        if (old + 1u == (gen + 1u) * nloc) {
            __builtin_amdgcn_fence(__ATOMIC_RELEASE, "agent");
            asm volatile("s_waitcnt vmcnt(0)" ::: "memory");
            const unsigned og = xb_add(&bar[XB_TOP], 1u);
            const unsigned tg = og / nx;
            if (og + 1u == (tg + 1u) * nx) xb_add(&bar[XB_TOPGEN], 1u);
            else XB_SPIN(xb_ld(&bar[XB_TOPGEN]) == tg, bar);
            __builtin_amdgcn_fence(__ATOMIC_ACQUIRE, "agent");
            xb_add(&bar[XB_XGEN(b.x)], 1u);
            asm volatile("s_waitcnt vmcnt(0)" ::: "memory");
        } else {
            XB_SPIN(xb_ld(&bar[XB_XGEN(b.x)]) == gen, bar);
            __builtin_amdgcn_fence(__ATOMIC_ACQUIRE, "agent");
            asm volatile("s_waitcnt vmcnt(0)" ::: "memory");
        }
    }
    __syncthreads();
}

DI int gemm_count(int sub) { return (sub == S_GXR) ? 1 : (sub == S_GQK || sub == S_GAB) ? 2 : (sub == S_GQKV) ? 3 : 0; }
DI GD get_gd(const Args& a, int l, int sub, int i) {
    unsigned char* ws = a.ws;
    u16* A0 = (u16*)ws; u16* A1 = (u16*)(ws + U); u16* A2 = (u16*)(ws + 2 * U); u16* A3 = (u16*)(ws + 3 * U); u16* A4 = (u16*)(ws + 4 * U); u16* A5 = (u16*)(ws + 5 * U); u16* A6 = (u16*)(ws + 6 * U);
    u16* WT = (u16*)(ws + WS_WT); u16* MEMN = (u16*)(ws + WS_MEMN); u16* KMEM = A3; u16* VTM = A3 + 2097152;
    float* SS = (float*)(ws + WS_SS);
    const size_t MW = (size_t)1024 * 1024;
    UE er = ue_bf16(nullptr, 1024, 0); er.perm = 1; er.kind = 3; er.ssp = (float*)(ws + WS_SSP); er.cnt = (unsigned*)(ws + WS_CNT) + (size_t)(l * 3 + (sub == S_GMIX ? 0 : sub == S_GWO ? 1 : 2)) * 64; er.Fin = (l == 0 && sub == S_GMIX) ? a.in[0] : a.out; er.F = a.out;
    switch (sub) {
    case S_GQK: { UE eo = ue_bf16(A1, 1024, 0); eo.ss = SS + (size_t)(l * 3) * T; eo.smode = 1; UE ev = ue_bf16(A2, T, 0); ev.ss = SS + (size_t)(l * 3) * T; ev.smode = 2;
        return i == 0 ? mkgd(A0, WT + 2 * MW, T, 1024, 1024, 0, eo) : mkgd(WT + 3 * MW, A0, 1024, T, 1024, 0, ev); }
    case S_GXR: { UE e = ue_bf16(A1, 1024, 1); e.ss = SS + (size_t)(l * 3) * T; e.smode = 1; return mkgd(A0, WT + 4 * MW, T, 4096, 1024, 0, e); }
    case S_GAB: { UE e1 = ue_bf16(nullptr, 1024, 0); e1.perm = 1; e1.kind = 1; e1.gate = A3; e1.O = A1; UE e2 = e1; e2.kind = 2; e2.gate = A4; e2.Fin = (const float*)A1; e2.O = A0;
        return i == 0 ? mkgd(A5, WT + 8 * MW, T, 1024, 1024, 0, e1) : mkgd(A6, WT + 9 * MW, T, 1024, 1024, 0, e2); }
    case S_GMIX: er.HBo = A1; er.sso = SS + (size_t)(l * 3 + 1) * T; er.rflags = 0; return mkgd(A0, WT + 10 * MW, T, 1024, 1024, 0, er);
    case S_GQKV: { UE eq = ue_bf16(A0, 1024, 0); eq.ss = SS + (size_t)(l * 3 + 1) * T; eq.smode = 1;
        return i == 0 ? mkgd(A1, WT, T, 1024, 1024, 0, eq) : i == 1 ? mkgd(MEMN, WT + MW, 2048, 1024, 1024, 0, ue_bf16(KMEM, 1024, 0)) : mkgd(WT + 2 * MW, MEMN, 1024, 2048, 1024, 64, ue_bf16(VTM, 2048, 0)); }
    case S_GWO: er.HBo = A0; er.sso = SS + (size_t)(l * 3 + 2) * T; er.Fin = (const float*)A1; er.rflags = 1; return mkgd(A2, WT + 3 * MW, T, 1024, 1024, 0, er);
    default: er.HBo = A0; er.sso = SS + (size_t)(l * 3 + 3) * T; er.Fin = (const float*)A0; er.rflags = 3; return mkgd(A4, WT + 11 * MW, T, 1024, 3072, 0, er);
    }
}
DI void cvt_set(int mk_tid, LAS unsigned char* lds, const Args& a, int l, int set) {
    u16* WT = (u16*)(a.ws + WS_WT); const size_t MW = (size_t)1024 * 1024; int tb = 0; const int nj = set == 0 ? 8 : set == 1 ? 3 : 1;
    for (int j = 0; j < nj; ++j) {
        const float* W; int ldw, col0, ncols, K = 1024, il = 0; u16* dst; const float* gain = nullptr;
        if (set == 0) { const float* win = a.in[3] + (size_t)l * 1024 * 8200;
            if (j < 5) { W = win; ldw = 8200; col0 = (j == 0) ? 2048 : (j == 1) ? 5120 : (j == 2) ? 4096 : (j == 3) ? 0 : 6152; ncols = (j == 1 || j == 2) ? 1024 : 2048; dst = WT + ((j == 0) ? 0 : (j == 1) ? 2 : (j == 2) ? 3 : (j == 3) ? 4 : 6) * MW; gain = a.in[2] + l * 1024; }
            else { W = a.in[15 + (j - 5)] + l * MW; ldw = 1024; col0 = 0; ncols = 1024; dst = WT + (8 + (j - 5)) * MW; } }
        else if (set == 1) { W = (j == 0) ? a.in[19] + l * MW : (j == 1) ? a.in[20] + l * 2 * MW : a.in[21] + l * MW; ldw = (j == 1) ? 2048 : 1024; col0 = 0; ncols = (j == 1) ? 2048 : 1024; dst = WT + ((j == 0) ? 0 : (j == 1) ? 1 : 3) * MW; gain = (j == 0) ? a.in[18] + l * 1024 : nullptr; }
        else if (set == 2) { W = a.in[23] + (size_t)l * 6 * MW; ldw = 6144; col0 = 0; ncols = 6144; il = 1; dst = WT + 4 * MW; gain = a.in[22] + l * 1024; }
        else { W = a.in[26] + (size_t)l * 3 * MW; ldw = 1024; col0 = 0; ncols = 1024; K = 3072; dst = WT + 11 * MW; }
        cvt_w(mk_tid, lds, W, ldw, col0, ncols, K, dst, tb, il, gain);
    }
}
DI void ifg_rows(int mk_tid, LAS unsigned char* lds, const u16* hb, const float* ss, const float* win, const float* g, const float* ifb, float* ifg) {
    const int tid = mk_tid, lane = tid & 63, wid = tid >> 6;
    LAS float* sW = (LAS float*)lds;
    __syncthreads();
    for (int e = tid; e < 8192; e += 512) sW[e] = win[(size_t)(e >> 3) * 8200 + 6144 + (e & 7)] * g[e >> 3];
    __syncthreads();
    for (int r0 = blockIdx.x * 64; r0 < T; r0 += gridDim.x * 64) {
        u16 hv[8][16];
#pragma unroll
        for (int rr = 0; rr < 8; ++rr)
#pragma unroll
            for (int e = 0; e < 16; ++e) hv[rr][e] = hb[(size_t)(r0 + wid * 8 + rr) * 1024 + e * 64 + lane];
#pragma unroll
        for (int rr = 0; rr < 8; ++rr) { const int row = r0 + wid * 8 + rr;
            float a0 = 0, a1 = 0, a2 = 0, a3 = 0, a4 = 0, a5 = 0, a6 = 0, a7 = 0;
#pragma unroll
            for (int e = 0; e < 16; ++e) { const int k = e * 64 + lane; const float y = bf2f(hv[rr][e]); const LAS f32x4* wp = (const LAS f32x4*)(sW + k * 8); const f32x4 w0 = wp[0], w1 = wp[1];
                a0 += y * w0.x; a1 += y * w0.y; a2 += y * w0.z; a3 += y * w0.w; a4 += y * w1.x; a5 += y * w1.y; a6 += y * w1.z; a7 += y * w1.w; }
            a0 = wsum(a0); a1 = wsum(a1); a2 = wsum(a2); a3 = wsum(a3); a4 = wsum(a4); a5 = wsum(a5); a6 = wsum(a6); a7 = wsum(a7);
            if (lane == 0) { const float rs = rsqrtf(ss[row] * (1.f / 1024.f) + 1e-6f); float4 o0, o1; o0.x = a0 * rs + ifb[0]; o0.y = a1 * rs + ifb[1]; o0.z = a2 * rs + ifb[2]; o0.w = a3 * rs + ifb[3]; o1.x = a4 * rs + ifb[4]; o1.y = a5 * rs + ifb[5]; o1.z = a6 * rs + ifb[6]; o1.w = a7 * rs + ifb[7];
                *(float4*)(ifg + (size_t)row * 8) = o0; *(float4*)(ifg + (size_t)row * 8 + 4) = o1; }
            __builtin_amdgcn_sched_barrier(0); }
    }
    __syncthreads();
}
DI void raw_rows(int mk_tid, const float* src, u16* dst, float* ssout) {
    const int lane = mk_tid & 63, gw = blockIdx.x * 8 + (mk_tid >> 6), nw = gridDim.x * 8;
    for (int row = gw; row < T; row += nw) {
        float4 v[4]; float sq = 0.f;
#pragma unroll
        for (int i = 0; i < 4; ++i) { v[i] = *(const float4*)(src + (size_t)row * 1024 + i * 256 + lane * 4); sq += v[i].x * v[i].x + v[i].y * v[i].y + v[i].z * v[i].z + v[i].w * v[i].w; }
        sq = wsum(sq);
#pragma unroll
        for (int i = 0; i < 4; ++i) { u32x2 w; w.x = pk2(v[i].x, v[i].y); w.y = pk2(v[i].z, v[i].w); *(u32x2*)(dst + (size_t)row * 1024 + i * 256 + lane * 4) = w; }
        if (lane == 0) ssout[row] = sq;
    }
}
DI void resid_gemm(int mk_tid, LAS unsigned char* lds, const Args& a, int l, int which, const u16* A, const u16* Bt, int K, const float* Fin, u16* HBo, u16* HB2, int rflags) {
    unsigned char* ws = a.ws;
    Gemm g; g.A = A; g.Bt = Bt; g.M = T; g.N = 1024; g.K = K;
    UE3 e; e.perm = 1; e.Fin = Fin; e.F = a.out; e.HBo = HBo; e.HB2 = HB2; e.sso = (float*)(ws + WS_SS) + (size_t)(l * 3 + which + 1) * T; e.ssp = (float*)(ws + WS_SSP); e.cnt = (unsigned*)(ws + WS_CNT) + (size_t)(l * 3 + which) * 64; e.rflags = rflags;
    StaticOrder S; S.init(T, 1024, (int)gridDim.x, (int)blockIdx.x);
    for (int i = 0; ; ++i) { OneUnit O; if (!S.next(i, O.u)) break; __syncthreads(); gemm_phase<UE3, OneUnit, false>(mk_tid, lds, g, O, e, nullptr); }
}
DI void init_phase(int mk_tid, LAS unsigned char* lds, const Args& a) {
    unsigned char* ws = a.ws; float* SS = (float*)(ws + WS_SS);
    for (int i = blockIdx.x * 512 + mk_tid; i < 1024; i += gridDim.x * 512) ((unsigned*)(ws + WS_CNT))[i] = 0u;
    cvt_set(mk_tid, lds, a, 0, 0);
    raw_rows(mk_tid, a.in[0], (u16*)ws, SS);
    norm_rows(mk_tid, a.in[1], a.in[27], (u16*)(ws + WS_MEMN), 2048, nullptr, nullptr, nullptr);
}
DI void other_phase(int mk_tid, LAS unsigned char* lds, const Args& a, int l, int sub) {
    unsigned char* ws = a.ws;
    u16* A0 = (u16*)ws; u16* A1 = (u16*)(ws + U); u16* A2 = (u16*)(ws + 2 * U); u16* A3 = (u16*)(ws + 3 * U); u16* A4 = (u16*)(ws + 4 * U); u16* A5 = (u16*)(ws + 5 * U); u16* A6 = (u16*)(ws + 6 * U);
    u16* WT = (u16*)(ws + WS_WT); u16* KMEM = A3; u16* VTM = A3 + 2097152;
    float* IFG = (float*)(ws + WS_IFG); float* GZ = (float*)(ws + WS_GZ); float* GM = (float*)(ws + WS_GM); float* GE = (float*)(ws + WS_GE); float* GMS = (float*)(ws + WS_GMS); float* GML = (float*)(ws + WS_GML); float* NVEC = (float*)(ws + WS_NVEC);
    float* SS = (float*)(ws + WS_SS);
    const int tid = mk_tid, wid = tid >> 6;
    const size_t MW = (size_t)1024 * 1024;
    switch (sub) {
    case S_GQK: {
        ifg_rows(mk_tid, lds, A0, SS + (size_t)(l * 3) * T, a.in[3] + (size_t)l * 1024 * 8200, a.in[2] + l * 1024, a.in[13] + l * 8, IFG);
        Gemm g; g.A = A0; g.Bt = WT; g.M = T; g.N = 2048; g.K = 1024;
        UE6 e6; e6.perm = 0; e6.qc = A6; e6.kc = A5; e6.HB = (float*)(ws + WS_HBQ); e6.cw = a.in[11] + l * 8192; e6.cb = a.in[12] + l * 2048; e6.ss = SS + (size_t)(l * 3) * T;
        StaticOrder S; S.init(T, 2048, (int)gridDim.x, (int)blockIdx.x);
        for (int i = 0; ; ++i) { OneUnit O; if (!S.next(i, O.u)) break; __syncthreads(); gemm_phase<UE6, OneUnit, false>(mk_tid, lds, g, O, e6, nullptr); }
    } break;
    case S_STATE: mlstm_state_phase(mk_tid, lds, A5, A2, (float*)(ws + WS_GW), GMS, GML, A3, NVEC, IFG, GZ, GM, GE, (const float*)(ws + WS_HBQ), a.in[11] + l * 8192, a.in[12] + l * 2048); break;
    case S_OUT: mlstm_out_phase(mk_tid, lds, A6, A5, A2, A3, NVEC, A1, GZ, GM, GE, GMS, a.in[14] + l * 1024, 0, (const float*)(ws + WS_HBQ), a.in[11] + l * 8192, a.in[12] + l * 2048); break;
    case S_RG0: case S_RG1:
        if (sub == S_RG0) { cvt_set(mk_tid, lds, a, l, 1); __syncthreads(); }
        rglru_phase(mk_tid, lds, A1, A2, a.in[4] + l * 4096, a.in[5] + l * 1024, a.in[6] + l * 65536, a.in[7] + l * 1024, a.in[8] + l * 65536, a.in[9] + l * 1024, a.in[10] + l * 1024, A5, sub - S_RG0, (float*)(ws + WS_SUMA), (float*)(ws + WS_SUMH)); break;
    case S_ATT: cvt_set(mk_tid, lds, a, l, 2); __syncthreads(); xattn_phase(mk_tid, lds, A0, KMEM, VTM, A2); break;
    case S_GUP: {
        cvt_set(mk_tid, lds, a, l, 3);
        Gemm g; g.A = A0; g.Bt = WT + 4 * MW; g.M = T; g.N = 6144; g.K = 1024;
        UE5 e5; e5.perm = 0; e5.act = A4; e5.HB = (float*)A1; e5.cw = a.in[24] + l * 18432; e5.cb = a.in[25] + l * 6144; e5.ss = SS + (size_t)(l * 3 + 2) * T;
        StaticOrder S; S.init(T, 6144, (int)gridDim.x, (int)blockIdx.x);
        for (int i = 0; ; ++i) { OneUnit O; if (!S.next(i, O.u)) break; __syncthreads(); gemm_phase<UE5, OneUnit, false>(mk_tid, lds, g, O, e5, nullptr); }
    } break;
    case S_GDOWN: {
        if (l == 0) cvt_set(mk_tid, lds, a, 1, 0);
        StaticOrder S; S.init(T, 1024, (int)gridDim.x, (int)blockIdx.x);
        for (int i = 0; ; ++i) { Unit u; if (!S.next(i, u)) break; ffn_fix_tile(mk_tid, (const float*)A1, a.in[24] + l * 18432, a.in[25] + l * 6144, A4, u.pm); }
        asm volatile("s_waitcnt vmcnt(0)" ::: "memory"); __syncthreads();
        resid_gemm(mk_tid, lds, a, l, 2, A4, WT + 11 * MW, 3072, (const float*)A0, A0, (l == 0) ? (u16*)a.out : nullptr, 1);
    } break;
    case S_GMIX: resid_gemm(mk_tid, lds, a, l, 0, A0, WT + 10 * MW, 1024, (l == 0) ? a.in[0] : a.out, A1, nullptr, (l == 0) ? 0 : 1); break;
    case S_GWO: resid_gemm(mk_tid, lds, a, l, 1, A2, WT + 3 * MW, 1024, (const float*)A1, A0, nullptr, 1); break;
    default: break;
    }
}

__global__ void __launch_bounds__(512, 2) mk_fwd(Args a) {
    extern __shared__ __attribute__((aligned(16))) unsigned char shm[];
    LAS unsigned char* lds = (LAS unsigned char*)shm;
    cg::grid_group grid = cg::this_grid();
    if (a.ph_hi < 0) grid.sync();
    volatile LAS unsigned* xst = (volatile LAS unsigned*)(lds + LDS_BYTES - 16);
    if (threadIdx.x == 0) { xst[0] = 0u; xst[1] = 0u; }
    __syncthreads();
    const XcdBarrier xbar = xcd_barrier_post((unsigned*)(a.ws + WS_BAR), xst);
    int tid0 = threadIdx.x;
    for (int ph = a.ph_lo; ph < a.ph_hi; ++ph) {
        if (ph > a.ph_lo) xcd_barrier(xbar);
        asm volatile("" : "+v"(tid0)); const int mk_tid = tid0;
        if (ph == 0) { init_phase(mk_tid, lds, a); continue; }
        if (ph == NPH - 1) { final_norm(mk_tid, (const u16*)a.ws, a.out, a.in[28]); continue; }
        const int l = (ph - 1) / PL, sub = (ph - 1) % PL;
        const int ng = gemm_count(sub);
        other_phase(mk_tid, lds, a, l, sub);
#if PROBE_DUP
        { const int bit = (sub == S_GQK || sub == S_GUP) ? 2 : (sub == S_STATE) ? 4 : (sub == S_RG0 || sub == S_RG1) ? 8 : (sub == S_ATT) ? 16 : (sub == S_GDOWN) ? 32 : 0;
          if (PROBE_DUP & bit) { __syncthreads(); other_phase(mk_tid, lds, a, l, sub); } }
        if (PROBE_DUP & 128) xcd_barrier(xbar);
        if (PROBE_DUP & 1) for (int i = 0; i < ng; ++i) {
            GD d = get_gd(a, l, sub, i); d.e.kind = 4;
            __syncthreads();
            Gemm g; g.A = d.A; g.Bt = d.Bt; g.M = d.M; g.N = d.N; g.K = d.K;
            StaticOrder S; S.init(d.M, d.N, (int)gridDim.x, (int)((blockIdx.x + d.cshift) % gridDim.x));
            gemm_phase<UE, StaticOrder, false>(mk_tid, lds, g, S, d.e, nullptr);
        }
#endif
        for (int i = 0; i < ng; ++i) {
            GD d = get_gd(a, l, sub, i);
            __syncthreads();
            Gemm g; g.A = d.A; g.Bt = d.Bt; g.M = d.M; g.N = d.N; g.K = d.K;
            StaticOrder S; S.init(d.M, d.N, (int)gridDim.x, (int)((blockIdx.x + d.cshift) % gridDim.x));
            gemm_phase<UE, StaticOrder, false>(mk_tid, lds, g, S, d.e, nullptr);
        }
    }
}

extern "C" void kernel_launch(void* const* d_in, const int* in_sizes, int n_in, void* d_out, int out_size, void* d_ws, size_t ws_size, hipStream_t stream) {
    static int grid = 0;
    if (grid == 0) {
        if (n_in != 29 || out_size != T * 1024 || ws_size < WS_END) { fprintf(stderr, "kernel_launch: unexpected shapes (n_in %d out %d ws %zu need %zu)\n", n_in, out_size, ws_size, (size_t)WS_END); grid = -1; return; }
        int dev = 0, cus = 0, per_cu = 0;
        hipGetDevice(&dev); hipDeviceGetAttribute(&cus, hipDeviceAttributeMultiprocessorCount, dev);
        hipFuncSetAttribute((const void*)mk_fwd, hipFuncAttributeMaxDynamicSharedMemorySize, LDS_BYTES);
        hipOccupancyMaxActiveBlocksPerMultiprocessor(&per_cu, (const void*)mk_fwd, 512, LDS_BYTES);
        if (per_cu < 1) per_cu = 1;
        grid = cus * per_cu;
        (void)hipGetLastError();
    }
    if (grid < 0) return;
    Args a{};
    for (int i = 0; i < 29; ++i) a.in[i] = (const float*)d_in[i];
    a.out = (float*)d_out; a.ws = (unsigned char*)d_ws;
#if defined(MK_PER_PHASE)
    for (int ph = 0; ph < NPH; ++ph) { a.ph_lo = ph; a.ph_hi = ph + 1; hipLaunchKernelGGL(mk_fwd, dim3(grid), dim3(512), LDS_BYTES, stream, a); }
#else
    a.ph_lo = 0; a.ph_hi = NPH;
    (void)hipMemsetAsync((unsigned char*)d_ws + WS_BAR, 0, 16384, stream);
    void* args[] = {&a};
    hipError_t e = hipLaunchCooperativeKernel((void*)mk_fwd, dim3(grid), dim3(512), args, LDS_BYTES, stream);
    if (e != hipSuccess) fprintf(stderr, "cooperative launch failed: %s (grid %d)\n", hipGetErrorString(e), grid);
#endif
}
```

```cpp
#include <hip/hip_runtime.h>
#include <hip/hip_cooperative_groups.h>
#include <cstdio>
namespace cg = cooperative_groups;
namespace pg8 {
#define PG8_LAS __attribute__((address_space(3)))
typedef unsigned short bf16_t;
typedef short bf16x8 __attribute__((ext_vector_type(8)));
typedef float f32x4 __attribute__((ext_vector_type(4)));
typedef unsigned u32x4 __attribute__((ext_vector_type(4)));
constexpr int BM = 256, BK = 64, HALF = 128, HTB = HALF * BK * 2  , STAGE_BYTES = 8 * HTB, NXCD = 8, WGM = 8;

__host__ __device__ __forceinline__ int lds_byte(int r, int c) { const int st = (r >> 4) * 2 + (c >> 5), rr = r & 15, cc = c & 31, ob = rr * 64 + cc * 2; return st * 1024 + (ob ^ (((ob >> 9) & 1) << 5)); }
__host__ __device__ __forceinline__ void stage_rc(int b, int& R, int& C) { const int st = b / 1024, sb = b % 1024, swz = sb ^ (((sb >> 9) & 1) << 5); R = (st >> 1) * 16 + swz / 64; C = (st & 1) * 32 + (swz % 64) / 2; }
__host__ __device__ __forceinline__ int perm32(int rho) { const int n = rho >> 4, i = rho & 15; return 8 * (i >> 2) + 4 * n + (i & 3); }

struct Unit { int pm, pn; };
struct Gemm { const bf16_t* A; const bf16_t* Bt; int M, N, K; };

struct StaticOrder {
    int nM, nN, nwg, G, c;
    __host__ __device__ void init(int M, int N, int G_, int c_) { nM = M / BM; nN = N / BM; nwg = nM * nN; G = G_; c = c_; }
    __host__ __device__ bool next(int i, Unit& u) const {
        const long L = (long)i * G + c; if (L >= nwg) return false;
        int wgid = (int)L; { const int q = nwg / NXCD, r = nwg % NXCD, xcd = wgid % NXCD, off = wgid / NXCD; wgid = (xcd < r ? xcd * (q + 1) : r * (q + 1) + (xcd - r) * q) + off; }
        const int nig = WGM * nN, gid = wgid / nig, fm = gid * WGM, gsz = (nM - fm) < WGM ? (nM - fm) : WGM;
        u.pm = fm + ((wgid % nig) % gsz); u.pn = (wgid % nig) / gsz; return true;
    }
    __device__ __forceinline__ void a_ready(const Unit&) const {}
    __device__ __forceinline__ void done(const Unit&) const {}
};
__device__ __forceinline__ unsigned cvt_pk_bf16(float lo, float hi) { unsigned r; asm volatile("v_cvt_pk_bf16_f32 %0, %1, %2" : "=v"(r) : "v"(lo), "v"(hi)); return r; }
typedef float f32x2 __attribute__((ext_vector_type(2)));
template <class Epi, class Sched, bool STAMP = false>
__device__ __forceinline__ void gemm_phase(int mk_tid, PG8_LAS unsigned char* lds, const Gemm g, const Sched& S, const Epi& E, unsigned long long* stamps) {
    const int tid = mk_tid, wid = __builtin_amdgcn_readfirstlane(tid >> 6), lane = tid & 63, wr = wid >> 2, wc = wid & 3, fr = lane & 15, fq = lane >> 4;
    const int K = g.K, nt = K / BK;
    int ts_lo = 0, ts_hi = 0, nts = 0; const unsigned long long rt_entry = STAMP ? (unsigned long long)wall_clock64() : 0ull;
#define PG8_STAMP() do { if (STAMP && wid == 0 && nts < 64) { const unsigned long long _c = (unsigned long long)clock64(); \
        ts_lo = (lane == nts) ? (int)(unsigned)_c : ts_lo; ts_hi = (lane == nts) ? (int)(unsigned)(_c >> 32) : ts_hi; ++nts; } } while (0)
    PG8_STAMP();
    unsigned voffA[2], voffB[2];
#pragma unroll
    for (int i = 0; i < 2; ++i) { int R, C; stage_rc(tid * 16 + i * 8192, R, C); const int Rb = E.perm ? ((R & ~31) + perm32(R & 31)) : R;
        voffA[i] = (unsigned)(R * K + C) * 2u; voffB[i] = (unsigned)(Rb * K + C) * 2u; }
    const size_t kstep = (size_t)(BK * 2);
    const size_t hstep = (size_t)HALF * K * 2;
    const size_t tstep = 2 * hstep;
    const unsigned ldsw = (unsigned)wid * 1024u;
    const int aoff = lds_byte(wr * 64 + fr, fq * 8), boff = lds_byte(wc * 32 + fr, fq * 8);
#define PG8_SA(b, h) (((b) * 2 + (h)) * HTB)
#define PG8_SB(b, h) ((4 + (b) * 2 + (h)) * HTB)
#define PG8_STAGE(bufoff, gbase, voff) do { _Pragma("unroll") for (int _i = 0; _i < 2; ++_i) \
        __builtin_amdgcn_global_load_lds((const unsigned*)((const char*)(gbase) + (voff)[_i]), (PG8_LAS unsigned*)(lds + (bufoff) + ldsw + _i * 8192), 16, 0, 0); } while (0)
#define PG8_LDA(dst, b, h) do { _Pragma("unroll") for (int m = 0; m < 4; ++m) _Pragma("unroll") for (int k = 0; k < 2; ++k) dst[m][k] = *(const PG8_LAS bf16x8*)(lds + PG8_SA(b, h) + aoff + m * 2048 + k * 1024); } while (0)
#define PG8_LDB(dst, b, h) do { _Pragma("unroll") for (int n = 0; n < 2; ++n) _Pragma("unroll") for (int k = 0; k < 2; ++k) dst[n][k] = *(const PG8_LAS bf16x8*)(lds + PG8_SB(b, h) + boff + n * 2048 + k * 1024); } while (0)
#define PG8_MMA(ai, bj, At, Bt) do { __builtin_amdgcn_s_setprio(1); _Pragma("unroll") for (int m = 0; m < 4; ++m) _Pragma("unroll") for (int n = 0; n < 2; ++n) _Pragma("unroll") for (int k = 0; k < 2; ++k) \
        acc[ai][bj][m][n] = __builtin_amdgcn_mfma_f32_16x16x32_bf16(Bt[n][k], At[m][k], acc[ai][bj][m][n], 0, 0, 0); __builtin_amdgcn_s_setprio(0); } while (0)
#define PG8_WAIT_V(n) asm volatile("s_waitcnt vmcnt(" #n ")" ::: "memory")
#define PG8_WAIT_L(n) asm volatile("s_waitcnt lgkmcnt(" #n ")" ::: "memory")
#define PG8_BAR __builtin_amdgcn_s_barrier()
#define PG8_SCHED __builtin_amdgcn_sched_barrier(0)
    Unit cur, nxt; int ui = 0;
    if (!S.next(0, cur)) return;
    f32x4 acc[2][2][4][2];
#pragma unroll
    for (int a = 0; a < 2; ++a)
#pragma unroll
        for (int b = 0; b < 2; ++b)
#pragma unroll
            for (int m = 0; m < 4; ++m)
#pragma unroll
                for (int n = 0; n < 2; ++n) acc[a][b][m][n] = (f32x4){0.f, 0.f, 0.f, 0.f};
    bf16x8 At[4][2], B0[2][2], B1[2][2];
    const char* cA = (const char*)g.A + (size_t)cur.pm * tstep; const char* cB = (const char*)g.Bt + (size_t)cur.pn * tstep;
    S.a_ready(cur);
    PG8_STAGE(PG8_SB(0, 0), cB, voffB); PG8_STAGE(PG8_SA(0, 0), cA, voffA); PG8_STAGE(PG8_SB(0, 1), cB + hstep, voffB); PG8_STAGE(PG8_SA(0, 1), cA + hstep, voffA);
    if (wr == 1) PG8_BAR;
    PG8_WAIT_V(4); PG8_BAR;
    PG8_STAGE(PG8_SB(1, 0), cB + kstep, voffB); PG8_STAGE(PG8_SA(1, 0), cA + kstep, voffA); PG8_STAGE(PG8_SB(1, 1), cB + hstep + kstep, voffB);
    PG8_WAIT_V(6); PG8_BAR;
    PG8_STAMP();
    for (;;) {
        const bool has_next = S.next(ui + 1, nxt);
        const char* nA = has_next ? (const char*)g.A + (size_t)nxt.pm * tstep : cA; const char* nB = has_next ? (const char*)g.Bt + (size_t)nxt.pn * tstep : cB;
        for (int t = 0; t < nt; t += 2) {
            const bool last = (t == nt - 2);
            const char* a1 = cA + (size_t)(t + 1) * kstep;
            const char* a2 = last ? nA : cA + (size_t)(t + 2) * kstep; const char* b2 = last ? nB : cB + (size_t)(t + 2) * kstep;
            const char* a3 = a2 + kstep; const char* b3 = b2 + kstep;
            if (last && has_next) S.a_ready(nxt);
            PG8_LDB(B0, 0, 0); PG8_SCHED; PG8_LDA(At, 0, 0); PG8_STAGE(PG8_SA(1, 1), a1 + hstep, voffA);
            PG8_WAIT_L(8); PG8_BAR; PG8_WAIT_L(0); PG8_MMA(0, 0, At, B0); PG8_BAR; PG8_SCHED;
            PG8_LDB(B1, 0, 1); PG8_STAGE(PG8_SB(0, 0), b2, voffB);
            PG8_BAR; PG8_WAIT_L(0); PG8_MMA(0, 1, At, B1); PG8_BAR;
            PG8_LDA(At, 0, 1); PG8_STAGE(PG8_SA(0, 0), a2, voffA);
            PG8_BAR; PG8_WAIT_L(0); PG8_MMA(1, 0, At, B0); PG8_BAR; PG8_SCHED;
            PG8_STAGE(PG8_SB(0, 1), b2 + hstep, voffB);
            PG8_WAIT_V(6); PG8_BAR; PG8_MMA(1, 1, At, B1); PG8_BAR;
            PG8_LDB(B0, 1, 0); PG8_SCHED; PG8_LDA(At, 1, 0); PG8_STAGE(PG8_SA(0, 1), a2 + hstep, voffA);
            PG8_WAIT_L(8); PG8_BAR; PG8_WAIT_L(0); PG8_MMA(0, 0, At, B0); PG8_BAR; PG8_SCHED;
            PG8_LDB(B1, 1, 1); PG8_STAGE(PG8_SB(1, 0), b3, voffB);
            PG8_BAR; PG8_WAIT_L(0); PG8_MMA(0, 1, At, B1); PG8_BAR;
            PG8_LDA(At, 1, 1); PG8_STAGE(PG8_SA(1, 0), a3, voffA);
            PG8_BAR; PG8_WAIT_L(0); PG8_MMA(1, 0, At, B0); PG8_BAR; PG8_SCHED;
            PG8_STAGE(PG8_SB(1, 1), b3 + hstep, voffB);
            PG8_WAIT_V(6); PG8_BAR; PG8_MMA(1, 1, At, B1); PG8_BAR;
        }
        PG8_STAMP();
        if constexpr (!Epi::AFTER_DRAIN) { E(acc, cur, wr, wc, fr, fq); S.done(cur); }
        PG8_STAMP();
        if (!has_next) break;
#pragma unroll
        for (int a = 0; a < 2; ++a)
#pragma unroll
            for (int b = 0; b < 2; ++b)
#pragma unroll
                for (int m = 0; m < 4; ++m)
#pragma unroll
                    for (int n = 0; n < 2; ++n) acc[a][b][m][n] = (f32x4){0.f, 0.f, 0.f, 0.f};
        cur = nxt; cA = nA; cB = nB; ++ui;
    }
    PG8_WAIT_V(0);
    if (wr == 0) PG8_BAR;
    PG8_BAR;

    if constexpr (Epi::AFTER_DRAIN) { E.fused(acc, cur, wr, wc, fr, fq, lds, wid, lane); }
    PG8_STAMP();
    if (STAMP && wid == 0) { stamps[lane] = lane < nts ? (((unsigned long long)(unsigned)ts_hi << 32) | (unsigned)ts_lo) : 0ull;
        if (lane == 62) stamps[62] = rt_entry; if (lane == 63) stamps[63] = (unsigned long long)wall_clock64(); }
#undef PG8_STAMP
#undef PG8_SA
#undef PG8_SB
#undef PG8_STAGE
#undef PG8_LDA
#undef PG8_LDB
#undef PG8_MMA
#undef PG8_WAIT_V
#undef PG8_WAIT_L
#undef PG8_BAR
#undef PG8_SCHED
}
}

using namespace pg8;
#define DI __device__ __forceinline__
#define LAS PG8_LAS
typedef unsigned short u16;
typedef unsigned u32x2 __attribute__((ext_vector_type(2)));
typedef short s16x4 __attribute__((ext_vector_type(4)));

constexpr int T = 16384, SEQ = 2048;
constexpr int LDS_BYTES = 147456;
constexpr size_t U = (size_t)T * 1024 * 2;
constexpr size_t WS_WT = 7 * U;
constexpr size_t WS_MEMN = WS_WT + (size_t)14336 * 2048;
constexpr size_t WS_SS = WS_MEMN + 4194304;
constexpr size_t WS_SSP = WS_SS + (size_t)7 * T * 4;
constexpr size_t WS_CNT = WS_SSP + (size_t)T * 16 * 4;
constexpr size_t WS_IFG = WS_CNT + 4096;
constexpr size_t WS_GZ = WS_IFG + (size_t)T * 8 * 4;
constexpr size_t WS_GM = WS_GZ + 262144;
constexpr size_t WS_GE = WS_GM + 262144;
constexpr size_t WS_GMS = WS_GE + 262144;
constexpr size_t WS_GML = WS_GMS + 2048;
constexpr size_t WS_NVEC = WS_GML + 2048;
constexpr size_t WS_GW = WS_NVEC + 524288;
constexpr size_t WS_SUMA = WS_GW + 262144;
constexpr size_t WS_SUMH = WS_SUMA + 524288;
constexpr size_t WS_BAR = WS_SUMH + 524288;
constexpr size_t WS_HBQ = WS_BAR + 16384;
constexpr size_t WS_END = WS_HBQ + (size_t)64 * 6 * 2048 * 4;
enum { S_GQK = 0, S_STATE, S_OUT, S_GXR, S_RG0, S_RG1, S_GAB, S_GMIX, S_GQKV, S_GWO, S_GUP, S_GDOWN, PL };
constexpr int NPH = 2 * PL + 2;
#ifndef PROBE_DUP
#define PROBE_DUP 0
#endif

struct Args { const float* in[29]; float* out; unsigned char* ws; int ph_lo, ph_hi; };

DI float bf2f(u16 v) { return __uint_as_float(((unsigned)v) << 16); }
DI float bflo(unsigned v) { return __uint_as_float(v << 16); }
DI float bfhi(unsigned v) { return __uint_as_float(v & 0xffff0000u); }
DI u16 f2bf(float f) { unsigned r; asm("v_cvt_pk_bf16_f32 %0, %1, %1" : "=v"(r) : "v"(f)); return (u16)r; }
DI unsigned pk2(float lo, float hi) { unsigned r; asm("v_cvt_pk_bf16_f32 %0, %1, %2" : "=v"(r) : "v"(lo), "v"(hi)); return r; }
DI float sigm(float x) { return __builtin_amdgcn_rcpf(1.f + __expf(-x)); }
DI float gelu_t(float x) { const float u = 1.5957691216f * (x + 0.044715f * x * x * x); return x * __builtin_amdgcn_rcpf(1.f + __expf(-u)); }
DI float wsum(float v) { v += __shfl_xor(v, 1); v += __shfl_xor(v, 2); v += __shfl_xor(v, 4); v += __shfl_xor(v, 8); v += __shfl_xor(v, 16); v += __shfl_xor(v, 32); return v; }
DI void unpack8(const u32x4 r, float* f) { f[0] = bflo(r.x); f[1] = bfhi(r.x); f[2] = bflo(r.y); f[3] = bfhi(r.y); f[4] = bflo(r.z); f[5] = bfhi(r.z); f[6] = bflo(r.w); f[7] = bfhi(r.w); }
DI f32x4 mfma16(bf16x8 a, bf16x8 b, f32x4 c) { return __builtin_amdgcn_mfma_f32_16x16x32_bf16(a, b, c, 0, 0, 0); }

struct UE {
    static constexpr bool AFTER_DRAIN = false;
    int perm, kind; u16* O; int ldc, split; const u16* gate; float* F; const float* Fin; const float* ss; int smode; u16* HBo; float* sso; float* ssp; unsigned* cnt; int rflags;
    DI void operator()(const f32x4 (&acc)[2][2][4][2], const Unit& u, int wr, int wc, int fr, int fq) const {
        const int row0 = u.pm * 256 + wr * 64 + fr;
        if (kind == 4) return;
        const int col0 = u.pn * 256 + wc * 32 + 8 * fq;
        if (kind == 0) {
            float rs[2][4]; f32x4 cf[2][2];
#pragma unroll
            for (int ai = 0; ai < 2; ++ai)
#pragma unroll
                for (int m = 0; m < 4; ++m) rs[ai][m] = (smode == 1) ? ss[row0 + ai * 128 + m * 16] : 1024.f - 1e-6f * 1024.f;
#pragma unroll
            for (int bj = 0; bj < 2; ++bj)
#pragma unroll
                for (int n = 0; n < 2; ++n) cf[bj][n] = (smode == 2) ? *(const f32x4*)(ss + col0 + bj * 128 + n * 4) : (f32x4){1024.f - 1e-6f * 1024.f, 1024.f - 1e-6f * 1024.f, 1024.f - 1e-6f * 1024.f, 1024.f - 1e-6f * 1024.f};
#pragma unroll
            for (int ai = 0; ai < 2; ++ai)
#pragma unroll
                for (int m = 0; m < 4; ++m) rs[ai][m] = rsqrtf(rs[ai][m] * (1.f / 1024.f) + 1e-6f);
#pragma unroll
            for (int bj = 0; bj < 2; ++bj)
#pragma unroll
                for (int n = 0; n < 2; ++n)
#pragma unroll
                    for (int j = 0; j < 4; ++j) cf[bj][n][j] = rsqrtf(cf[bj][n][j] * (1.f / 1024.f) + 1e-6f);
            __builtin_amdgcn_sched_barrier(0);
#pragma unroll
            for (int ai = 0; ai < 2; ++ai)
#pragma unroll
                for (int m = 0; m < 4; ++m) { const int row = row0 + ai * 128 + m * 16;
#pragma unroll
                    for (int bj = 0; bj < 2; ++bj) { const int col = col0 + bj * 128;
                        u16* p = split ? O + (size_t)(col >> 10) * ((size_t)T * 1024) + (size_t)row * 1024 + (col & 1023) : O + (size_t)row * ldc + col;
                        const f32x4 v0 = acc[ai][bj][m][0] * rs[ai][m] * cf[bj][0], v1 = acc[ai][bj][m][1] * rs[ai][m] * cf[bj][1];
                        u32x4 w; w.x = cvt_pk_bf16(v0[0], v0[1]); w.y = cvt_pk_bf16(v0[2], v0[3]); w.z = cvt_pk_bf16(v1[0], v1[1]); w.w = cvt_pk_bf16(v1[2], v1[3]);
                        *(u32x4*)p = w; } }
        } else {
#pragma unroll
            for (int aim = 0; aim < 4; ++aim) { const int ai = aim >> 1, mb = (aim & 1) * 2;
                f32x4 ld[4][2][2];
#pragma unroll
                for (int m = mb; m < mb + 2; ++m)
#pragma unroll
                    for (int bj = 0; bj < 2; ++bj) { const size_t idx = (size_t)(row0 + ai * 128 + m * 16) * 1024 + col0 + bj * 128;
                        if (kind == 3) { if (rflags & 1) { ld[m][bj][0] = *(const f32x4*)((const u16*)Fin + idx); ld[m][bj][1] = (f32x4){0.f, 0.f, 0.f, 0.f}; } else { ld[m][bj][0] = *(const f32x4*)(Fin + idx); ld[m][bj][1] = *(const f32x4*)(Fin + idx + 4); } }
                        else { ld[m][bj][0] = *(const f32x4*)(gate + idx); ld[m][bj][1] = (kind == 2) ? *(const f32x4*)((const u16*)Fin + idx) : (f32x4){0.f, 0.f, 0.f, 0.f}; } }
                __builtin_amdgcn_sched_barrier(0);
#pragma unroll
                for (int m = mb; m < mb + 2; ++m) { const int row = row0 + ai * 128 + m * 16; float psq = 0.f;
#pragma unroll
                    for (int bj = 0; bj < 2; ++bj) { const size_t idx = (size_t)row * 1024 + col0 + bj * 128; const f32x4 v0 = acc[ai][bj][m][0], v1 = acc[ai][bj][m][1];
                        if (kind == 3) { f32x4 b0 = ld[m][bj][0], b1 = ld[m][bj][1];
                            if (rflags & 1) { const u32x4 rb = __builtin_bit_cast(u32x4, ld[m][bj][0]); b0 = (f32x4){bflo(rb.x), bfhi(rb.x), bflo(rb.y), bfhi(rb.y)}; b1 = (f32x4){bflo(rb.z), bfhi(rb.z), bflo(rb.w), bfhi(rb.w)}; }
                            const f32x4 h0 = b0 + v0, h1 = b1 + v1; if (rflags & 2) { *(f32x4*)(F + idx) = h0; *(f32x4*)(F + idx + 4) = h1; }
                            u32x4 hw; hw.x = cvt_pk_bf16(h0[0], h0[1]); hw.y = cvt_pk_bf16(h0[2], h0[3]); hw.z = cvt_pk_bf16(h1[0], h1[1]); hw.w = cvt_pk_bf16(h1[2], h1[3]); *(u32x4*)(HBo + idx) = hw;
                            psq += (h0[0] * h0[0] + h0[1] * h0[1]) + (h0[2] * h0[2] + h0[3] * h0[3]) + (h1[0] * h1[0] + h1[1] * h1[1]) + (h1[2] * h1[2] + h1[3] * h1[3]); }
                        else { const u32x4 gr = __builtin_bit_cast(u32x4, ld[m][bj][0]);
                            f32x4 s0, s1; s0[0] = sigm(bflo(gr.x)); s0[1] = sigm(bfhi(gr.x)); s0[2] = sigm(bflo(gr.y)); s0[3] = sigm(bfhi(gr.y)); s1[0] = sigm(bflo(gr.z)); s1[1] = sigm(bfhi(gr.z)); s1[2] = sigm(bflo(gr.w)); s1[3] = sigm(bfhi(gr.w));
                            f32x4 r0 = s0 * v0, r1 = s1 * v1;
                            if (kind == 2) { const u32x4 yb = __builtin_bit_cast(u32x4, ld[m][bj][1]);
                                r0[0] += bflo(yb.x); r0[1] += bfhi(yb.x); r0[2] += bflo(yb.y); r0[3] += bfhi(yb.y); r1[0] += bflo(yb.z); r1[1] += bfhi(yb.z); r1[2] += bflo(yb.w); r1[3] += bfhi(yb.w); }
                            u32x4 w; w.x = cvt_pk_bf16(r0[0], r0[1]); w.y = cvt_pk_bf16(r0[2], r0[3]); w.z = cvt_pk_bf16(r1[0], r1[1]); w.w = cvt_pk_bf16(r1[2], r1[3]);
                            *(u32x4*)(O + idx) = w; } }
                    if (kind == 3) { psq += __shfl_xor(psq, 16); psq += __shfl_xor(psq, 32); if (fq == 0) __hip_atomic_store(ssp + (size_t)row * 16 + u.pn * 4 + wc, psq, __ATOMIC_RELAXED, __HIP_MEMORY_SCOPE_AGENT); } }
                __builtin_amdgcn_sched_barrier(0);
            }
            if (kind == 3) {
                asm volatile("s_waitcnt vmcnt(0)" ::: "memory");
                const int lane = fq * 16 + fr; unsigned old = 0u;
                if (lane == 0) old = __hip_atomic_fetch_add(cnt + u.pm, 1u, __ATOMIC_RELAXED, __HIP_MEMORY_SCOPE_AGENT);
                old = (unsigned)__builtin_amdgcn_readfirstlane((int)old);
                if (old == 31u) {
                    for (int r = lane; r < 256; r += 64) { const size_t row = (size_t)u.pm * 256 + r; float t = 0.f;
#pragma unroll 4
                        for (int k = 0; k < 16; ++k) t += __hip_atomic_load(ssp + row * 16 + k, __ATOMIC_RELAXED, __HIP_MEMORY_SCOPE_AGENT);
                        sso[row] = t; } }
            }
        }
    }
};
struct UE3 {
    static constexpr bool AFTER_DRAIN = true;
    int perm; const float* Fin; float* F; u16* HBo; u16* HB2; float* sso; float* ssp; unsigned* cnt; int rflags;
    DI void operator()(const f32x4 (&)[2][2][4][2], const Unit&, int, int, int, int) const {}
    DI void fused(const f32x4 (&acc)[2][2][4][2], const Unit& u, int wr, int wc, int fr, int fq, LAS unsigned char* lds, int wid, int lane) const {
        LAS float* P = (LAS float*)lds;
        LAS unsigned* flag = (LAS unsigned*)(lds + 8192);
        const int tid = wid * 64 + lane, row0 = u.pm * 256 + wr * 64 + fr, col0 = u.pn * 256 + wc * 32 + 8 * fq;
#pragma unroll
        for (int aim = 0; aim < 4; ++aim) { const int ai = aim >> 1, mb = (aim & 1) * 2;
            f32x4 ld[4][2][2];
#pragma unroll
            for (int m = mb; m < mb + 2; ++m)
#pragma unroll
                for (int bj = 0; bj < 2; ++bj) { const size_t idx = (size_t)(row0 + ai * 128 + m * 16) * 1024 + col0 + bj * 128;
                    if (rflags & 1) { ld[m][bj][0] = *(const f32x4*)((const u16*)Fin + idx); ld[m][bj][1] = (f32x4){0.f, 0.f, 0.f, 0.f}; } else { ld[m][bj][0] = *(const f32x4*)(Fin + idx); ld[m][bj][1] = *(const f32x4*)(Fin + idx + 4); } }
            __builtin_amdgcn_sched_barrier(0);
#pragma unroll
            for (int m = mb; m < mb + 2; ++m) { const int row = row0 + ai * 128 + m * 16; float psq = 0.f;
#pragma unroll
                for (int bj = 0; bj < 2; ++bj) { const size_t idx = (size_t)row * 1024 + col0 + bj * 128; const f32x4 v0 = acc[ai][bj][m][0], v1 = acc[ai][bj][m][1];
                    f32x4 b0 = ld[m][bj][0], b1 = ld[m][bj][1];
                    if (rflags & 1) { const u32x4 rb = __builtin_bit_cast(u32x4, ld[m][bj][0]); b0 = (f32x4){bflo(rb.x), bfhi(rb.x), bflo(rb.y), bfhi(rb.y)}; b1 = (f32x4){bflo(rb.z), bfhi(rb.z), bflo(rb.w), bfhi(rb.w)}; }
                    const f32x4 h0 = b0 + v0, h1 = b1 + v1; if (rflags & 2) { *(f32x4*)(F + idx) = h0; *(f32x4*)(F + idx + 4) = h1; }
                    u32x4 hw; hw.x = cvt_pk_bf16(h0[0], h0[1]); hw.y = cvt_pk_bf16(h0[2], h0[3]); hw.z = cvt_pk_bf16(h1[0], h1[1]); hw.w = cvt_pk_bf16(h1[2], h1[3]); *(u32x4*)(HBo + idx) = hw; if (HB2) *(u32x4*)(HB2 + idx) = hw;
                    psq += (h0[0] * h0[0] + h0[1] * h0[1]) + (h0[2] * h0[2] + h0[3] * h0[3]) + (h1[0] * h1[0] + h1[1] * h1[1]) + (h1[2] * h1[2] + h1[3] * h1[3]); }
                psq += __shfl_xor(psq, 16); psq += __shfl_xor(psq, 32);
                if (fq == 0) P[(ai * 128 + wr * 64 + m * 16 + fr) * 4 + wc] = psq; }
            __builtin_amdgcn_sched_barrier(0);
        }
        __syncthreads();
        if (tid < 256) { const float t = (P[tid * 4] + P[tid * 4 + 1]) + (P[tid * 4 + 2] + P[tid * 4 + 3]); __hip_atomic_store(ssp + ((size_t)u.pm * 256 + tid) * 4 + u.pn, t, __ATOMIC_RELAXED, __HIP_MEMORY_SCOPE_AGENT); }
        asm volatile("s_waitcnt vmcnt(0)" ::: "memory");
        __syncthreads();
        if (tid == 0) flag[0] = __hip_atomic_fetch_add(cnt + u.pm, 1u, __ATOMIC_RELAXED, __HIP_MEMORY_SCOPE_AGENT);
        __syncthreads();
        if (flag[0] == 3u && tid < 256) { const size_t row = (size_t)u.pm * 256 + tid;
            const float t0 = __hip_atomic_load(ssp + row * 4, __ATOMIC_RELAXED, __HIP_MEMORY_SCOPE_AGENT), t1 = __hip_atomic_load(ssp + row * 4 + 1, __ATOMIC_RELAXED, __HIP_MEMORY_SCOPE_AGENT),
                        t2 = __hip_atomic_load(ssp + row * 4 + 2, __ATOMIC_RELAXED, __HIP_MEMORY_SCOPE_AGENT), t3 = __hip_atomic_load(ssp + row * 4 + 3, __ATOMIC_RELAXED, __HIP_MEMORY_SCOPE_AGENT);
            sso[row] = (t0 + t1) + (t2 + t3); }
        __syncthreads();
    }
};
struct OneUnit { Unit u; DI bool next(int i, Unit& o) const { if (i != 0) return false; o = u; return true; } DI void a_ready(const Unit&) const {} DI void done(const Unit&) const {} };
struct UE5 {
    static constexpr bool AFTER_DRAIN = true;
    int perm; u16* act; float* HB; const float* cw; const float* cb; const float* ss;
    DI void operator()(const f32x4 (&)[2][2][4][2], const Unit&, int, int, int, int) const {}
    DI void fused(const f32x4 (&acc)[2][2][4][2], const Unit& u, int wr, int wc, int fr, int fq, LAS unsigned char* lds, int wid, int lane) const {
        LAS float* tl = (LAS float*)lds;
        LAS float* side = (LAS float*)(lds + 133120);
        const int tid = wid * 64 + lane, q = tid & 31, rsub = tid >> 5, ch = u.pn * 128 + q * 4;
        const f32x4 g0 = *(const f32x4*)(cw + ch), g1 = *(const f32x4*)(cw + 6144 + ch), g2 = *(const f32x4*)(cw + 12288 + ch), gb = *(const f32x4*)(cb + ch);
        const f32x4 u0 = *(const f32x4*)(cw + 3072 + ch), u1 = *(const f32x4*)(cw + 6144 + 3072 + ch), u2 = *(const f32x4*)(cw + 12288 + 3072 + ch), ub = *(const f32x4*)(cb + 3072 + ch);
#pragma unroll
        for (int ai = 0; ai < 2; ++ai) {
            if (ai == 1) {
                __syncthreads();
            }
#pragma unroll
            for (int m = 0; m < 4; ++m) { const float rs = rsqrtf(ss[u.pm * 256 + ai * 128 + wr * 64 + m * 16 + fr] * (1.f / 1024.f) + 1e-6f);
#pragma unroll
                for (int bj = 0; bj < 2; ++bj)
#pragma unroll
                    for (int n = 0; n < 2; ++n) *(LAS f32x4*)(tl + (wr * 64 + m * 16 + fr) * 260 + bj * 128 + wc * 32 + n * 16 + 4 * fq) = acc[ai][bj][m][n] * rs; }
            __syncthreads();
            if (ai == 0) {
                if (tid < 128) { const int rr = tid >> 6, cq = tid & 63; const f32x4 v = *(const LAS f32x4*)(tl + rr * 260 + cq * 4);
                    *(f32x4*)(HB + ((size_t)u.pm * 4 + rr) * 6144 + (cq < 32 ? u.pn * 128 + cq * 4 : 3072 + u.pn * 128 + (cq - 32) * 4)) = v; }
            } else {
                if (tid < 128) { const int rr = tid >> 6, cq = tid & 63; const f32x4 v = *(const LAS f32x4*)(tl + (126 + rr) * 260 + cq * 4);
                    *(f32x4*)(HB + ((size_t)u.pm * 4 + 2 + rr) * 6144 + (cq < 32 ? u.pn * 128 + cq * 4 : 3072 + u.pn * 128 + (cq - 32) * 4)) = v; }
            }
#pragma unroll 2
            for (int it = 0; it < 8; ++it) {
                const int row = it * 16 + rsub;
                const f32x4 xg = *(const LAS f32x4*)(tl + row * 260 + q * 4), xu = *(const LAS f32x4*)(tl + row * 260 + 128 + q * 4);
                f32x4 p1g, p1u, p2g, p2u; bool ok = true;
                if (row >= 2) { p1g = *(const LAS f32x4*)(tl + (row - 1) * 260 + q * 4); p1u = *(const LAS f32x4*)(tl + (row - 1) * 260 + 128 + q * 4); p2g = *(const LAS f32x4*)(tl + (row - 2) * 260 + q * 4); p2u = *(const LAS f32x4*)(tl + (row - 2) * 260 + 128 + q * 4); }
                else if (ai == 1) {
                    if (row == 1) { p1g = *(const LAS f32x4*)(tl + q * 4); p1u = *(const LAS f32x4*)(tl + 128 + q * 4); p2g = *(const LAS f32x4*)(side + 260 + q * 4); p2u = *(const LAS f32x4*)(side + 260 + 128 + q * 4); }
                    else { p1g = *(const LAS f32x4*)(side + 260 + q * 4); p1u = *(const LAS f32x4*)(side + 260 + 128 + q * 4); p2g = *(const LAS f32x4*)(side + q * 4); p2u = *(const LAS f32x4*)(side + 128 + q * 4); }
                } else { ok = false; p1g = xg; p1u = xu; p2g = xg; p2u = xu; }
                const f32x4 gv = gb + g0 * p2g + g1 * p1g + g2 * xg, uv = ub + u0 * p2u + u1 * p1u + u2 * xu;
                if (ok) { u32x2 w; w.x = cvt_pk_bf16(gelu_t(gv[0]) * uv[0], gelu_t(gv[1]) * uv[1]); w.y = cvt_pk_bf16(gelu_t(gv[2]) * uv[2], gelu_t(gv[3]) * uv[3]);
                    *(u32x2*)(act + ((size_t)u.pm * 256 + ai * 128 + row) * 3072 + ch) = w; }
            }
            if (ai == 0) {
                if (tid < 128) { const int rr = tid >> 6, cq = tid & 63; *(LAS f32x4*)(side + rr * 260 + cq * 4) = *(const LAS f32x4*)(tl + (126 + rr) * 260 + cq * 4); }
            }
        }
        __syncthreads();
    }
};
DI void ffn_fix_tile(int mk_tid, const float* HB, const float* cw, const float* cb, u16* act, int pm) {
    for (int item = mk_tid; item < 2 * 768; item += 512) {
        const int cq = item % 768, j = item / 768, ch = cq * 4; const bool hp = (pm & 7) != 0;
        const f32x4 z4 = (f32x4){0.f, 0.f, 0.f, 0.f};
        const float* cur = HB + ((size_t)pm * 4 + j) * 6144 + ch; const float* f0 = HB + ((size_t)pm * 4) * 6144 + ch;
        const float* l0 = HB + ((size_t)(pm - 1) * 4 + 2) * 6144 + ch; const float* l1 = HB + ((size_t)(pm - 1) * 4 + 3) * 6144 + ch;
        const f32x4 xg = *(const f32x4*)cur, xu = *(const f32x4*)(cur + 3072);
        f32x4 p1g, p1u, p2g, p2u;
        if (j == 1) { p1g = *(const f32x4*)f0; p1u = *(const f32x4*)(f0 + 3072); p2g = hp ? *(const f32x4*)l1 : z4; p2u = hp ? *(const f32x4*)(l1 + 3072) : z4; }
        else { p1g = hp ? *(const f32x4*)l1 : z4; p1u = hp ? *(const f32x4*)(l1 + 3072) : z4; p2g = hp ? *(const f32x4*)l0 : z4; p2u = hp ? *(const f32x4*)(l0 + 3072) : z4; }
        const f32x4 wg0 = *(const f32x4*)(cw + ch), wg1 = *(const f32x4*)(cw + 6144 + ch), wg2 = *(const f32x4*)(cw + 12288 + ch), bg = *(const f32x4*)(cb + ch);
        const f32x4 wu0 = *(const f32x4*)(cw + 3072 + ch), wu1 = *(const f32x4*)(cw + 6144 + 3072 + ch), wu2 = *(const f32x4*)(cw + 12288 + 3072 + ch), bu = *(const f32x4*)(cb + 3072 + ch);
        const f32x4 gv = bg + wg0 * p2g + wg1 * p1g + wg2 * xg, uv = bu + wu0 * p2u + wu1 * p1u + wu2 * xu;
        u32x2 w; w.x = pk2(gelu_t(gv[0]) * uv[0], gelu_t(gv[1]) * uv[1]); w.y = pk2(gelu_t(gv[2]) * uv[2], gelu_t(gv[3]) * uv[3]);
        *(u32x2*)(act + ((size_t)pm * 256 + j) * 3072 + ch) = w;
    }
}

struct UE6 {
    static constexpr bool AFTER_DRAIN = true;
    int perm; u16* qc; u16* kc; float* HB; const float* cw; const float* cb; const float* ss;
    DI void operator()(const f32x4 (&)[2][2][4][2], const Unit&, int, int, int, int) const {}
    DI void fused(const f32x4 (&acc)[2][2][4][2], const Unit& u, int wr, int wc, int fr, int fq, LAS unsigned char* lds, int wid, int lane) const {
        LAS float* tl = (LAS float*)lds;
        LAS float* side = (LAS float*)(lds + 133120);
        const int tid = wid * 64 + lane, q = tid & 63, rsub = tid >> 6, ch = u.pn * 256 + q * 4;
        const f32x4 w0 = *(const f32x4*)(cw + ch), w1 = *(const f32x4*)(cw + 2048 + ch), w2 = *(const f32x4*)(cw + 4096 + ch), w3 = *(const f32x4*)(cw + 6144 + ch), bb = *(const f32x4*)(cb + ch);
        u16* dst = (ch < 1024) ? qc + ch : kc + (ch - 1024); const float sc = (ch < 1024) ? 1.f : 0.0625f;
#pragma unroll
        for (int ai = 0; ai < 2; ++ai) {
            if (ai == 1) __syncthreads();
#pragma unroll
            for (int m = 0; m < 4; ++m) { const float rs = rsqrtf(ss[u.pm * 256 + ai * 128 + wr * 64 + m * 16 + fr] * (1.f / 1024.f) + 1e-6f);
#pragma unroll
                for (int bj = 0; bj < 2; ++bj)
#pragma unroll
                    for (int n = 0; n < 2; ++n) *(LAS f32x4*)(tl + (wr * 64 + m * 16 + fr) * 260 + bj * 128 + wc * 32 + n * 16 + 4 * fq) = acc[ai][bj][m][n] * rs; }
            __syncthreads();
            if (tid < 192) { const int rr = tid >> 6, cq = tid & 63; const f32x4 v = *(const LAS f32x4*)(tl + ((ai == 0 ? 0 : 125) + rr) * 260 + cq * 4);
                *(f32x4*)(HB + ((size_t)u.pm * 6 + (ai == 0 ? 0 : 3) + rr) * 2048 + u.pn * 256 + cq * 4) = v; }
#pragma unroll 2
            for (int it = 0; it < 16; ++it) {
                const int row = it * 8 + rsub;
                const f32x4 x = *(const LAS f32x4*)(tl + row * 260 + q * 4);
                f32x4 p1, p2, p3; bool ok = true;
                if (row >= 3) { p1 = *(const LAS f32x4*)(tl + (row - 1) * 260 + q * 4); p2 = *(const LAS f32x4*)(tl + (row - 2) * 260 + q * 4); p3 = *(const LAS f32x4*)(tl + (row - 3) * 260 + q * 4); }
                else if (ai == 1) {
                    p1 = (row >= 1) ? *(const LAS f32x4*)(tl + (row - 1) * 260 + q * 4) : *(const LAS f32x4*)(side + 2 * 260 + q * 4);
                    p2 = (row >= 2) ? *(const LAS f32x4*)(tl + (row - 2) * 260 + q * 4) : *(const LAS f32x4*)(side + (1 + row) * 260 + q * 4);
                    p3 = *(const LAS f32x4*)(side + row * 260 + q * 4);
                } else { ok = false; p1 = x; p2 = x; p3 = x; }
                const f32x4 v = bb + w0 * p3 + w1 * p2 + w2 * p1 + w3 * x;
                if (ok) { u32x2 w; w.x = cvt_pk_bf16(sc * v[0] * sigm(v[0]), sc * v[1] * sigm(v[1])); w.y = cvt_pk_bf16(sc * v[2] * sigm(v[2]), sc * v[3] * sigm(v[3]));
                    *(u32x2*)(dst + ((size_t)u.pm * 256 + ai * 128 + row) * 1024) = w; }
            }
            if (ai == 0) { if (tid < 192) { const int rr = tid >> 6, cq = tid & 63; *(LAS f32x4*)(side + rr * 260 + cq * 4) = *(const LAS f32x4*)(tl + (125 + rr) * 260 + cq * 4); } }
        }
        __syncthreads();
    }
};
DI void qk_fix_local(int mk_tid, const float* HB, const float* cw, const float* cb, u16* dst, int chg, int pm0, int npm) {
    for (int item = mk_tid; item < npm * 3 * 64; item += 512) {
        const int cq = item & 63, rr = item >> 6, pmi = rr / 3, j = rr - pmi * 3, pm = pm0 + pmi, ch = chg + cq * 4; const bool hp = (pm & 7) != 0;
        const f32x4 z4 = (f32x4){0.f, 0.f, 0.f, 0.f};
        const float* me = HB + (size_t)pm * 6 * 2048 + ch; const float* pv = HB + (size_t)(pm - 1) * 6 * 2048 + ch;
        const f32x4 x = *(const f32x4*)(me + j * 2048);
        f32x4 p[3];
#pragma unroll
        for (int k = 1; k <= 3; ++k) { const int r = j - k; p[k - 1] = (r >= 0) ? *(const f32x4*)(me + r * 2048) : (hp ? *(const f32x4*)(pv + (6 + r) * 2048) : z4); }
        const f32x4 w0 = *(const f32x4*)(cw + ch), w1 = *(const f32x4*)(cw + 2048 + ch), w2 = *(const f32x4*)(cw + 4096 + ch), w3 = *(const f32x4*)(cw + 6144 + ch), bb = *(const f32x4*)(cb + ch);
        const f32x4 v = bb + w0 * p[2] + w1 * p[1] + w2 * p[0] + w3 * x;
        const float sc = (ch < 1024) ? 1.f : 0.0625f;
        u32x2 w; w.x = pk2(sc * v[0] * sigm(v[0]), sc * v[1] * sigm(v[1])); w.y = pk2(sc * v[2] * sigm(v[2]), sc * v[3] * sigm(v[3]));
        *(u32x2*)(dst + ((size_t)pm * 256 + j) * 1024 + (ch & 1023)) = w;
    }
}
DI void qk_fix_phase(int mk_tid, const float* HB, const float* cw, const float* cb, u16* qc, u16* kc) {
    const int gtid = blockIdx.x * 512 + mk_tid, nth = gridDim.x * 512;
    for (int item = gtid; item < 192 * 512; item += nth) {
        const int cq = item & 511, rr = item >> 9, pm = rr / 3, j = rr - pm * 3, ch = cq * 4; const bool hp = (pm & 7) != 0;
        const f32x4 z4 = (f32x4){0.f, 0.f, 0.f, 0.f};
        const float* me = HB + (size_t)pm * 6 * 2048 + ch; const float* pv = HB + (size_t)(pm - 1) * 6 * 2048 + ch;
        const f32x4 x = *(const f32x4*)(me + j * 2048);
        f32x4 p[3];
#pragma unroll
        for (int k = 1; k <= 3; ++k) { const int r = j - k; p[k - 1] = (r >= 0) ? *(const f32x4*)(me + r * 2048) : (hp ? *(const f32x4*)(pv + (6 + r) * 2048) : z4); }
        const f32x4 w0 = *(const f32x4*)(cw + ch), w1 = *(const f32x4*)(cw + 2048 + ch), w2 = *(const f32x4*)(cw + 4096 + ch), w3 = *(const f32x4*)(cw + 6144 + ch), bb = *(const f32x4*)(cb + ch);
        const f32x4 v = bb + w0 * p[2] + w1 * p[1] + w2 * p[0] + w3 * x;
        u16* dst = (ch < 1024) ? qc + ch : kc + (ch - 1024); const float sc = (ch < 1024) ? 1.f : 0.0625f;
        u32x2 w; w.x = pk2(sc * v[0] * sigm(v[0]), sc * v[1] * sigm(v[1])); w.y = pk2(sc * v[2] * sigm(v[2]), sc * v[3] * sigm(v[3]));
        *(u32x2*)(dst + ((size_t)pm * 256 + j) * 1024) = w;
    }
}

struct GD { const u16* A; const u16* Bt; int M, N, K, cshift; UE e; };

DI void cvt_w(int mk_tid, LAS unsigned char* lds, const float* W, int ldw, int col0, int ncols, int K, u16* dst, int& tb, int il, const float* gain) {
    LAS float* tile = (LAS float*)lds;
    const int tid = mk_tid, G = gridDim.x; const int ntn = ncols >> 8, nt = ntn * (K >> 6);
    int i0 = ((int)blockIdx.x - tb) % G; if (i0 < 0) i0 += G;
    for (int i = i0; i < nt; i += G) {
        const int tn = i % ntn, tk = i / ntn;
        __syncthreads();
        const float* src = W + (size_t)(tk * 64) * ldw + col0 + (il ? tn * 128 : tn * 256);
#pragma unroll 16
        for (int e = tid; e < 16384; e += 512) { const int r = e >> 8, c = e & 255; const int cs = (il && c >= 128) ? c + 3072 - 128 : c; tile[r * 257 + c] = src[(size_t)r * ldw + cs]; }
        __syncthreads();
        u16* dp = dst + (size_t)(tn * 256) * K + tk * 64; const float gk0 = gain ? gain[tk * 64 + (tid & 31) * 2] : 1.f, gk1 = gain ? gain[tk * 64 + (tid & 31) * 2 + 1] : 1.f;
#pragma unroll 4
        for (int e = tid; e < 8192; e += 512) { const int n = e >> 5, k2 = (e & 31) * 2; *(unsigned*)(dp + (size_t)n * K + k2) = pk2(tile[k2 * 257 + n] * gk0, tile[(k2 + 1) * 257 + n] * gk1); }
    }
    tb = (tb + nt) % G;
}

DI void norm_rows(int mk_tid, const float* src, const float* g, u16* dst, int nrows, const LAS float* sW, const float* ifb, float* ifg) {
    const int lane = mk_tid & 63, gw = blockIdx.x * 8 + (mk_tid >> 6), nw = gridDim.x * 8;
    for (int row0 = gw; row0 < nrows; row0 += 4 * nw) {
        float4 v[4][4];
#pragma unroll
        for (int r = 0; r < 4; ++r) { const int row = row0 + r * nw; if (row < nrows) {
#pragma unroll
            for (int i = 0; i < 4; ++i) v[r][i] = *(const float4*)(src + (size_t)row * 1024 + i * 256 + lane * 4); } }
        float4 gv[4];
#pragma unroll
        for (int i = 0; i < 4; ++i) gv[i] = *(const float4*)(g + i * 256 + lane * 4);
#pragma unroll
        for (int r = 0; r < 4; ++r) { const int row = row0 + r * nw; if (row < nrows) {
            float ss = 0.f;
#pragma unroll
            for (int i = 0; i < 4; ++i) ss += v[r][i].x * v[r][i].x + v[r][i].y * v[r][i].y + v[r][i].z * v[r][i].z + v[r][i].w * v[r][i].w;
            ss = wsum(ss); const float rinv = rsqrtf(ss * (1.f / 1024.f) + 1e-6f);
#pragma unroll
            for (int i = 0; i < 4; ++i) { v[r][i].x *= rinv * gv[i].x; v[r][i].y *= rinv * gv[i].y; v[r][i].z *= rinv * gv[i].z; v[r][i].w *= rinv * gv[i].w;
                u32x2 w; w.x = pk2(v[r][i].x, v[r][i].y); w.y = pk2(v[r][i].z, v[r][i].w); *(u32x2*)(dst + (size_t)row * 1024 + i * 256 + lane * 4) = w; }
            if (sW) {
                float a0 = 0, a1 = 0, a2 = 0, a3 = 0, a4 = 0, a5 = 0, a6 = 0, a7 = 0;
#pragma unroll
                for (int i = 0; i < 4; ++i) { const float y[4] = {v[r][i].x, v[r][i].y, v[r][i].z, v[r][i].w};
#pragma unroll
                    for (int e = 0; e < 4; ++e) { const int k = i * 256 + lane * 4 + e; const LAS f32x4* wp = (const LAS f32x4*)(sW + k * 8); const f32x4 w0 = wp[0], w1 = wp[1];
                        a0 += y[e] * w0.x; a1 += y[e] * w0.y; a2 += y[e] * w0.z; a3 += y[e] * w0.w; a4 += y[e] * w1.x; a5 += y[e] * w1.y; a6 += y[e] * w1.z; a7 += y[e] * w1.w; } __builtin_amdgcn_sched_barrier(0); }
                a0 = wsum(a0); a1 = wsum(a1); a2 = wsum(a2); a3 = wsum(a3); a4 = wsum(a4); a5 = wsum(a5); a6 = wsum(a6); a7 = wsum(a7);
                if (lane == 0) { float4 o0, o1; o0.x = a0 + ifb[0]; o0.y = a1 + ifb[1]; o0.z = a2 + ifb[2]; o0.w = a3 + ifb[3]; o1.x = a4 + ifb[4]; o1.y = a5 + ifb[5]; o1.z = a6 + ifb[6]; o1.w = a7 + ifb[7];
                    *(float4*)(ifg + (size_t)row * 8) = o0; *(float4*)(ifg + (size_t)row * 8 + 4) = o1; }
            } } __builtin_amdgcn_sched_barrier(0); }
    }
}
DI void final_norm(int mk_tid, const u16* hb, float* out, const float* g) {
    const int lane = mk_tid & 63, gw = blockIdx.x * 8 + (mk_tid >> 6), nw = gridDim.x * 8;
    float4 gv[4];
#pragma unroll
    for (int i = 0; i < 4; ++i) gv[i] = *(const float4*)(g + i * 256 + lane * 4);
    for (int row0 = gw; row0 < T; row0 += 4 * nw) {
        u32x2 v[4][4];
#pragma unroll
        for (int r = 0; r < 4; ++r)
#pragma unroll
            for (int i = 0; i < 4; ++i) v[r][i] = *(const u32x2*)(hb + (size_t)(row0 + r * nw) * 1024 + i * 256 + lane * 4);
        __builtin_amdgcn_sched_barrier(0);
#pragma unroll
        for (int r = 0; r < 4; ++r) { float* p = out + (size_t)(row0 + r * nw) * 1024; float ss = 0.f; float4 f[4];
#pragma unroll
            for (int i = 0; i < 4; ++i) { f[i].x = bflo(v[r][i].x); f[i].y = bfhi(v[r][i].x); f[i].z = bflo(v[r][i].y); f[i].w = bfhi(v[r][i].y); ss += f[i].x * f[i].x + f[i].y * f[i].y + f[i].z * f[i].z + f[i].w * f[i].w; }
            ss = wsum(ss); const float rinv = rsqrtf(ss * (1.f / 1024.f) + 1e-6f);
#pragma unroll
            for (int i = 0; i < 4; ++i) { float4 o; o.x = f[i].x * rinv * gv[i].x; o.y = f[i].y * rinv * gv[i].y; o.z = f[i].z * rinv * gv[i].z; o.w = f[i].w * rinv * gv[i].w; *(float4*)(p + i * 256 + lane * 4) = o; } }
    }
}

DI void conv_qk_phase(int mk_tid, const u16* qk, const float* cw, const float* cb, u16* qc, u16* kc) {
    const int gtid = blockIdx.x * 512 + mk_tid, nth = gridDim.x * 512;
    for (int item = gtid; item < 256 * 1024; item += nth) {
        const int co = item & 255, tb = item >> 8, c0 = co * 8, t0 = tb * 16;
        float w0[8], w1[8], w2[8], w3[8], bb[8];
#pragma unroll
        for (int e = 0; e < 8; ++e) { w0[e] = cw[c0 + e]; w1[e] = cw[2048 + c0 + e]; w2[e] = cw[4096 + c0 + e]; w3[e] = cw[6144 + c0 + e]; bb[e] = cb[c0 + e]; }
        float x0[8], x1[8], x2[8], x3[8];
        if ((t0 & (SEQ - 1)) == 0) {
#pragma unroll
            for (int e = 0; e < 8; ++e) { x0[e] = 0.f; x1[e] = 0.f; x2[e] = 0.f; }
        } else {
            unpack8(*(const u32x4*)(qk + (size_t)(t0 - 3) * 2048 + c0), x0); unpack8(*(const u32x4*)(qk + (size_t)(t0 - 2) * 2048 + c0), x1); unpack8(*(const u32x4*)(qk + (size_t)(t0 - 1) * 2048 + c0), x2);
        }
        u16* dstp = (c0 < 1024) ? qc + c0 : kc + (c0 - 1024); const float sc = (c0 < 1024) ? 1.f : 0.0625f;
        for (int tt = 0; tt < 16; ++tt) {
            unpack8(*(const u32x4*)(qk + (size_t)(t0 + tt) * 2048 + c0), x3);
            float o[8];
#pragma unroll
            for (int e = 0; e < 8; ++e) { const float v = bb[e] + w0[e] * x0[e] + w1[e] * x1[e] + w2[e] * x2[e] + w3[e] * x3[e]; o[e] = sc * v * sigm(v); x0[e] = x1[e]; x1[e] = x2[e]; x2[e] = x3[e]; }
            u32x4 r; r.x = pk2(o[0], o[1]); r.y = pk2(o[2], o[3]); r.z = pk2(o[4], o[5]); r.w = pk2(o[6], o[7]);
            *(u32x4*)(dstp + (size_t)(t0 + tt) * 1024) = r;
        }
    }
}

DI float logsig(float x) { return fminf(x, 0.f) - log1pf(__expf(-fabsf(x))); }
DI void gate_prepass(int mk_tid, LAS unsigned char* lds, int bh, const float* ifg, float* gz, float* gM, float* gE, float* gms, float* gMl, float* gW) {
    const int lane = mk_tid & 63, wid = mk_tid >> 6, b = bh >> 2, h = bh & 3;
    LAS float* G = (LAS float*)lds; LAS float* CM = G + 16;
    float z0[2], z1[2], b0[2], b1[2], excm[2], incm[2];
    __syncthreads();
#pragma unroll
    for (int cc = 0; cc < 2; ++cc) { const int c = wid * 2 + cc;
        const int s0 = c * 128 + 2 * lane; const size_t t = (size_t)b * SEQ + s0;
        const float i0 = ifg[t * 8 + h], f0 = ifg[t * 8 + 4 + h], i1 = ifg[t * 8 + 8 + h], f1 = ifg[t * 8 + 12 + h];
        const float lf0 = logsig(f0), lf1 = logsig(f1), s1 = lf0 + lf1;
        float inc = s1;
#pragma unroll
        for (int d = 1; d < 64; d <<= 1) { const float o = __shfl_up(inc, d); if (lane >= d) inc += o; }
        const float exc = inc - s1; b0[cc] = exc + lf0; b1[cc] = exc + s1; z0[cc] = i0 - b0[cc]; z1[cc] = i1 - b1[cc];
        float im = fmaxf(z0[cc], z1[cc]);
#pragma unroll
        for (int d = 1; d < 64; d <<= 1) { const float o = __shfl_up(im, d); if (lane >= d) im = fmaxf(im, o); }
        float em = __shfl_up(im, 1); if (lane == 0) em = -3.0e38f;
        incm[cc] = im; excm[cc] = em;
        if (lane == 63) { G[c] = inc; CM[c] = im; }
    }
    __syncthreads();
    float m = 0.f, mst[2] = {0.f, 0.f};
    for (int c = 0; c < wid * 2; ++c) m = G[c] + fmaxf(m, CM[c]);
    mst[0] = m; m = G[wid * 2] + fmaxf(m, CM[wid * 2]); mst[1] = m;
#pragma unroll
    for (int cc = 0; cc < 2; ++cc) { const int c = wid * 2 + cc; const float m_st = mst[cc];
        const float M0 = fmaxf(m_st, fmaxf(excm[cc], z0[cc])), M1 = fmaxf(m_st, incm[cc]), Ml = fmaxf(m_st, CM[c]);
        const size_t gi = (size_t)bh * SEQ + c * 128 + 2 * lane;
        *(float2*)(gz + gi) = make_float2(z0[cc], z1[cc]); *(float2*)(gM + gi) = make_float2(M0, M1); *(float2*)(gE + gi) = make_float2(__expf(-(b0[cc] + M0)), __expf(-(b1[cc] + M1)));
        *(float2*)(gW + gi) = make_float2(__expf(z0[cc] - Ml), __expf(z1[cc] - Ml));
        if (lane == 0) { gms[bh * 16 + c] = m_st; gMl[bh * 16 + c] = Ml; }
    }
    __syncthreads();
}

DI void mlstm_state_phase(int mk_tid, LAS unsigned char* lds, u16* kc, const u16* vT, float* gW, float* gms, float* gMl, u16* CT, float* nvec,
                          const float* ifg, float* gz, float* gM, float* gE, const float* HBQ, const float* cw, const float* cb) {
    const int tid = mk_tid, lane = tid & 63, wid = tid >> 6, fr = lane & 15, fq = lane >> 4;
    LAS unsigned* slab = (LAS unsigned*)(lds + wid * 9216);
    const unsigned trbase = (unsigned)(size_t)slab + (unsigned)((8 * fq + (fr >> 2)) * 72 + 8 * (fr & 3));
    const int lr = lane >> 2, lp = lane & 3;
    for (int item = blockIdx.x; item < 256; item += gridDim.x) {
        const int bh = item >> 3, eb = item & 7, b = bh >> 2, h = bh & 3;
        gate_prepass(mk_tid, lds, bh, ifg, gz, gM, gE, gms, gMl, gW);
        qk_fix_local(mk_tid, HBQ, cw, cb, kc, 1024 + h * 256, b * 8, 8);
        asm volatile("s_waitcnt vmcnt(0)" ::: "memory"); __syncthreads();
        f32x4 acc[2][2], nac4[2] = {(f32x4){0.f, 0.f, 0.f, 0.f}, (f32x4){0.f, 0.f, 0.f, 0.f}};
        const bf16x8 ones8 = __builtin_bit_cast(bf16x8, (u32x4){0x3F803F80u, 0x3F803F80u, 0x3F803F80u, 0x3F803F80u});
#pragma unroll
        for (int dm = 0; dm < 2; ++dm)
#pragma unroll
            for (int en = 0; en < 2; ++en) acc[dm][en] = (f32x4){0.f, 0.f, 0.f, 0.f};
        u32x4 kreg[8], vreg[4][2]; float wrow[8];
        {   const size_t tbase = (size_t)b * SEQ;
#pragma unroll
            for (int i = 0; i < 8; ++i) { kreg[i] = *(const u32x4*)(kc + (tbase + i * 16 + lr) * 1024 + h * 256 + wid * 32 + lp * 8); wrow[i] = gW[(size_t)bh * SEQ + i * 16 + lr]; }
#pragma unroll
            for (int ks = 0; ks < 4; ++ks)
#pragma unroll
                for (int en = 0; en < 2; ++en) vreg[ks][en] = *(const u32x4*)(vT + (size_t)(h * 256 + eb * 32 + en * 16 + fr) * T + tbase + ks * 32 + 8 * fq); }
        for (int c = 0; c < 16; ++c) {
            u16* ct = CT + ((size_t)(bh * 16 + c) << 16);
#pragma unroll
            for (int dm = 0; dm < 2; ++dm) {
#pragma unroll
                for (int en = 0; en < 2; ++en) { const int e = eb * 32 + en * 16 + fr, d = wid * 32 + dm * 16 + 4 * fq; u32x2 w; w.x = pk2(acc[dm][en][0], acc[dm][en][1]); w.y = pk2(acc[dm][en][2], acc[dm][en][3]); *(u32x2*)(ct + e * 256 + d) = w; }
                if (eb == 0 && fr == 0) *(f32x4*)(nvec + (size_t)(bh * 16 + c) * 256 + wid * 32 + dm * 16 + 4 * fq) = nac4[dm];
            }
            if (c == 15) break;
#pragma unroll
            for (int i = 0; i < 8; ++i) { float kf[8]; unpack8(kreg[i], kf); const float w = wrow[i]; LAS unsigned* dp = slab + (i * 16 + lr) * 18 + lp * 4;
                dp[0] = pk2(kf[0] * w, kf[1] * w); dp[1] = pk2(kf[2] * w, kf[3] * w); dp[2] = pk2(kf[4] * w, kf[5] * w); dp[3] = pk2(kf[6] * w, kf[7] * w); }
            bf16x8 bfr[4][2];
#pragma unroll
            for (int ks = 0; ks < 4; ++ks)
#pragma unroll
                for (int en = 0; en < 2; ++en) bfr[ks][en] = __builtin_bit_cast(bf16x8, vreg[ks][en]);
            if (c + 1 < 15) { const size_t tbase = (size_t)b * SEQ + (c + 1) * 128;
#pragma unroll
                for (int i = 0; i < 8; ++i) { kreg[i] = *(const u32x4*)(kc + (tbase + i * 16 + lr) * 1024 + h * 256 + wid * 32 + lp * 8); wrow[i] = gW[(size_t)bh * SEQ + (c + 1) * 128 + i * 16 + lr]; }
#pragma unroll
                for (int ks = 0; ks < 4; ++ks)
#pragma unroll
                    for (int en = 0; en < 2; ++en) vreg[ks][en] = *(const u32x4*)(vT + (size_t)(h * 256 + eb * 32 + en * 16 + fr) * T + tbase + ks * 32 + 8 * fq); }
            const float dec = __expf(gms[bh * 16 + c] - gMl[bh * 16 + c]);
#pragma unroll
            for (int dm = 0; dm < 2; ++dm) { nac4[dm] *= dec;
#pragma unroll
                for (int en = 0; en < 2; ++en) acc[dm][en] *= dec; }
            __builtin_amdgcn_fence(__ATOMIC_RELEASE, "wavefront"); __builtin_amdgcn_wave_barrier(); __builtin_amdgcn_fence(__ATOMIC_ACQUIRE, "wavefront");
#pragma unroll
            for (int ks = 0; ks < 4; ++ks) {
                bf16x8 afr[2];
                {
                    s16x4 a00, a01, a10, a11; const unsigned ad = trbase + (unsigned)(ks * 32 * 72);
                    asm volatile("s_waitcnt lgkmcnt(0)\n\tds_read_b64_tr_b16 %0, %4\n\tds_read_b64_tr_b16 %1, %4 offset:288\n\tds_read_b64_tr_b16 %2, %4 offset:32\n\tds_read_b64_tr_b16 %3, %4 offset:320\n\ts_waitcnt lgkmcnt(0)"
                                 : "=&v"(a00), "=&v"(a01), "=&v"(a10), "=&v"(a11) : "v"(ad) : "memory");
                    afr[0] = __builtin_shufflevector(a00, a01, 0, 1, 2, 3, 4, 5, 6, 7); afr[1] = __builtin_shufflevector(a10, a11, 0, 1, 2, 3, 4, 5, 6, 7); }
                nac4[0] = mfma16(afr[0], ones8, nac4[0]); nac4[1] = mfma16(afr[1], ones8, nac4[1]);
#pragma unroll
                for (int dm = 0; dm < 2; ++dm)
#pragma unroll
                    for (int en = 0; en < 2; ++en) acc[dm][en] = mfma16(afr[dm], bfr[ks][en], acc[dm][en]);
            }
            __builtin_amdgcn_fence(__ATOMIC_RELEASE, "wavefront"); __builtin_amdgcn_wave_barrier(); __builtin_amdgcn_fence(__ATOMIC_ACQUIRE, "wavefront");
        }
    }
}

DI void mlstm_out_phase(int mk_tid, LAS unsigned char* lds, u16* qy, const u16* kc, const u16* vT, const u16* CT, const float* nvec, const u16* og,
                        const float* gz, const float* gM, const float* gE, const float* gms, const float* ng, int nostore, const float* HBQ, const float* cw, const float* cb) {
    const int tid = mk_tid, lane = tid & 63, wid = __builtin_amdgcn_readfirstlane(tid >> 6), fr = lane & 15, fq = lane >> 4;
    LAS u16* Ksh = (LAS u16*)lds;
    LAS u16* Vsh = (LAS u16*)(lds + 67584);
    for (int item = blockIdx.x; item < 512; item += gridDim.x) {
        const int bh = item >> 4, c = item & 15, b = bh >> 2, h = bh & 3; const size_t tbase = (size_t)b * SEQ + c * 128;
        if ((c & 1) == 0) qk_fix_local(mk_tid, HBQ, cw, cb, qy, h * 256, (int)(tbase >> 8), 1);
        __syncthreads();
        for (int e = tid; e < 4096; e += 512) { const int r = e >> 5, p = e & 31; *(LAS u32x4*)(Ksh + r * 264 + p * 8) = *(const u32x4*)(kc + (tbase + r) * 1024 + h * 256 + p * 8); }
        for (int e = tid; e < 4096; e += 512) { const int r = e >> 4, p = e & 15; *(LAS u32x4*)(Vsh + r * 136 + p * 8) = *(const u32x4*)(vT + (size_t)(h * 256 + r) * T + tbase + p * 8); }
        asm volatile("s_waitcnt vmcnt(0)" ::: "memory");
        __syncthreads();
        const int tl = wid * 16 + fr; const size_t tok = tbase + tl;
        bf16x8 qf[8];
#pragma unroll
        for (int ks = 0; ks < 8; ++ks) qf[ks] = *(const bf16x8*)(qy + tok * 1024 + h * 256 + ks * 32 + 8 * fq);
        const size_t gi = (size_t)bh * SEQ + c * 128;
        const float Mt = gM[gi + tl], en_t = gE[gi + tl], winter = __expf(gms[bh * 16 + c] - Mt);
        const u16* ct = CT + ((size_t)(bh * 16 + c) << 16);
        u32x4 cpre[8];
#pragma unroll
        for (int i = 0; i < 8; ++i) { const int e = tid + i * 512, r = e >> 5, p = e & 31; cpre[i] = *(const u32x4*)(ct + (size_t)r * 256 + p * 8); }
        bf16x8 pf[4]; float dsum = 0.f;
#pragma unroll
        for (int sp = 0; sp < 4; ++sp) {
            u32x4 pk = (u32x4){0u, 0u, 0u, 0u};
#pragma unroll
            for (int hh = 0; hh < 2; ++hh) { const int si = sp * 2 + hh;
                if (si <= wid) {
                    f32x4 st = (f32x4){0.f, 0.f, 0.f, 0.f};
#pragma unroll
                    for (int ks = 0; ks < 8; ++ks) { const bf16x8 a = *(const LAS bf16x8*)(Ksh + (si * 16 + fr) * 264 + ks * 32 + 8 * fq); st = mfma16(a, qf[ks], st); }
                    const float4 z = *(const float4*)(gz + gi + si * 16 + 4 * fq); const float zz[4] = {z.x, z.y, z.z, z.w}; float pv[4];
#pragma unroll
                    for (int j = 0; j < 4; ++j) { const int s = si * 16 + 4 * fq + j; const float p = (s <= tl) ? st[j] * __expf(zz[j] - Mt) : 0.f; dsum += p; pv[j] = p; }
                    if (hh == 0) { pk.x = pk2(pv[0], pv[1]); pk.y = pk2(pv[2], pv[3]); } else { pk.z = pk2(pv[0], pv[1]); pk.w = pk2(pv[2], pv[3]); }
                } }
            pf[sp] = __builtin_bit_cast(bf16x8, pk);
        }
        f32x4 o[16];
#pragma unroll
        for (int half = 0; half < 2; ++half) {
            __syncthreads();
#pragma unroll
            for (int i = 0; i < 8; ++i) { const int e = tid + i * 512, r = e >> 5, p = e & 31; *(LAS u32x4*)(Ksh + r * 264 + p * 8) = cpre[i]; }
            if (half == 0) {
#pragma unroll
                for (int i = 0; i < 8; ++i) { const int e = tid + i * 512, r = e >> 5, p = e & 31; cpre[i] = *(const u32x4*)(ct + (size_t)(128 + r) * 256 + p * 8); } }
            __syncthreads();
#pragma unroll
            for (int e8 = 0; e8 < 8; ++e8) { f32x4 a = (f32x4){0.f, 0.f, 0.f, 0.f};
#pragma unroll
                for (int ks = 0; ks < 8; ++ks) { const bf16x8 cf = *(const LAS bf16x8*)(Ksh + (e8 * 16 + fr) * 264 + ks * 32 + 8 * fq); a = mfma16(cf, qf[ks], a); }
                o[half * 8 + e8] = a * winter; __builtin_amdgcn_sched_barrier(0); }
        }
        const float* nv = nvec + (size_t)(bh * 16 + c) * 256; float qn = 0.f;
#pragma unroll
        for (int ks = 0; ks < 8; ++ks) { const float4 n0 = *(const float4*)(nv + ks * 32 + 8 * fq), n1 = *(const float4*)(nv + ks * 32 + 8 * fq + 4); const float nn[8] = {n0.x, n0.y, n0.z, n0.w, n1.x, n1.y, n1.z, n1.w};
#pragma unroll
            for (int j = 0; j < 8; ++j) qn += bf2f((u16)qf[ks][j]) * nn[j]; }
        qn += __shfl_xor(qn, 16); qn += __shfl_xor(qn, 32); dsum += __shfl_xor(dsum, 16); dsum += __shfl_xor(dsum, 32);
        const int nsp = (wid >> 1) + 1;
#pragma unroll
        for (int et = 0; et < 16; ++et) { __builtin_amdgcn_sched_barrier(0);
#pragma unroll
            for (int sp = 0; sp < 4; ++sp) if (sp < nsp) {
                const s16x4 lo = *(const LAS s16x4*)(Vsh + (et * 16 + fr) * 136 + sp * 32 + 4 * fq), hi = *(const LAS s16x4*)(Vsh + (et * 16 + fr) * 136 + sp * 32 + 16 + 4 * fq);
                const bf16x8 a = __builtin_shufflevector(lo, hi, 0, 1, 2, 3, 4, 5, 6, 7); o[et] = mfma16(a, pf[sp], o[et]); } }
        const float den = winter * qn + dsum, inv = 1.f / fmaxf(fabsf(den), en_t);
        float sum = 0.f;
#pragma unroll
        for (int et = 0; et < 16; ++et) { o[et] *= inv; sum += (o[et][0] + o[et][1]) + (o[et][2] + o[et][3]); }
        sum += __shfl_xor(sum, 16); sum += __shfl_xor(sum, 32); const float mu = sum * (1.f / 256.f);
        float var = 0.f;
#pragma unroll
        for (int et = 0; et < 16; ++et) { o[et] -= mu; var += (o[et][0] * o[et][0] + o[et][1] * o[et][1]) + (o[et][2] * o[et][2] + o[et][3] * o[et][3]); }
        var += __shfl_xor(var, 16); var += __shfl_xor(var, 32); const float rstd = rsqrtf(var * (1.f / 256.f) + 1e-6f);
        u32x2 ogr[16]; float4 gg[16];
#pragma unroll
        for (int et = 0; et < 16; ++et) { ogr[et] = *(const u32x2*)(og + tok * 1024 + h * 256 + et * 16 + 4 * fq); gg[et] = *(const float4*)(ng + h * 256 + et * 16 + 4 * fq); }
        __builtin_amdgcn_sched_barrier(0);
#pragma unroll
        for (int et = 0; et < 16; ++et) { const int e = h * 256 + et * 16 + 4 * fq; const float4 g4 = gg[et];
            u32x2 w; w.x = pk2(sigm(bflo(ogr[et].x)) * o[et][0] * rstd * g4.x, sigm(bfhi(ogr[et].x)) * o[et][1] * rstd * g4.y); w.y = pk2(sigm(bflo(ogr[et].y)) * o[et][2] * rstd * g4.z, sigm(bfhi(ogr[et].y)) * o[et][3] * rstd * g4.w);
            if (!nostore) *(u32x2*)(qy + tok * 1024 + e) = w; }
    }
}

DI void xattn_pair(int mk_tid, LAS unsigned char* lds, const u16* q, const u16* kmem, const u16* vTm, u16* ao, int b, int h, int qb0) {
    const int tid = mk_tid, lane = tid & 63, wid = tid >> 6, fr = lane & 15, fq = lane >> 4;
    LAS u16* Ksh = (LAS u16*)lds;
    {
        __syncthreads();
        for (int e = tid; e < 8192; e += 512) { const int r = e >> 5, p = e & 31; *(LAS u32x4*)(Ksh + r * 264 + p * 8) = *(const u32x4*)(kmem + (size_t)(b * 256 + r) * 1024 + h * 256 + p * 8); }
        __syncthreads();
        const size_t tok0 = (size_t)b * SEQ + qb0 * 128 + wid * 16 + fr, tok1 = tok0 + 128;
        bf16x8 qa[8], qb8[8];
#pragma unroll
        for (int ks = 0; ks < 8; ++ks) { qa[ks] = *(const bf16x8*)(q + tok0 * 1024 + h * 256 + ks * 32 + 8 * fq); qb8[ks] = *(const bf16x8*)(q + tok1 * 1024 + h * 256 + ks * 32 + 8 * fq); }
        float mx0 = -3.0e38f, mx1 = -3.0e38f;
#pragma unroll
        for (int mi = 0; mi < 16; ++mi) { f32x4 a = (f32x4){0.f, 0.f, 0.f, 0.f}, c = (f32x4){0.f, 0.f, 0.f, 0.f};
#pragma unroll
            for (int ks = 0; ks < 8; ++ks) { const bf16x8 kf = *(const LAS bf16x8*)(Ksh + (mi * 16 + fr) * 264 + ks * 32 + 8 * fq); a = mfma16(kf, qa[ks], a); c = mfma16(kf, qb8[ks], c); }
            mx0 = fmaxf(mx0, fmaxf(fmaxf(a[0], a[1]), fmaxf(a[2], a[3]))); mx1 = fmaxf(mx1, fmaxf(fmaxf(c[0], c[1]), fmaxf(c[2], c[3]))); __builtin_amdgcn_sched_barrier(0); }
        mx0 = fmaxf(mx0, __shfl_xor(mx0, 16)); mx0 = fmaxf(mx0, __shfl_xor(mx0, 32)); mx1 = fmaxf(mx1, __shfl_xor(mx1, 16)); mx1 = fmaxf(mx1, __shfl_xor(mx1, 32));
        bf16x8 pf0[8], pf1[8]; float sum0 = 0.f, sum1 = 0.f;
#pragma unroll
        for (int sp = 0; sp < 8; ++sp) { f32x4 a0 = (f32x4){0.f, 0.f, 0.f, 0.f}, a1 = a0, c0 = a0, c1 = a0;
#pragma unroll
            for (int ks = 0; ks < 8; ++ks) { const bf16x8 k0 = *(const LAS bf16x8*)(Ksh + (sp * 32 + fr) * 264 + ks * 32 + 8 * fq), k1 = *(const LAS bf16x8*)(Ksh + (sp * 32 + 16 + fr) * 264 + ks * 32 + 8 * fq);
                a0 = mfma16(k0, qa[ks], a0); a1 = mfma16(k1, qa[ks], a1); c0 = mfma16(k0, qb8[ks], c0); c1 = mfma16(k1, qb8[ks], c1); }
            float p[8], r[8];
#pragma unroll
            for (int j = 0; j < 4; ++j) { p[j] = __expf((a0[j] - mx0) * 0.0625f); p[4 + j] = __expf((a1[j] - mx0) * 0.0625f); sum0 += p[j] + p[4 + j];
                                          r[j] = __expf((c0[j] - mx1) * 0.0625f); r[4 + j] = __expf((c1[j] - mx1) * 0.0625f); sum1 += r[j] + r[4 + j]; }
            u32x4 pk; pk.x = pk2(p[0], p[1]); pk.y = pk2(p[2], p[3]); pk.z = pk2(p[4], p[5]); pk.w = pk2(p[6], p[7]); pf0[sp] = __builtin_bit_cast(bf16x8, pk);
            u32x4 rk; rk.x = pk2(r[0], r[1]); rk.y = pk2(r[2], r[3]); rk.z = pk2(r[4], r[5]); rk.w = pk2(r[6], r[7]); pf1[sp] = __builtin_bit_cast(bf16x8, rk); __builtin_amdgcn_sched_barrier(0); }
        sum0 += __shfl_xor(sum0, 16); sum0 += __shfl_xor(sum0, 32); sum1 += __shfl_xor(sum1, 16); sum1 += __shfl_xor(sum1, 32);
        const float iv0 = 1.f / sum0, iv1 = 1.f / sum1;
        __syncthreads();
        for (int e = tid; e < 8192; e += 512) { const int r = e >> 5, p = e & 31; *(LAS u32x4*)(Ksh + r * 264 + p * 8) = *(const u32x4*)(vTm + (size_t)(h * 256 + r) * 2048 + b * 256 + p * 8); }
        __syncthreads();
#pragma unroll 2
        for (int et = 0; et < 16; ++et) {
            f32x4 o0 = (f32x4){0.f, 0.f, 0.f, 0.f}, o1 = o0;
#pragma unroll
            for (int sp = 0; sp < 8; ++sp) { const s16x4 lo = *(const LAS s16x4*)(Ksh + (et * 16 + fr) * 264 + sp * 32 + 4 * fq), hi = *(const LAS s16x4*)(Ksh + (et * 16 + fr) * 264 + sp * 32 + 16 + 4 * fq);
                const bf16x8 a = __builtin_shufflevector(lo, hi, 0, 1, 2, 3, 4, 5, 6, 7); o0 = mfma16(a, pf0[sp], o0); o1 = mfma16(a, pf1[sp], o1); }
            u32x2 w0, w1; w0.x = pk2(o0[0] * iv0, o0[1] * iv0); w0.y = pk2(o0[2] * iv0, o0[3] * iv0); w1.x = pk2(o1[0] * iv1, o1[1] * iv1); w1.y = pk2(o1[2] * iv1, o1[3] * iv1);
            *(u32x2*)(ao + tok0 * 1024 + h * 256 + et * 16 + 4 * fq) = w0; *(u32x2*)(ao + tok1 * 1024 + h * 256 + et * 16 + 4 * fq) = w1; __builtin_amdgcn_sched_barrier(0); }
    }
}

DI void rglru_phase(int mk_tid, LAS unsigned char* lds, const u16* xr, const u16* gr, const float* cw, const float* cb, const float* wa, const float* ba, const float* wx, const float* bx, const float* lam, u16* ya, int pass, float* sumA, float* sumH) {
    const int tid = mk_tid, lane = tid & 63, wid = tid >> 6, fr = lane & 15, fq = lane >> 4;
    LAS u16* xs = (LAS u16*)(lds + wid * 8192);
    LAS float* xf = (LAS float*)(lds + wid * 8192 + 2560);
    const int tp = lane >> 3, co = lane & 7;
    for (int item = blockIdx.x * 8 + wid; item < 2048; item += gridDim.x * 8) {
        const int b = item >> 8, g = (item >> 4) & 15, seg = item & 15, ccol = g * 64 + co * 8;
        LAS u16* Wsh = (LAS u16*)(lds + 65536);
        __syncthreads();
        for (int e = tid; e < 4096; e += 512) { const int i = e >> 6, j = e & 63; Wsh[j * 72 + i] = f2bf(wa[(size_t)(g * 64 + i) * 64 + j]); Wsh[4608 + j * 72 + i] = f2bf(wx[(size_t)(g * 64 + i) * 64 + j]); }
        __syncthreads();
        if (pass == 0 && seg == 15) continue;
        float bav[4], bxv[4], c8[4], carry[4], aprod[4];
#pragma unroll
        for (int nt = 0; nt < 4; ++nt) { const int cch = g * 64 + nt * 16 + fr;
            bav[nt] = ba[cch]; bxv[nt] = bx[cch]; c8[nt] = -8.f * log1pf(__expf(-lam[cch])); carry[nt] = 0.f; aprod[nt] = 1.f;
            if (pass == 1) for (int s2 = 0; s2 < seg; ++s2) carry[nt] = sumA[(size_t)(b * 16 + s2) * 1024 + cch] * carry[nt] + sumH[(size_t)(b * 16 + s2) * 1024 + cch]; }
        float w0[8], w1[8], w2[8], w3[8], bb[8];
#pragma unroll
        for (int e = 0; e < 8; ++e) { w0[e] = cw[ccol + e]; w1[e] = cw[1024 + ccol + e]; w2[e] = cw[2048 + ccol + e]; w3[e] = cw[3072 + ccol + e]; bb[e] = cb[ccol + e]; }
        const size_t tb0 = (size_t)b * SEQ; const int sb = seg * 128;
        u32x4 rows[5]; u16 grv[4][4];
#pragma unroll
        for (int r = 0; r < 5; ++r) { const int srow = sb + 2 * tp - 3 + r; rows[r] = (srow >= 0) ? *(const u32x4*)(xr + (tb0 + srow) * 1024 + ccol) : (u32x4){0u, 0u, 0u, 0u}; }
#pragma unroll
        for (int nt = 0; nt < 4; ++nt)
#pragma unroll
            for (int j = 0; j < 4; ++j) grv[nt][j] = (pass == 1) ? gr[(tb0 + sb + 4 * fq + j) * 1024 + g * 64 + nt * 16 + fr] : (u16)0;
        for (int st = 0; st < 8; ++st) {
            u32x4 cur[5]; u16 gcur[4][4];
#pragma unroll
            for (int r = 0; r < 5; ++r) cur[r] = rows[r];
#pragma unroll
            for (int nt = 0; nt < 4; ++nt)
#pragma unroll
                for (int j = 0; j < 4; ++j) gcur[nt][j] = grv[nt][j];
            const int t0 = sb + st * 16;
            if (st + 1 < 8) {
#pragma unroll
                for (int r = 0; r < 5; ++r) rows[r] = *(const u32x4*)(xr + (tb0 + t0 + 16 + 2 * tp - 3 + r) * 1024 + ccol);
                if (pass == 1) {
#pragma unroll
                    for (int nt = 0; nt < 4; ++nt)
#pragma unroll
                        for (int j = 0; j < 4; ++j) grv[nt][j] = gr[(tb0 + t0 + 16 + 4 * fq + j) * 1024 + g * 64 + nt * 16 + fr]; }
            }
            float r0[8], r1[8], r2[8], r3[8], r4[8], oa[8], ob[8];
            unpack8(cur[0], r0); unpack8(cur[1], r1); unpack8(cur[2], r2); unpack8(cur[3], r3); unpack8(cur[4], r4);
#pragma unroll
            for (int e = 0; e < 8; ++e) { oa[e] = bb[e] + w0[e] * r0[e] + w1[e] * r1[e] + w2[e] * r2[e] + w3[e] * r3[e]; ob[e] = bb[e] + w0[e] * r1[e] + w1[e] * r2[e] + w2[e] * r3[e] + w3[e] * r4[e]; }
            { u32x4 pa, pb; pa.x = pk2(oa[0], oa[1]); pa.y = pk2(oa[2], oa[3]); pa.z = pk2(oa[4], oa[5]); pa.w = pk2(oa[6], oa[7]); pb.x = pk2(ob[0], ob[1]); pb.y = pk2(ob[2], ob[3]); pb.z = pk2(ob[4], ob[5]); pb.w = pk2(ob[6], ob[7]);
              *(LAS u32x4*)(xs + (2 * tp) * 72 + co * 8) = pa; *(LAS u32x4*)(xs + (2 * tp + 1) * 72 + co * 8) = pb;
              *(LAS f32x4*)(xf + (2 * tp) * 68 + co * 8) = (f32x4){oa[0], oa[1], oa[2], oa[3]}; *(LAS f32x4*)(xf + (2 * tp) * 68 + co * 8 + 4) = (f32x4){oa[4], oa[5], oa[6], oa[7]};
              *(LAS f32x4*)(xf + (2 * tp + 1) * 68 + co * 8) = (f32x4){ob[0], ob[1], ob[2], ob[3]}; *(LAS f32x4*)(xf + (2 * tp + 1) * 68 + co * 8 + 4) = (f32x4){ob[4], ob[5], ob[6], ob[7]}; }
            __builtin_amdgcn_fence(__ATOMIC_RELEASE, "wavefront"); __builtin_amdgcn_wave_barrier(); __builtin_amdgcn_fence(__ATOMIC_ACQUIRE, "wavefront");
            const bf16x8 af0 = *(const LAS bf16x8*)(xs + fr * 72 + 8 * fq), af1 = *(const LAS bf16x8*)(xs + fr * 72 + 32 + 8 * fq);
#pragma unroll
            for (int nt = 0; nt < 4; ++nt) {
                f32x4 aa = (f32x4){0.f, 0.f, 0.f, 0.f}, ax = (f32x4){0.f, 0.f, 0.f, 0.f};
                { const LAS u16* wp = Wsh + (nt * 16 + fr) * 72 + 8 * fq; const bf16x8 wa0 = *(const LAS bf16x8*)wp, wa1 = *(const LAS bf16x8*)(wp + 32), wx0 = *(const LAS bf16x8*)(wp + 4608), wx1 = *(const LAS bf16x8*)(wp + 4608 + 32);
                  aa = mfma16(af0, wa0, aa); aa = mfma16(af1, wa1, aa); ax = mfma16(af0, wx0, ax); ax = mfma16(af1, wx1, ax); }
                float hl[4], pa4[4]; float Al = 1.f, Hl = 0.f;
#pragma unroll
                for (int j = 0; j < 4; ++j) { const float xc = xf[(4 * fq + j) * 68 + nt * 16 + fr]; const float rr = sigm(aa[j] + bav[nt]), ii = sigm(ax[j] + bxv[nt]), la = c8[nt] * rr, av = __expf(la), x2 = 2.f * la;
                    const float om = (x2 > -0.02f) ? -x2 * (1.f + x2 * (0.5f + x2 * (1.f / 6.f))) : 1.f - av * av;
                    const float uu = __builtin_amdgcn_sqrtf(fmaxf(om, 0.f)) * ii * xc;
                    Hl = av * Hl + uu; Al *= av; hl[j] = Hl; pa4[j] = Al; }
                const float A0 = __shfl(Al, fr), H0 = __shfl(Hl, fr), A1 = __shfl(Al, fr + 16), H1 = __shfl(Hl, fr + 16), A2 = __shfl(Al, fr + 32), H2 = __shfl(Hl, fr + 32), A3 = __shfl(Al, fr + 48), H3 = __shfl(Hl, fr + 48);
                const float cin = carry[nt], c1 = A0 * cin + H0, c2 = A1 * c1 + H1, c3 = A2 * c2 + H2, c4 = A3 * c3 + H3;
                const float hin = (fq == 0) ? cin : (fq == 1) ? c1 : (fq == 2) ? c2 : c3;
                carry[nt] = c4; aprod[nt] *= (A0 * A1) * (A2 * A3);
                if (pass == 1) {
#pragma unroll
                    for (int j = 0; j < 4; ++j) { const float hv = hl[j] + pa4[j] * hin; ya[(tb0 + t0 + 4 * fq + j) * 1024 + g * 64 + nt * 16 + fr] = f2bf(gelu_t(bf2f(gcur[nt][j])) * hv); } }
            }
            __builtin_amdgcn_fence(__ATOMIC_RELEASE, "wavefront"); __builtin_amdgcn_wave_barrier(); __builtin_amdgcn_fence(__ATOMIC_ACQUIRE, "wavefront");
        }
        if (pass == 0 && fq == 0) {
#pragma unroll
            for (int nt = 0; nt < 4; ++nt) { sumA[(size_t)(b * 16 + seg) * 1024 + g * 64 + nt * 16 + fr] = aprod[nt]; sumH[(size_t)(b * 16 + seg) * 1024 + g * 64 + nt * 16 + fr] = carry[nt]; } }
    }
}

DI void ffn_act_phase(int mk_tid, const u16* up, const float* cw, const float* cb, u16* act, int part) {
    const int gtid = blockIdx.x * 512 + mk_tid, nth = gridDim.x * 512;
    for (int item = gtid; item < 192 * 1024; item += nth) {
        const int co = item % 192, tb = item / 192, c0 = co * 8, t0 = tb * 16, gc = part * 1536 + c0;
        float wg0[8], wg1[8], wg2[8], wu0[8], wu1[8], wu2[8], bg[8], bu[8];
#pragma unroll
        for (int e = 0; e < 8; ++e) { wg0[e] = cw[gc + e]; wg1[e] = cw[6144 + gc + e]; wg2[e] = cw[12288 + gc + e]; wu0[e] = cw[3072 + gc + e]; wu1[e] = cw[6144 + 3072 + gc + e]; wu2[e] = cw[12288 + 3072 + gc + e]; bg[e] = cb[gc + e]; bu[e] = cb[3072 + gc + e]; }
        float g0[8], g1[8], g2[8], u0[8], u1[8], u2[8];
        if ((t0 & (SEQ - 1)) == 0) {
#pragma unroll
            for (int e = 0; e < 8; ++e) { g0[e] = 0.f; g1[e] = 0.f; u0[e] = 0.f; u1[e] = 0.f; }
        } else {
            unpack8(*(const u32x4*)(up + (size_t)(t0 - 2) * 3072 + c0), g0); unpack8(*(const u32x4*)(up + (size_t)(t0 - 1) * 3072 + c0), g1);
            unpack8(*(const u32x4*)(up + (size_t)(t0 - 2) * 3072 + 1536 + c0), u0); unpack8(*(const u32x4*)(up + (size_t)(t0 - 1) * 3072 + 1536 + c0), u1);
        }
        for (int tt = 0; tt < 16; ++tt) {
            unpack8(*(const u32x4*)(up + (size_t)(t0 + tt) * 3072 + c0), g2); unpack8(*(const u32x4*)(up + (size_t)(t0 + tt) * 3072 + 1536 + c0), u2);
            float o[8];
#pragma unroll
            for (int e = 0; e < 8; ++e) { const float gv = bg[e] + wg0[e] * g0[e] + wg1[e] * g1[e] + wg2[e] * g2[e], uv = bu[e] + wu0[e] * u0[e] + wu1[e] * u1[e] + wu2[e] * u2[e]; o[e] = gelu_t(gv) * uv; g0[e] = g1[e]; g1[e] = g2[e]; u0[e] = u1[e]; u1[e] = u2[e]; }
            u32x4 r; r.x = pk2(o[0], o[1]); r.y = pk2(o[2], o[3]); r.z = pk2(o[4], o[5]); r.w = pk2(o[6], o[7]);
            *(u32x4*)(act + (size_t)(t0 + tt) * 3072 + gc) = r;
        }
    }
}

DI UE ue_bf16(u16* O, int ldc, int split) { UE e; e.perm = 1; e.kind = 0; e.O = O; e.ldc = ldc; e.split = split; e.gate = nullptr; e.F = nullptr; e.Fin = nullptr; e.ss = nullptr; e.smode = 0; e.HBo = nullptr; e.sso = nullptr; e.ssp = nullptr; e.cnt = nullptr; e.rflags = 0; return e; }
DI GD mkgd(const u16* A, const u16* Bt, int M, int N, int K, int cshift, UE e) { GD d; d.A = A; d.Bt = Bt; d.M = M; d.N = N; d.K = K; d.cshift = cshift; d.e = e; return d; }

#define XB_TMO      128
#define XB_XCNT(j)  (256  + 64 * (j))
#define XB_XSUB(j)  (1280 + 64 * (j))
#define XB_XGEN(j)  (2304 + 64 * (j))
#define XB_TOP      3328
#define XB_TOPGEN   3392
#define XCD_BAR_WORDS 3456
#define XB_SPIN_CAP (1u << 18)

__device__ __forceinline__ unsigned xb_ld(unsigned* p)              { return __hip_atomic_load(p, __ATOMIC_RELAXED, __HIP_MEMORY_SCOPE_AGENT); }
__device__ __forceinline__ unsigned xb_add(unsigned* p, unsigned v) { return __hip_atomic_fetch_add(p, v, __ATOMIC_RELAXED, __HIP_MEMORY_SCOPE_AGENT); }
__device__ __forceinline__ unsigned xb_xcc_id() { return (unsigned)__builtin_amdgcn_s_getreg((3 << 11) | 20) & 0xFu; }
#define XB_SPIN(cond, bar) do { unsigned _sp = 0; while (cond) { __builtin_amdgcn_s_sleep(1); \
    if ((++_sp & 255u) == 0u) { if (xb_ld(&(bar)[XB_TMO])) break; if (_sp > XB_SPIN_CAP) { atomicAdd(&(bar)[XB_TMO], 1u); break; } } } } while (0)

struct XcdBarrier {
    unsigned* bar; unsigned x;
    volatile LAS unsigned* st;
};

__device__ __forceinline__ XcdBarrier xcd_barrier_post(unsigned* bar, volatile LAS unsigned* st) {
    XcdBarrier b; b.bar = bar; b.x = xb_xcc_id(); b.st = st;
    if (threadIdx.x == 0) (void)xb_add(&bar[XB_XCNT(b.x)], 1u);
    return b;
}
__device__ __forceinline__ void xcd_barrier_complete(unsigned* bar, unsigned x, unsigned& nloc, unsigned& nx) {
    const unsigned G = gridDim.x * gridDim.y * gridDim.z;
    unsigned sum, cnt, mine, sp = 0u;
    for (;;) {
        sum = 0u; cnt = 0u; mine = 0u;
#pragma unroll
        for (unsigned j = 0; j < 16; ++j) { const unsigned c = xb_ld(&bar[XB_XCNT(j)]); sum += c; cnt += (c > 0u) ? 1u : 0u; mine = (j == x) ? c : mine; }
        if (sum == G) break;
        __builtin_amdgcn_s_sleep(1);
        if ((++sp & 255u) == 0u) { if (xb_ld(&bar[XB_TMO])) break; if (sp > XB_SPIN_CAP) { atomicAdd(&bar[XB_TMO], 1u); break; } }
    }
    nloc = mine > 0u ? mine : 1u; nx = cnt > 0u ? cnt : 1u;
}

__device__ __forceinline__ void xcd_barrier(const XcdBarrier& b) {
    asm volatile("s_waitcnt vmcnt(0)" ::: "memory");
    __syncthreads();
    if (threadIdx.x == 0) {
        unsigned* bar = b.bar;
        __builtin_amdgcn_s_waitcnt(0);
        unsigned nloc = b.st[0], nx = b.st[1];
        if (nloc == 0u) { xcd_barrier_complete(bar, b.x, nloc, nx); b.st[0] = nloc; b.st[1] = nx; }
        const unsigned old = xb_add(&bar[XB_XSUB(b.x)], 1u);
        const unsigned gen = old / nloc;
        if (old + 1u == (gen + 1u) * nloc) {
            __builtin_amdgcn_fence(__ATOMIC_RELEASE, "agent");
            asm volatile("s_waitcnt vmcnt(0)" ::: "memory");
            const unsigned og = xb_add(&bar[XB_TOP], 1u);
            const unsigned tg = og / nx;
            if (og + 1u == (tg + 1u) * nx) xb_add(&bar[XB_TOPGEN], 1u);
            else XB_SPIN(xb_ld(&bar[XB_TOPGEN]) == tg, bar);
            __builtin_amdgcn_fence(__ATOMIC_ACQUIRE, "agent");
            xb_add(&bar[XB_XGEN(b.x)], 1u);
            asm volatile("s_waitcnt vmcnt(0)" ::: "memory");
        } else {
            XB_SPIN(xb_ld(&bar[XB_XGEN(b.x)]) == gen, bar);
            __builtin_amdgcn_fence(__ATOMIC_ACQUIRE, "agent");
            asm volatile("s_waitcnt vmcnt(0)" ::: "memory");
        }
    }
    __syncthreads();
}

DI int gemm_count(int sub) { return (sub == S_GXR) ? 1 : (sub == S_GQK || sub == S_GAB || sub == S_GMIX) ? 2 : 0; }
DI GD get_gd(const Args& a, int l, int sub, int i) {
    unsigned char* ws = a.ws;
    u16* A0 = (u16*)ws; u16* A1 = (u16*)(ws + U); u16* A2 = (u16*)(ws + 2 * U); u16* A3 = (u16*)(ws + 3 * U); u16* A4 = (u16*)(ws + 4 * U); u16* A5 = (u16*)(ws + 5 * U); u16* A6 = (u16*)(ws + 6 * U);
    u16* WT = (u16*)(ws + WS_WT); u16* MEMN = (u16*)(ws + WS_MEMN); u16* KMEM = A3; u16* VTM = A3 + 2097152;
    float* SS = (float*)(ws + WS_SS);
    const size_t MW = (size_t)1024 * 1024;
    UE er = ue_bf16(nullptr, 1024, 0); er.perm = 1; er.kind = 3; er.ssp = (float*)(ws + WS_SSP); er.cnt = (unsigned*)(ws + WS_CNT) + (size_t)(l * 3 + (sub == S_GMIX ? 0 : sub == S_GWO ? 1 : 2)) * 64; er.Fin = (l == 0 && sub == S_GMIX) ? a.in[0] : a.out; er.F = a.out;
    switch (sub) {
    case S_GQK: { UE eo = ue_bf16(A1, 1024, 0); eo.ss = SS + (size_t)(l * 3) * T; eo.smode = 1; UE ev = ue_bf16(A2, T, 0); ev.ss = SS + (size_t)(l * 3) * T; ev.smode = 2;
        return i == 0 ? mkgd(A0, WT + 2 * MW, T, 1024, 1024, 0, eo) : mkgd(WT + 3 * MW, A0, 1024, T, 1024, 0, ev); }
    case S_GXR: { UE e = ue_bf16(A1, 1024, 1); e.ss = SS + (size_t)(l * 3) * T; e.smode = 1; return mkgd(A0, WT + 4 * MW, T, 4096, 1024, 0, e); }
    case S_GAB: { UE e1 = ue_bf16(nullptr, 1024, 0); e1.perm = 1; e1.kind = 1; e1.gate = A3; e1.O = A1; UE e2 = e1; e2.kind = 2; e2.gate = A4; e2.Fin = (const float*)A1; e2.O = A0;
        return i == 0 ? mkgd(A5, WT + 8 * MW, T, 1024, 1024, 0, e1) : mkgd(A6, WT + 9 * MW, T, 1024, 1024, 0, e2); }
    case S_GMIX: return i == 0 ? mkgd(MEMN, WT + MW, 2048, 1024, 1024, 0, ue_bf16(KMEM, 1024, 0)) : mkgd(WT + 2 * MW, MEMN, 1024, 2048, 1024, 64, ue_bf16(VTM, 2048, 0));
    case S_GWO: er.HBo = A0; er.sso = SS + (size_t)(l * 3 + 2) * T; er.Fin = (const float*)A1; er.rflags = 1; return mkgd(A2, WT + 3 * MW, T, 1024, 1024, 0, er);
    default: er.HBo = A0; er.sso = SS + (size_t)(l * 3 + 3) * T; er.Fin = (const float*)A0; er.rflags = 3; return mkgd(A4, WT + 11 * MW, T, 1024, 3072, 0, er);
    }
}
DI void cvt_set(int mk_tid, LAS unsigned char* lds, const Args& a, int l, int set) {
    u16* WT = (u16*)(a.ws + WS_WT); const size_t MW = (size_t)1024 * 1024; int tb = 0; const int nj = set == 0 ? 8 : set == 1 ? 3 : 1;
    for (int j = 0; j < nj; ++j) {
        const float* W; int ldw, col0, ncols, K = 1024, il = 0; u16* dst; const float* gain = nullptr;
        if (set == 0) { const float* win = a.in[3] + (size_t)l * 1024 * 8200;
            if (j < 5) { W = win; ldw = 8200; col0 = (j == 0) ? 2048 : (j == 1) ? 5120 : (j == 2) ? 4096 : (j == 3) ? 0 : 6152; ncols = (j == 1 || j == 2) ? 1024 : 2048; dst = WT + ((j == 0) ? 0 : (j == 1) ? 2 : (j == 2) ? 3 : (j == 3) ? 4 : 6) * MW; gain = a.in[2] + l * 1024; }
            else { W = a.in[15 + (j - 5)] + l * MW; ldw = 1024; col0 = 0; ncols = 1024; dst = WT + (8 + (j - 5)) * MW; } }
        else if (set == 1) { W = (j == 0) ? a.in[19] + l * MW : (j == 1) ? a.in[20] + l * 2 * MW : a.in[21] + l * MW; ldw = (j == 1) ? 2048 : 1024; col0 = 0; ncols = (j == 1) ? 2048 : 1024; dst = WT + ((j == 0) ? 0 : (j == 1) ? 1 : 3) * MW; gain = (j == 0) ? a.in[18] + l * 1024 : nullptr; }
        else if (set == 2) { W = a.in[23] + (size_t)l * 6 * MW; ldw = 6144; col0 = 0; ncols = 6144; il = 1; dst = WT + 4 * MW; gain = a.in[22] + l * 1024; }
        else { W = a.in[26] + (size_t)l * 3 * MW; ldw = 1024; col0 = 0; ncols = 1024; K = 3072; dst = WT + 11 * MW; }
        cvt_w(mk_tid, lds, W, ldw, col0, ncols, K, dst, tb, il, gain);
    }
}
DI void ifg_rows(int mk_tid, LAS unsigned char* lds, const u16* hb, const float* ss, const float* win, const float* g, const float* ifb, float* ifg) {
    const int tid = mk_tid, lane = tid & 63, wid = tid >> 6;
    LAS float* sW = (LAS float*)lds;
    __syncthreads();
    for (int e = tid; e < 8192; e += 512) sW[e] = win[(size_t)(e >> 3) * 8200 + 6144 + (e & 7)] * g[e >> 3];
    __syncthreads();
    for (int r0 = blockIdx.x * 64; r0 < T; r0 += gridDim.x * 64) {
        u16 hv[8][16];
#pragma unroll
        for (int rr = 0; rr < 8; ++rr)
#pragma unroll
            for (int e = 0; e < 16; ++e) hv[rr][e] = hb[(size_t)(r0 + wid * 8 + rr) * 1024 + e * 64 + lane];
#pragma unroll
        for (int rr = 0; rr < 8; ++rr) { const int row = r0 + wid * 8 + rr;
            float a0 = 0, a1 = 0, a2 = 0, a3 = 0, a4 = 0, a5 = 0, a6 = 0, a7 = 0;
#pragma unroll
            for (int e = 0; e < 16; ++e) { const int k = e * 64 + lane; const float y = bf2f(hv[rr][e]); const LAS f32x4* wp = (const LAS f32x4*)(sW + k * 8); const f32x4 w0 = wp[0], w1 = wp[1];
                a0 += y * w0.x; a1 += y * w0.y; a2 += y * w0.z; a3 += y * w0.w; a4 += y * w1.x; a5 += y * w1.y; a6 += y * w1.z; a7 += y * w1.w; }
            a0 = wsum(a0); a1 = wsum(a1); a2 = wsum(a2); a3 = wsum(a3); a4 = wsum(a4); a5 = wsum(a5); a6 = wsum(a6); a7 = wsum(a7);
            if (lane == 0) { const float rs = rsqrtf(ss[row] * (1.f / 1024.f) + 1e-6f); float4 o0, o1; o0.x = a0 * rs + ifb[0]; o0.y = a1 * rs + ifb[1]; o0.z = a2 * rs + ifb[2]; o0.w = a3 * rs + ifb[3]; o1.x = a4 * rs + ifb[4]; o1.y = a5 * rs + ifb[5]; o1.z = a6 * rs + ifb[6]; o1.w = a7 * rs + ifb[7];
                *(float4*)(ifg + (size_t)row * 8) = o0; *(float4*)(ifg + (size_t)row * 8 + 4) = o1; }
            __builtin_amdgcn_sched_barrier(0); }
    }
    __syncthreads();
}
DI void raw_rows(int mk_tid, const float* src, u16* dst, float* ssout) {
    const int lane = mk_tid & 63, gw = blockIdx.x * 8 + (mk_tid >> 6), nw = gridDim.x * 8;
    for (int row = gw; row < T; row += nw) {
        float4 v[4]; float sq = 0.f;
#pragma unroll
        for (int i = 0; i < 4; ++i) { v[i] = *(const float4*)(src + (size_t)row * 1024 + i * 256 + lane * 4); sq += v[i].x * v[i].x + v[i].y * v[i].y + v[i].z * v[i].z + v[i].w * v[i].w; }
        sq = wsum(sq);
#pragma unroll
        for (int i = 0; i < 4; ++i) { u32x2 w; w.x = pk2(v[i].x, v[i].y); w.y = pk2(v[i].z, v[i].w); *(u32x2*)(dst + (size_t)row * 1024 + i * 256 + lane * 4) = w; }
        if (lane == 0) ssout[row] = sq;
    }
}
DI void resid_gemm(int mk_tid, LAS unsigned char* lds, const Args& a, int l, int which, const u16* A, const u16* Bt, int K, const float* Fin, u16* HBo, u16* HB2, int rflags) {
    unsigned char* ws = a.ws;
    Gemm g; g.A = A; g.Bt = Bt; g.M = T; g.N = 1024; g.K = K;
    UE3 e; e.perm = 1; e.Fin = Fin; e.F = a.out; e.HBo = HBo; e.HB2 = HB2; e.sso = (float*)(ws + WS_SS) + (size_t)(l * 3 + which + 1) * T; e.ssp = (float*)(ws + WS_SSP); e.cnt = (unsigned*)(ws + WS_CNT) + (size_t)(l * 3 + which) * 64; e.rflags = rflags;
    StaticOrder S; S.init(T, 1024, (int)gridDim.x, (int)blockIdx.x);
    for (int i = 0; ; ++i) { OneUnit O; if (!S.next(i, O.u)) break; __syncthreads(); gemm_phase<UE3, OneUnit, false>(mk_tid, lds, g, O, e, nullptr); }
}
DI void init_phase(int mk_tid, LAS unsigned char* lds, const Args& a) {
    unsigned char* ws = a.ws; float* SS = (float*)(ws + WS_SS);
    for (int i = blockIdx.x * 512 + mk_tid; i < 1024; i += gridDim.x * 512) ((unsigned*)(ws + WS_CNT))[i] = 0u;
    cvt_set(mk_tid, lds, a, 0, 0);
    raw_rows(mk_tid, a.in[0], (u16*)ws, SS);
    norm_rows(mk_tid, a.in[1], a.in[27], (u16*)(ws + WS_MEMN), 2048, nullptr, nullptr, nullptr);
}
DI void other_phase(int mk_tid, LAS unsigned char* lds, const Args& a, int l, int sub) {
    unsigned char* ws = a.ws;
    u16* A0 = (u16*)ws; u16* A1 = (u16*)(ws + U); u16* A2 = (u16*)(ws + 2 * U); u16* A3 = (u16*)(ws + 3 * U); u16* A4 = (u16*)(ws + 4 * U); u16* A5 = (u16*)(ws + 5 * U); u16* A6 = (u16*)(ws + 6 * U);
    u16* WT = (u16*)(ws + WS_WT); u16* KMEM = A3; u16* VTM = A3 + 2097152;
    float* IFG = (float*)(ws + WS_IFG); float* GZ = (float*)(ws + WS_GZ); float* GM = (float*)(ws + WS_GM); float* GE = (float*)(ws + WS_GE); float* GMS = (float*)(ws + WS_GMS); float* GML = (float*)(ws + WS_GML); float* NVEC = (float*)(ws + WS_NVEC);
    float* SS = (float*)(ws + WS_SS);
    const int tid = mk_tid, wid = tid >> 6;
    const size_t MW = (size_t)1024 * 1024;
    switch (sub) {
    case S_GQK: {
        ifg_rows(mk_tid, lds, A0, SS + (size_t)(l * 3) * T, a.in[3] + (size_t)l * 1024 * 8200, a.in[2] + l * 1024, a.in[13] + l * 8, IFG);
        Gemm g; g.A = A0; g.Bt = WT; g.M = T; g.N = 2048; g.K = 1024;
        UE6 e6; e6.perm = 0; e6.qc = A6; e6.kc = A5; e6.HB = (float*)(ws + WS_HBQ); e6.cw = a.in[11] + l * 8192; e6.cb = a.in[12] + l * 2048; e6.ss = SS + (size_t)(l * 3) * T;
        StaticOrder S; S.init(T, 2048, (int)gridDim.x, (int)blockIdx.x);
        for (int i = 0; ; ++i) { OneUnit O; if (!S.next(i, O.u)) break; __syncthreads(); gemm_phase<UE6, OneUnit, false>(mk_tid, lds, g, O, e6, nullptr); }
    } break;
    case S_STATE: mlstm_state_phase(mk_tid, lds, A5, A2, (float*)(ws + WS_GW), GMS, GML, A3, NVEC, IFG, GZ, GM, GE, (const float*)(ws + WS_HBQ), a.in[11] + l * 8192, a.in[12] + l * 2048); break;
    case S_OUT: mlstm_out_phase(mk_tid, lds, A6, A5, A2, A3, NVEC, A1, GZ, GM, GE, GMS, a.in[14] + l * 1024, 0, (const float*)(ws + WS_HBQ), a.in[11] + l * 8192, a.in[12] + l * 2048); break;
    case S_RG0: case S_RG1:
        if (sub == S_RG0) { cvt_set(mk_tid, lds, a, l, 1); __syncthreads(); }
        rglru_phase(mk_tid, lds, A1, A2, a.in[4] + l * 4096, a.in[5] + l * 1024, a.in[6] + l * 65536, a.in[7] + l * 1024, a.in[8] + l * 65536, a.in[9] + l * 1024, a.in[10] + l * 1024, A5, sub - S_RG0, (float*)(ws + WS_SUMA), (float*)(ws + WS_SUMH)); break;
    case S_GQKV: {
        cvt_set(mk_tid, lds, a, l, 2);
        Gemm g; g.A = A1; g.Bt = WT; g.M = T; g.N = 1024; g.K = 1024;
        UE eq = ue_bf16(A0, 1024, 0); eq.ss = SS + (size_t)(l * 3 + 1) * T; eq.smode = 1;
        StaticOrder S; S.init(T, 1024, (int)gridDim.x, (int)blockIdx.x);
        for (int i = 0; ; ++i) { OneUnit O; if (!S.next(i, O.u)) break; __syncthreads();
            gemm_phase<UE, OneUnit, false>(mk_tid, lds, g, O, eq, nullptr);
            asm volatile("s_waitcnt vmcnt(0)" ::: "memory"); __syncthreads();
            int t2 = mk_tid; asm volatile("" : "+v"(t2));
            xattn_pair(t2, lds, A0, KMEM, VTM, A2, O.u.pm >> 3, O.u.pn, (O.u.pm & 7) * 2); }
    } break;
    case S_GUP: {
        cvt_set(mk_tid, lds, a, l, 3);
        Gemm g; g.A = A0; g.Bt = WT + 4 * MW; g.M = T; g.N = 6144; g.K = 1024;
        UE5 e5; e5.perm = 0; e5.act = A4; e5.HB = (float*)A1; e5.cw = a.in[24] + l * 18432; e5.cb = a.in[25] + l * 6144; e5.ss = SS + (size_t)(l * 3 + 2) * T;
        StaticOrder S; S.init(T, 6144, (int)gridDim.x, (int)blockIdx.x);
        for (int i = 0; ; ++i) { OneUnit O; if (!S.next(i, O.u)) break; __syncthreads(); gemm_phase<UE5, OneUnit, false>(mk_tid, lds, g, O, e5, nullptr); }
    } break;
    case S_GDOWN: {
        if (l == 0) cvt_set(mk_tid, lds, a, 1, 0);
        StaticOrder S; S.init(T, 1024, (int)gridDim.x, (int)blockIdx.x);
        for (int i = 0; ; ++i) { Unit u; if (!S.next(i, u)) break; ffn_fix_tile(mk_tid, (const float*)A1, a.in[24] + l * 18432, a.in[25] + l * 6144, A4, u.pm); }
        asm volatile("s_waitcnt vmcnt(0)" ::: "memory"); __syncthreads();
        resid_gemm(mk_tid, lds, a, l, 2, A4, WT + 11 * MW, 3072, (const float*)A0, A0, (l == 0) ? (u16*)a.out : nullptr, 1);
    } break;
    case S_GMIX: resid_gemm(mk_tid, lds, a, l, 0, A0, WT + 10 * MW, 1024, (l == 0) ? a.in[0] : a.out, A1, nullptr, (l == 0) ? 0 : 1); break;
    case S_GWO: resid_gemm(mk_tid, lds, a, l, 1, A2, WT + 3 * MW, 1024, (const float*)A1, A0, nullptr, 1); break;
    default: break;
    }
}

__global__ void __launch_bounds__(512, 2) mk_fwd(Args a) {
    extern __shared__ __attribute__((aligned(16))) unsigned char shm[];
    LAS unsigned char* lds = (LAS unsigned char*)shm;
    cg::grid_group grid = cg::this_grid();
    if (a.ph_hi < 0) grid.sync();
    volatile LAS unsigned* xst = (volatile LAS unsigned*)(lds + LDS_BYTES - 16);
    if (threadIdx.x == 0) { xst[0] = 0u; xst[1] = 0u; }
    __syncthreads();
    const XcdBarrier xbar = xcd_barrier_post((unsigned*)(a.ws + WS_BAR), xst);
    int tid0 = threadIdx.x;
    for (int ph = a.ph_lo; ph < a.ph_hi; ++ph) {
        if (ph > a.ph_lo) xcd_barrier(xbar);
        asm volatile("" : "+v"(tid0)); const int mk_tid = tid0;
        if (ph == 0) { init_phase(mk_tid, lds, a); continue; }
        if (ph == NPH - 1) { final_norm(mk_tid, (const u16*)a.ws, a.out, a.in[28]); continue; }
        const int l = (ph - 1) / PL, sub = (ph - 1) % PL;
        const int ng = gemm_count(sub);
        other_phase(mk_tid, lds, a, l, sub);
#if PROBE_DUP
        { const int bit = (sub == S_GQK || sub == S_GUP) ? 2 : (sub == S_STATE) ? 4 : (sub == S_RG0 || sub == S_RG1) ? 8 : (0) ? 16 : (sub == S_GDOWN) ? 32 : 0;
          if (PROBE_DUP & bit) { __syncthreads(); other_phase(mk_tid, lds, a, l, sub); } }
        if (PROBE_DUP & 128) xcd_barrier(xbar);
        if (PROBE_DUP & 1) for (int i = 0; i < ng; ++i) {
            GD d = get_gd(a, l, sub, i); d.e.kind = 4;
            __syncthreads();
            Gemm g; g.A = d.A; g.Bt = d.Bt; g.M = d.M; g.N = d.N; g.K = d.K;
            StaticOrder S; S.init(d.M, d.N, (int)gridDim.x, (int)((blockIdx.x + d.cshift) % gridDim.x));
            gemm_phase<UE, StaticOrder, false>(mk_tid, lds, g, S, d.e, nullptr);
        }
#endif
        for (int i = 0; i < ng; ++i) {
            GD d = get_gd(a, l, sub, i);
            __syncthreads();
            Gemm g; g.A = d.A; g.Bt = d.Bt; g.M = d.M; g.N = d.N; g.K = d.K;
            StaticOrder S; S.init(d.M, d.N, (int)gridDim.x, (int)((blockIdx.x + d.cshift) % gridDim.x));
            gemm_phase<UE, StaticOrder, false>(mk_tid, lds, g, S, d.e, nullptr);
        }
    }
}

extern "C" void kernel_launch(void* const* d_in, const int* in_sizes, int n_in, void* d_out, int out_size, void* d_ws, size_t ws_size, hipStream_t stream) {
    static int grid = 0;
    if (grid == 0) {
        if (n_in != 29 || out_size != T * 1024 || ws_size < WS_END) { fprintf(stderr, "kernel_launch: unexpected shapes (n_in %d out %d ws %zu need %zu)\n", n_in, out_size, ws_size, (size_t)WS_END); grid = -1; return; }
        int dev = 0, cus = 0, per_cu = 0;
        hipGetDevice(&dev); hipDeviceGetAttribute(&cus, hipDeviceAttributeMultiprocessorCount, dev);
        hipFuncSetAttribute((const void*)mk_fwd, hipFuncAttributeMaxDynamicSharedMemorySize, LDS_BYTES);
        hipOccupancyMaxActiveBlocksPerMultiprocessor(&per_cu, (const void*)mk_fwd, 512, LDS_BYTES);
        if (per_cu < 1) per_cu = 1;
        grid = cus * per_cu;
        (void)hipGetLastError();
    }
    if (grid < 0) return;
    Args a{};
    for (int i = 0; i < 29; ++i) a.in[i] = (const float*)d_in[i];
    a.out = (float*)d_out; a.ws = (unsigned char*)d_ws;
#if defined(MK_PER_PHASE)
    for (int ph = 0; ph < NPH; ++ph) { a.ph_lo = ph; a.ph_hi = ph + 1; hipLaunchKernelGGL(mk_fwd, dim3(grid), dim3(512), LDS_BYTES, stream, a); }
#else
    a.ph_lo = 0; a.ph_hi = NPH;
    (void)hipMemsetAsync((unsigned char*)d_ws + WS_BAR, 0, 16384, stream);
    void* args[] = {&a};
    hipError_t e = hipLaunchCooperativeKernel((void*)mk_fwd, dim3(grid), dim3(512), args, LDS_BYTES, stream);
    if (e != hipSuccess) fprintf(stderr, "cooperative launch failed: %s (grid %d)\n", hipGetErrorString(e), grid);
#endif
}
```

```cpp
#include <hip/hip_runtime.h>
#include <hip/hip_cooperative_groups.h>
#include <cstdio>
namespace cg = cooperative_groups;
namespace pg8 {
#define PG8_LAS __attribute__((address_space(3)))
typedef unsigned short bf16_t;
typedef short bf16x8 __attribute__((ext_vector_type(8)));
typedef float f32x4 __attribute__((ext_vector_type(4)));
typedef unsigned u32x4 __attribute__((ext_vector_type(4)));
constexpr int BM = 256, BK = 64, HALF = 128, HTB = HALF * BK * 2  , STAGE_BYTES = 8 * HTB, NXCD = 8, WGM = 8;

__host__ __device__ __forceinline__ int lds_byte(int r, int c) { const int st = (r >> 4) * 2 + (c >> 5), rr = r & 15, cc = c & 31, ob = rr * 64 + cc * 2; return st * 1024 + (ob ^ (((ob >> 9) & 1) << 5)); }
__host__ __device__ __forceinline__ void stage_rc(int b, int& R, int& C) { const int st = b / 1024, sb = b % 1024, swz = sb ^ (((sb >> 9) & 1) << 5); R = (st >> 1) * 16 + swz / 64; C = (st & 1) * 32 + (swz % 64) / 2; }
__host__ __device__ __forceinline__ int perm32(int rho) { const int n = rho >> 4, i = rho & 15; return 8 * (i >> 2) + 4 * n + (i & 3); }

struct Unit { int pm, pn; };
struct Gemm { const bf16_t* A; const bf16_t* Bt; int M, N, K; };

struct StaticOrder {
    int nM, nN, nwg, G, c;
    __host__ __device__ void init(int M, int N, int G_, int c_) { nM = M / BM; nN = N / BM; nwg = nM * nN; G = G_; c = c_; }
    __host__ __device__ bool next(int i, Unit& u) const {
        const long L = (long)i * G + c; if (L >= nwg) return false;
        int wgid = (int)L; { const int q = nwg / NXCD, r = nwg % NXCD, xcd = wgid % NXCD, off = wgid / NXCD; wgid = (xcd < r ? xcd * (q + 1) : r * (q + 1) + (xcd - r) * q) + off; }
        const int nig = WGM * nN, gid = wgid / nig, fm = gid * WGM, gsz = (nM - fm) < WGM ? (nM - fm) : WGM;
        u.pm = fm + ((wgid % nig) % gsz); u.pn = (wgid % nig) / gsz; return true;
    }
    __device__ __forceinline__ void a_ready(const Unit&) const {}
    __device__ __forceinline__ void done(const Unit&) const {}
};
__device__ __forceinline__ unsigned cvt_pk_bf16(float lo, float hi) { unsigned r; asm volatile("v_cvt_pk_bf16_f32 %0, %1, %2" : "=v"(r) : "v"(lo), "v"(hi)); return r; }
typedef float f32x2 __attribute__((ext_vector_type(2)));
template <class Epi, class Sched, bool STAMP = false>
__device__ __forceinline__ void gemm_phase(int mk_tid, PG8_LAS unsigned char* lds, const Gemm g, const Sched& S, const Epi& E, unsigned long long* stamps) {
    const int tid = mk_tid, wid = __builtin_amdgcn_readfirstlane(tid >> 6), lane = tid & 63, wr = wid >> 2, wc = wid & 3, fr = lane & 15, fq = lane >> 4;
    const int K = g.K, nt = K / BK;
    int ts_lo = 0, ts_hi = 0, nts = 0; const unsigned long long rt_entry = STAMP ? (unsigned long long)wall_clock64() : 0ull;
#define PG8_STAMP() do { if (STAMP && wid == 0 && nts < 64) { const unsigned long long _c = (unsigned long long)clock64(); \
        ts_lo = (lane == nts) ? (int)(unsigned)_c : ts_lo; ts_hi = (lane == nts) ? (int)(unsigned)(_c >> 32) : ts_hi; ++nts; } } while (0)
    PG8_STAMP();
    unsigned voffA[2], voffB[2];
#pragma unroll
    for (int i = 0; i < 2; ++i) { int R, C; stage_rc(tid * 16 + i * 8192, R, C); const int Rb = E.perm ? ((R & ~31) + perm32(R & 31)) : R;
        voffA[i] = (unsigned)(R * K + C) * 2u; voffB[i] = (unsigned)(Rb * K + C) * 2u; }
    const size_t kstep = (size_t)(BK * 2);
    const size_t hstep = (size_t)HALF * K * 2;
    const size_t tstep = 2 * hstep;
    const unsigned ldsw = (unsigned)wid * 1024u;
    const int aoff = lds_byte(wr * 64 + fr, fq * 8), boff = lds_byte(wc * 32 + fr, fq * 8);
#define PG8_SA(b, h) (((b) * 2 + (h)) * HTB)
#define PG8_SB(b, h) ((4 + (b) * 2 + (h)) * HTB)
#define PG8_STAGE(bufoff, gbase, voff) do { _Pragma("unroll") for (int _i = 0; _i < 2; ++_i) \
        __builtin_amdgcn_global_load_lds((const unsigned*)((const char*)(gbase) + (voff)[_i]), (PG8_LAS unsigned*)(lds + (bufoff) + ldsw + _i * 8192), 16, 0, 0); } while (0)
#define PG8_LDA(dst, b, h) do { _Pragma("unroll") for (int m = 0; m < 4; ++m) _Pragma("unroll") for (int k = 0; k < 2; ++k) dst[m][k] = *(const PG8_LAS bf16x8*)(lds + PG8_SA(b, h) + aoff + m * 2048 + k * 1024); } while (0)
#define PG8_LDB(dst, b, h) do { _Pragma("unroll") for (int n = 0; n < 2; ++n) _Pragma("unroll") for (int k = 0; k < 2; ++k) dst[n][k] = *(const PG8_LAS bf16x8*)(lds + PG8_SB(b, h) + boff + n * 2048 + k * 1024); } while (0)
#define PG8_MMA(ai, bj, At, Bt) do { __builtin_amdgcn_s_setprio(1); _Pragma("unroll") for (int m = 0; m < 4; ++m) _Pragma("unroll") for (int n = 0; n < 2; ++n) _Pragma("unroll") for (int k = 0; k < 2; ++k) \
        acc[ai][bj][m][n] = __builtin_amdgcn_mfma_f32_16x16x32_bf16(Bt[n][k], At[m][k], acc[ai][bj][m][n], 0, 0, 0); __builtin_amdgcn_s_setprio(0); } while (0)
#define PG8_WAIT_V(n) asm volatile("s_waitcnt vmcnt(" #n ")" ::: "memory")
#define PG8_WAIT_L(n) asm volatile("s_waitcnt lgkmcnt(" #n ")" ::: "memory")
#define PG8_BAR __builtin_amdgcn_s_barrier()
#define PG8_SCHED __builtin_amdgcn_sched_barrier(0)
    Unit cur, nxt; int ui = 0;
    if (!S.next(0, cur)) return;
    f32x4 acc[2][2][4][2];
#pragma unroll
    for (int a = 0; a < 2; ++a)
#pragma unroll
        for (int b = 0; b < 2; ++b)
#pragma unroll
            for (int m = 0; m < 4; ++m)
#pragma unroll
                for (int n = 0; n < 2; ++n) acc[a][b][m][n] = (f32x4){0.f, 0.f, 0.f, 0.f};
    bf16x8 At[4][2], B0[2][2], B1[2][2];
    const char* cA = (const char*)g.A + (size_t)cur.pm * tstep; const char* cB = (const char*)g.Bt + (size_t)cur.pn * tstep;
    S.a_ready(cur);
    PG8_STAGE(PG8_SB(0, 0), cB, voffB); PG8_STAGE(PG8_SA(0, 0), cA, voffA); PG8_STAGE(PG8_SB(0, 1), cB + hstep, voffB); PG8_STAGE(PG8_SA(0, 1), cA + hstep, voffA);
    if (wr == 1) PG8_BAR;
    PG8_WAIT_V(4); PG8_BAR;
    PG8_STAGE(PG8_SB(1, 0), cB + kstep, voffB); PG8_STAGE(PG8_SA(1, 0), cA + kstep, voffA); PG8_STAGE(PG8_SB(1, 1), cB + hstep + kstep, voffB);
    PG8_WAIT_V(6); PG8_BAR;
    PG8_STAMP();
    for (;;) {
        const bool has_next = S.next(ui + 1, nxt);
        const char* nA = has_next ? (const char*)g.A + (size_t)nxt.pm * tstep : cA; const char* nB = has_next ? (const char*)g.Bt + (size_t)nxt.pn * tstep : cB;
        for (int t = 0; t < nt; t += 2) {
            const bool last = (t == nt - 2);
            const char* a1 = cA + (size_t)(t + 1) * kstep;
            const char* a2 = last ? nA : cA + (size_t)(t + 2) * kstep; const char* b2 = last ? nB : cB + (size_t)(t + 2) * kstep;
            const char* a3 = a2 + kstep; const char* b3 = b2 + kstep;
            if (last && has_next) S.a_ready(nxt);
            PG8_LDB(B0, 0, 0); PG8_SCHED; PG8_LDA(At, 0, 0); PG8_STAGE(PG8_SA(1, 1), a1 + hstep, voffA);
            PG8_WAIT_L(8); PG8_BAR; PG8_WAIT_L(0); PG8_MMA(0, 0, At, B0); PG8_BAR; PG8_SCHED;
            PG8_LDB(B1, 0, 1); PG8_STAGE(PG8_SB(0, 0), b2, voffB);
            PG8_BAR; PG8_WAIT_L(0); PG8_MMA(0, 1, At, B1); PG8_BAR;
            PG8_LDA(At, 0, 1); PG8_STAGE(PG8_SA(0, 0), a2, voffA);
            PG8_BAR; PG8_WAIT_L(0); PG8_MMA(1, 0, At, B0); PG8_BAR; PG8_SCHED;
            PG8_STAGE(PG8_SB(0, 1), b2 + hstep, voffB);
            PG8_WAIT_V(6); PG8_BAR; PG8_MMA(1, 1, At, B1); PG8_BAR;
            PG8_LDB(B0, 1, 0); PG8_SCHED; PG8_LDA(At, 1, 0); PG8_STAGE(PG8_SA(0, 1), a2 + hstep, voffA);
            PG8_WAIT_L(8); PG8_BAR; PG8_WAIT_L(0); PG8_MMA(0, 0, At, B0); PG8_BAR; PG8_SCHED;
            PG8_LDB(B1, 1, 1); PG8_STAGE(PG8_SB(1, 0), b3, voffB);
            PG8_BAR; PG8_WAIT_L(0); PG8_MMA(0, 1, At, B1); PG8_BAR;
            PG8_LDA(At, 1, 1); PG8_STAGE(PG8_SA(1, 0), a3, voffA);
            PG8_BAR; PG8_WAIT_L(0); PG8_MMA(1, 0, At, B0); PG8_BAR; PG8_SCHED;
            PG8_STAGE(PG8_SB(1, 1), b3 + hstep, voffB);
            PG8_WAIT_V(6); PG8_BAR; PG8_MMA(1, 1, At, B1); PG8_BAR;
        }
        PG8_STAMP();
        if constexpr (!Epi::AFTER_DRAIN) { E(acc, cur, wr, wc, fr, fq); S.done(cur); }
        PG8_STAMP();
        if (!has_next) break;
#pragma unroll
        for (int a = 0; a < 2; ++a)
#pragma unroll
            for (int b = 0; b < 2; ++b)
#pragma unroll
                for (int m = 0; m < 4; ++m)
#pragma unroll
                    for (int n = 0; n < 2; ++n) acc[a][b][m][n] = (f32x4){0.f, 0.f, 0.f, 0.f};
        cur = nxt; cA = nA; cB = nB; ++ui;
    }
    PG8_WAIT_V(0);
    if (wr == 0) PG8_BAR;
    PG8_BAR;

    if constexpr (Epi::AFTER_DRAIN) { E.fused(acc, cur, wr, wc, fr, fq, lds, wid, lane); }
    PG8_STAMP();
    if (STAMP && wid == 0) { stamps[lane] = lane < nts ? (((unsigned long long)(unsigned)ts_hi << 32) | (unsigned)ts_lo) : 0ull;
        if (lane == 62) stamps[62] = rt_entry; if (lane == 63) stamps[63] = (unsigned long long)wall_clock64(); }
#undef PG8_STAMP
#undef PG8_SA
#undef PG8_SB
#undef PG8_STAGE
#undef PG8_LDA
#undef PG8_LDB
#undef PG8_MMA
#undef PG8_WAIT_V
#undef PG8_WAIT_L
#undef PG8_BAR
#undef PG8_SCHED
}
}

using namespace pg8;
#define DI __device__ __forceinline__
#define LAS PG8_LAS
typedef unsigned short u16;
typedef unsigned u32x2 __attribute__((ext_vector_type(2)));
typedef short s16x4 __attribute__((ext_vector_type(4)));

constexpr int T = 16384, SEQ = 2048;
constexpr int LDS_BYTES = 147456;
constexpr size_t U = (size_t)T * 1024 * 2;
constexpr size_t WS_WT = 7 * U;
constexpr size_t WS_MEMN = WS_WT + (size_t)14336 * 2048;
constexpr size_t WS_SS = WS_MEMN + 4194304;
constexpr size_t WS_SSP = WS_SS + (size_t)7 * T * 4;
constexpr size_t WS_CNT = WS_SSP + (size_t)T * 16 * 4;
constexpr size_t WS_IFG = WS_CNT + 4096;
constexpr size_t WS_GZ = WS_IFG + (size_t)T * 8 * 4;
constexpr size_t WS_GM = WS_GZ + 262144;
constexpr size_t WS_GE = WS_GM + 262144;
constexpr size_t WS_GMS = WS_GE + 262144;
constexpr size_t WS_GML = WS_GMS + 2048;
constexpr size_t WS_NVEC = WS_GML + 2048;
constexpr size_t WS_GW = WS_NVEC + 524288;
constexpr size_t WS_SUMA = WS_GW + 262144;
constexpr size_t WS_SUMH = WS_SUMA + 524288;
constexpr size_t WS_BAR = WS_SUMH + 524288;
constexpr size_t WS_HBQ = WS_BAR + 16384;
constexpr size_t WS_END = WS_HBQ + (size_t)64 * 6 * 2048 * 4;
enum { S_GQK = 0, S_STATE, S_OUT, S_GXR, S_RG0, S_RG1, S_GAB, S_GMIX, S_GQKV, S_GWO, S_GUP, S_GDOWN, PL };
constexpr int NPH = 2 * PL + 2;
#ifndef PROBE_DUP
#define PROBE_DUP 0
#endif

struct Args { const float* in[29]; float* out; unsigned char* ws; int ph_lo, ph_hi; };

DI float bf2f(u16 v) { return __uint_as_float(((unsigned)v) << 16); }
DI float bflo(unsigned v) { return __uint_as_float(v << 16); }
DI float bfhi(unsigned v) { return __uint_as_float(v & 0xffff0000u); }
DI u16 f2bf(float f) { unsigned r; asm("v_cvt_pk_bf16_f32 %0, %1, %1" : "=v"(r) : "v"(f)); return (u16)r; }
DI unsigned pk2(float lo, float hi) { unsigned r; asm("v_cvt_pk_bf16_f32 %0, %1, %2" : "=v"(r) : "v"(lo), "v"(hi)); return r; }
DI float sigm(float x) { return __builtin_amdgcn_rcpf(1.f + __expf(-x)); }
DI float gelu_t(float x) { const float u = 1.5957691216f * (x + 0.044715f * x * x * x); return x * __builtin_amdgcn_rcpf(1.f + __expf(-u)); }
DI float wsum(float v) { v += __shfl_xor(v, 1); v += __shfl_xor(v, 2); v += __shfl_xor(v, 4); v += __shfl_xor(v, 8); v += __shfl_xor(v, 16); v += __shfl_xor(v, 32); return v; }
DI void unpack8(const u32x4 r, float* f) { f[0] = bflo(r.x); f[1] = bfhi(r.x); f[2] = bflo(r.y); f[3] = bfhi(r.y); f[4] = bflo(r.z); f[5] = bfhi(r.z); f[6] = bflo(r.w); f[7] = bfhi(r.w); }
DI f32x4 mfma16(bf16x8 a, bf16x8 b, f32x4 c) { return __builtin_amdgcn_mfma_f32_16x16x32_bf16(a, b, c, 0, 0, 0); }

struct UE {
    static constexpr bool AFTER_DRAIN = false;
    int perm, kind; u16* O; int ldc, split; const u16* gate; float* F; const float* Fin; const float* ss; int smode; u16* HBo; float* sso; float* ssp; unsigned* cnt; int rflags;
    DI void operator()(const f32x4 (&acc)[2][2][4][2], const Unit& u, int wr, int wc, int fr, int fq) const {
        const int row0 = u.pm * 256 + wr * 64 + fr;
        if (kind == 4) return;
        const int col0 = u.pn * 256 + wc * 32 + 8 * fq;
        if (kind == 0) {
            float rs[2][4]; f32x4 cf[2][2];
#pragma unroll
            for (int ai = 0; ai < 2; ++ai)
#pragma unroll
                for (int m = 0; m < 4; ++m) rs[ai][m] = (smode == 1) ? ss[row0 + ai * 128 + m * 16] : 1024.f - 1e-6f * 1024.f;
#pragma unroll
            for (int bj = 0; bj < 2; ++bj)
#pragma unroll
                for (int n = 0; n < 2; ++n) cf[bj][n] = (smode == 2) ? *(const f32x4*)(ss + col0 + bj * 128 + n * 4) : (f32x4){1024.f - 1e-6f * 1024.f, 1024.f - 1e-6f * 1024.f, 1024.f - 1e-6f * 1024.f, 1024.f - 1e-6f * 1024.f};
#pragma unroll
            for (int ai = 0; ai < 2; ++ai)
#pragma unroll
                for (int m = 0; m < 4; ++m) rs[ai][m] = rsqrtf(rs[ai][m] * (1.f / 1024.f) + 1e-6f);
#pragma unroll
            for (int bj = 0; bj < 2; ++bj)
#pragma unroll
                for (int n = 0; n < 2; ++n)
#pragma unroll
                    for (int j = 0; j < 4; ++j) cf[bj][n][j] = rsqrtf(cf[bj][n][j] * (1.f / 1024.f) + 1e-6f);
            __builtin_amdgcn_sched_barrier(0);
#pragma unroll
            for (int ai = 0; ai < 2; ++ai)
#pragma unroll
                for (int m = 0; m < 4; ++m) { const int row = row0 + ai * 128 + m * 16;
#pragma unroll
                    for (int bj = 0; bj < 2; ++bj) { const int col = col0 + bj * 128;
                        u16* p = split ? O + (size_t)(col >> 10) * ((size_t)T * 1024) + (size_t)row * 1024 + (col & 1023) : O + (size_t)row * ldc + col;
                        const f32x4 v0 = acc[ai][bj][m][0] * rs[ai][m] * cf[bj][0], v1 = acc[ai][bj][m][1] * rs[ai][m] * cf[bj][1];
                        u32x4 w; w.x = cvt_pk_bf16(v0[0], v0[1]); w.y = cvt_pk_bf16(v0[2], v0[3]); w.z = cvt_pk_bf16(v1[0], v1[1]); w.w = cvt_pk_bf16(v1[2], v1[3]);
                        *(u32x4*)p = w; } }
        } else {
#pragma unroll
            for (int aim = 0; aim < 4; ++aim) { const int ai = aim >> 1, mb = (aim & 1) * 2;
                f32x4 ld[4][2][2];
#pragma unroll
                for (int m = mb; m < mb + 2; ++m)
#pragma unroll
                    for (int bj = 0; bj < 2; ++bj) { const size_t idx = (size_t)(row0 + ai * 128 + m * 16) * 1024 + col0 + bj * 128;
                        if (kind == 3) { if (rflags & 1) { ld[m][bj][0] = *(const f32x4*)((const u16*)Fin + idx); ld[m][bj][1] = (f32x4){0.f, 0.f, 0.f, 0.f}; } else { ld[m][bj][0] = *(const f32x4*)(Fin + idx); ld[m][bj][1] = *(const f32x4*)(Fin + idx + 4); } }
                        else { ld[m][bj][0] = *(const f32x4*)(gate + idx); ld[m][bj][1] = (kind == 2) ? *(const f32x4*)((const u16*)Fin + idx) : (f32x4){0.f, 0.f, 0.f, 0.f}; } }
                __builtin_amdgcn_sched_barrier(0);
#pragma unroll
                for (int m = mb; m < mb + 2; ++m) { const int row = row0 + ai * 128 + m * 16; float psq = 0.f;
#pragma unroll
                    for (int bj = 0; bj < 2; ++bj) { const size_t idx = (size_t)row * 1024 + col0 + bj * 128; const f32x4 v0 = acc[ai][bj][m][0], v1 = acc[ai][bj][m][1];
                        if (kind == 3) { f32x4 b0 = ld[m][bj][0], b1 = ld[m][bj][1];
                            if (rflags & 1) { const u32x4 rb = __builtin_bit_cast(u32x4, ld[m][bj][0]); b0 = (f32x4){bflo(rb.x), bfhi(rb.x), bflo(rb.y), bfhi(rb.y)}; b1 = (f32x4){bflo(rb.z), bfhi(rb.z), bflo(rb.w), bfhi(rb.w)}; }
                            const f32x4 h0 = b0 + v0, h1 = b1 + v1; if (rflags & 2) { *(f32x4*)(F + idx) = h0; *(f32x4*)(F + idx + 4) = h1; }
                            u32x4 hw; hw.x = cvt_pk_bf16(h0[0], h0[1]); hw.y = cvt_pk_bf16(h0[2], h0[3]); hw.z = cvt_pk_bf16(h1[0], h1[1]); hw.w = cvt_pk_bf16(h1[2], h1[3]); *(u32x4*)(HBo + idx) = hw;
                            psq += (h0[0] * h0[0] + h0[1] * h0[1]) + (h0[2] * h0[2] + h0[3] * h0[3]) + (h1[0] * h1[0] + h1[1] * h1[1]) + (h1[2] * h1[2] + h1[3] * h1[3]); }
                        else { const u32x4 gr = __builtin_bit_cast(u32x4, ld[m][bj][0]);
                            f32x4 s0, s1; s0[0] = sigm(bflo(gr.x)); s0[1] = sigm(bfhi(gr.x)); s0[2] = sigm(bflo(gr.y)); s0[3] = sigm(bfhi(gr.y)); s1[0] = sigm(bflo(gr.z)); s1[1] = sigm(bfhi(gr.z)); s1[2] = sigm(bflo(gr.w)); s1[3] = sigm(bfhi(gr.w));
                            f32x4 r0 = s0 * v0, r1 = s1 * v1;
                            if (kind == 2) { const u32x4 yb = __builtin_bit_cast(u32x4, ld[m][bj][1]);
                                r0[0] += bflo(yb.x); r0[1] += bfhi(yb.x); r0[2] += bflo(yb.y); r0[3] += bfhi(yb.y); r1[0] += bflo(yb.z); r1[1] += bfhi(yb.z); r1[2] += bflo(yb.w); r1[3] += bfhi(yb.w); }
                            u32x4 w; w.x = cvt_pk_bf16(r0[0], r0[1]); w.y = cvt_pk_bf16(r0[2], r0[3]); w.z = cvt_pk_bf16(r1[0], r1[1]); w.w = cvt_pk_bf16(r1[2], r1[3]);
                            *(u32x4*)(O + idx) = w; } }
                    if (kind == 3) { psq += __shfl_xor(psq, 16); psq += __shfl_xor(psq, 32); if (fq == 0) __hip_atomic_store(ssp + (size_t)row * 16 + u.pn * 4 + wc, psq, __ATOMIC_RELAXED, __HIP_MEMORY_SCOPE_AGENT); } }
                __builtin_amdgcn_sched_barrier(0);
            }
            if (kind == 3) {
                asm volatile("s_waitcnt vmcnt(0)" ::: "memory");
                const int lane = fq * 16 + fr; unsigned old = 0u;
                if (lane == 0) old = __hip_atomic_fetch_add(cnt + u.pm, 1u, __ATOMIC_RELAXED, __HIP_MEMORY_SCOPE_AGENT);
                old = (unsigned)__builtin_amdgcn_readfirstlane((int)old);
                if (old == 31u) {
                    for (int r = lane; r < 256; r += 64) { const size_t row = (size_t)u.pm * 256 + r; float t = 0.f;
#pragma unroll 4
                        for (int k = 0; k < 16; ++k) t += __hip_atomic_load(ssp + row * 16 + k, __ATOMIC_RELAXED, __HIP_MEMORY_SCOPE_AGENT);
                        sso[row] = t; } }
            }
        }
    }
};
struct UE3 {
    static constexpr bool AFTER_DRAIN = true;
    int perm; const float* Fin; float* F; u16* HBo; u16* HB2; float* sso; float* ssp; unsigned* cnt; int rflags;
    DI void operator()(const f32x4 (&)[2][2][4][2], const Unit&, int, int, int, int) const {}
    DI void fused(const f32x4 (&acc)[2][2][4][2], const Unit& u, int wr, int wc, int fr, int fq, LAS unsigned char* lds, int wid, int lane) const {
        LAS float* P = (LAS float*)lds;
        LAS unsigned* flag = (LAS unsigned*)(lds + 8192);
        const int tid = wid * 64 + lane, row0 = u.pm * 256 + wr * 64 + fr, col0 = u.pn * 256 + wc * 32 + 8 * fq;
#pragma unroll
        for (int aim = 0; aim < 4; ++aim) { const int ai = aim >> 1, mb = (aim & 1) * 2;
            f32x4 ld[4][2][2];
#pragma unroll
            for (int m = mb; m < mb + 2; ++m)
#pragma unroll
                for (int bj = 0; bj < 2; ++bj) { const size_t idx = (size_t)(row0 + ai * 128 + m * 16) * 1024 + col0 + bj * 128;
                    if (rflags & 1) { ld[m][bj][0] = *(const f32x4*)((const u16*)Fin + idx); ld[m][bj][1] = (f32x4){0.f, 0.f, 0.f, 0.f}; } else { ld[m][bj][0] = *(const f32x4*)(Fin + idx); ld[m][bj][1] = *(const f32x4*)(Fin + idx + 4); } }
            __builtin_amdgcn_sched_barrier(0);
#pragma unroll
            for (int m = mb; m < mb + 2; ++m) { const int row = row0 + ai * 128 + m * 16; float psq = 0.f;
#pragma unroll
                for (int bj = 0; bj < 2; ++bj) { const size_t idx = (size_t)row * 1024 + col0 + bj * 128; const f32x4 v0 = acc[ai][bj][m][0], v1 = acc[ai][bj][m][1];
                    f32x4 b0 = ld[m][bj][0], b1 = ld[m][bj][1];
                    if (rflags & 1) { const u32x4 rb = __builtin_bit_cast(u32x4, ld[m][bj][0]); b0 = (f32x4){bflo(rb.x), bfhi(rb.x), bflo(rb.y), bfhi(rb.y)}; b1 = (f32x4){bflo(rb.z), bfhi(rb.z), bflo(rb.w), bfhi(rb.w)}; }
                    const f32x4 h0 = b0 + v0, h1 = b1 + v1; if (rflags & 2) { *(f32x4*)(F + idx) = h0; *(f32x4*)(F + idx + 4) = h1; }
                    u32x4 hw; hw.x = cvt_pk_bf16(h0[0], h0[1]); hw.y = cvt_pk_bf16(h0[2], h0[3]); hw.z = cvt_pk_bf16(h1[0], h1[1]); hw.w = cvt_pk_bf16(h1[2], h1[3]); *(u32x4*)(HBo + idx) = hw; if (HB2) *(u32x4*)(HB2 + idx) = hw;
                    psq += (h0[0] * h0[0] + h0[1] * h0[1]) + (h0[2] * h0[2] + h0[3] * h0[3]) + (h1[0] * h1[0] + h1[1] * h1[1]) + (h1[2] * h1[2] + h1[3] * h1[3]); }
                psq += __shfl_xor(psq, 16); psq += __shfl_xor(psq, 32);
                if (fq == 0) P[(ai * 128 + wr * 64 + m * 16 + fr) * 4 + wc] = psq; }
            __builtin_amdgcn_sched_barrier(0);
        }
        __syncthreads();
        if (tid < 256) { const float t = (P[tid * 4] + P[tid * 4 + 1]) + (P[tid * 4 + 2] + P[tid * 4 + 3]); __hip_atomic_store(ssp + ((size_t)u.pm * 256 + tid) * 4 + u.pn, t, __ATOMIC_RELAXED, __HIP_MEMORY_SCOPE_AGENT); }
        asm volatile("s_waitcnt vmcnt(0)" ::: "memory");
        __syncthreads();
        if (tid == 0) flag[0] = __hip_atomic_fetch_add(cnt + u.pm, 1u, __ATOMIC_RELAXED, __HIP_MEMORY_SCOPE_AGENT);
        __syncthreads();
        if (flag[0] == 3u && tid < 256) { const size_t row = (size_t)u.pm * 256 + tid;
            const float t0 = __hip_atomic_load(ssp + row * 4, __ATOMIC_RELAXED, __HIP_MEMORY_SCOPE_AGENT), t1 = __hip_atomic_load(ssp + row * 4 + 1, __ATOMIC_RELAXED, __HIP_MEMORY_SCOPE_AGENT),
                        t2 = __hip_atomic_load(ssp + row * 4 + 2, __ATOMIC_RELAXED, __HIP_MEMORY_SCOPE_AGENT), t3 = __hip_atomic_load(ssp + row * 4 + 3, __ATOMIC_RELAXED, __HIP_MEMORY_SCOPE_AGENT);
            sso[row] = (t0 + t1) + (t2 + t3); }
        __syncthreads();
    }
};
struct OneUnit { Unit u; DI bool next(int i, Unit& o) const { if (i != 0) return false; o = u; return true; } DI void a_ready(const Unit&) const {} DI void done(const Unit&) const {} };
struct UE5 {
    static constexpr bool AFTER_DRAIN = true;
    int perm; u16* act; float* HB; const float* cw; const float* cb; const float* ss;
    DI void operator()(const f32x4 (&)[2][2][4][2], const Unit&, int, int, int, int) const {}
    DI void fused(const f32x4 (&acc)[2][2][4][2], const Unit& u, int wr, int wc, int fr, int fq, LAS unsigned char* lds, int wid, int lane) const {
        LAS float* tl = (LAS float*)lds;
        LAS float* side = (LAS float*)(lds + 133120);
        const int tid = wid * 64 + lane, q = tid & 31, rsub = tid >> 5, ch = u.pn * 128 + q * 4;
        const f32x4 g0 = *(const f32x4*)(cw + ch), g1 = *(const f32x4*)(cw + 6144 + ch), g2 = *(const f32x4*)(cw + 12288 + ch), gb = *(const f32x4*)(cb + ch);
        const f32x4 u0 = *(const f32x4*)(cw + 3072 + ch), u1 = *(const f32x4*)(cw + 6144 + 3072 + ch), u2 = *(const f32x4*)(cw + 12288 + 3072 + ch), ub = *(const f32x4*)(cb + 3072 + ch);
#pragma unroll
        for (int ai = 0; ai < 2; ++ai) {
            if (ai == 1) {
                __syncthreads();
            }
#pragma unroll
            for (int m = 0; m < 4; ++m) { const float rs = rsqrtf(ss[u.pm * 256 + ai * 128 + wr * 64 + m * 16 + fr] * (1.f / 1024.f) + 1e-6f);
#pragma unroll
                for (int bj = 0; bj < 2; ++bj)
#pragma unroll
                    for (int n = 0; n < 2; ++n) *(LAS f32x4*)(tl + (wr * 64 + m * 16 + fr) * 260 + bj * 128 + wc * 32 + n * 16 + 4 * fq) = acc[ai][bj][m][n] * rs; }
            __syncthreads();
            if (ai == 0) {
                if (tid < 128) { const int rr = tid >> 6, cq = tid & 63; const f32x4 v = *(const LAS f32x4*)(tl + rr * 260 + cq * 4);
                    *(f32x4*)(HB + ((size_t)u.pm * 4 + rr) * 6144 + (cq < 32 ? u.pn * 128 + cq * 4 : 3072 + u.pn * 128 + (cq - 32) * 4)) = v; }
            } else {
                if (tid < 128) { const int rr = tid >> 6, cq = tid & 63; const f32x4 v = *(const LAS f32x4*)(tl + (126 + rr) * 260 + cq * 4);
                    *(f32x4*)(HB + ((size_t)u.pm * 4 + 2 + rr) * 6144 + (cq < 32 ? u.pn * 128 + cq * 4 : 3072 + u.pn * 128 + (cq - 32) * 4)) = v; }
            }
#pragma unroll 2
            for (int it = 0; it < 8; ++it) {
                const int row = it * 16 + rsub;
                const f32x4 xg = *(const LAS f32x4*)(tl + row * 260 + q * 4), xu = *(const LAS f32x4*)(tl + row * 260 + 128 + q * 4);
                f32x4 p1g, p1u, p2g, p2u; bool ok = true;
                if (row >= 2) { p1g = *(const LAS f32x4*)(tl + (row - 1) * 260 + q * 4); p1u = *(const LAS f32x4*)(tl + (row - 1) * 260 + 128 + q * 4); p2g = *(const LAS f32x4*)(tl + (row - 2) * 260 + q * 4); p2u = *(const LAS f32x4*)(tl + (row - 2) * 260 + 128 + q * 4); }
                else if (ai == 1) {
                    if (row == 1) { p1g = *(const LAS f32x4*)(tl + q * 4); p1u = *(const LAS f32x4*)(tl + 128 + q * 4); p2g = *(const LAS f32x4*)(side + 260 + q * 4); p2u = *(const LAS f32x4*)(side + 260 + 128 + q * 4); }
                    else { p1g = *(const LAS f32x4*)(side + 260 + q * 4); p1u = *(const LAS f32x4*)(side + 260 + 128 + q * 4); p2g = *(const LAS f32x4*)(side + q * 4); p2u = *(const LAS f32x4*)(side + 128 + q * 4); }
                } else { ok = false; p1g = xg; p1u = xu; p2g = xg; p2u = xu; }
                const f32x4 gv = gb + g0 * p2g + g1 * p1g + g2 * xg, uv = ub + u0 * p2u + u1 * p1u + u2 * xu;
                if (ok) { u32x2 w; w.x = cvt_pk_bf16(gelu_t(gv[0]) * uv[0], gelu_t(gv[1]) * uv[1]); w.y = cvt_pk_bf16(gelu_t(gv[2]) * uv[2], gelu_t(gv[3]) * uv[3]);
                    *(u32x2*)(act + ((size_t)u.pm * 256 + ai * 128 + row) * 3072 + ch) = w; }
            }
            if (ai == 0) {
                if (tid < 128) { const int rr = tid >> 6, cq = tid & 63; *(LAS f32x4*)(side + rr * 260 + cq * 4) = *(const LAS f32x4*)(tl + (126 + rr) * 260 + cq * 4); }
            }
        }
        __syncthreads();
    }
};
DI void ffn_fix_tile(int mk_tid, const float* HB, const float* cw, const float* cb, u16* act, int pm) {
    for (int item = mk_tid; item < 2 * 768; item += 512) {
        const int cq = item % 768, j = item / 768, ch = cq * 4; const bool hp = (pm & 7) != 0;
        const f32x4 z4 = (f32x4){0.f, 0.f, 0.f, 0.f};
        const float* cur = HB + ((size_t)pm * 4 + j) * 6144 + ch; const float* f0 = HB + ((size_t)pm * 4) * 6144 + ch;
        const float* l0 = HB + ((size_t)(pm - 1) * 4 + 2) * 6144 + ch; const float* l1 = HB + ((size_t)(pm - 1) * 4 + 3) * 6144 + ch;
        const f32x4 xg = *(const f32x4*)cur, xu = *(const f32x4*)(cur + 3072);
        f32x4 p1g, p1u, p2g, p2u;
        if (j == 1) { p1g = *(const f32x4*)f0; p1u = *(const f32x4*)(f0 + 3072); p2g = hp ? *(const f32x4*)l1 : z4; p2u = hp ? *(const f32x4*)(l1 + 3072) : z4; }
        else { p1g = hp ? *(const f32x4*)l1 : z4; p1u = hp ? *(const f32x4*)(l1 + 3072) : z4; p2g = hp ? *(const f32x4*)l0 : z4; p2u = hp ? *(const f32x4*)(l0 + 3072) : z4; }
        const f32x4 wg0 = *(const f32x4*)(cw + ch), wg1 = *(const f32x4*)(cw + 6144 + ch), wg2 = *(const f32x4*)(cw + 12288 + ch), bg = *(const f32x4*)(cb + ch);
        const f32x4 wu0 = *(const f32x4*)(cw + 3072 + ch), wu1 = *(const f32x4*)(cw + 6144 + 3072 + ch), wu2 = *(const f32x4*)(cw + 12288 + 3072 + ch), bu = *(const f32x4*)(cb + 3072 + ch);
        const f32x4 gv = bg + wg0 * p2g + wg1 * p1g + wg2 * xg, uv = bu + wu0 * p2u + wu1 * p1u + wu2 * xu;
        u32x2 w; w.x = pk2(gelu_t(gv[0]) * uv[0], gelu_t(gv[1]) * uv[1]); w.y = pk2(gelu_t(gv[2]) * uv[2], gelu_t(gv[3]) * uv[3]);
        *(u32x2*)(act + ((size_t)pm * 256 + j) * 3072 + ch) = w;
    }
}

struct UE6 {
    static constexpr bool AFTER_DRAIN = true;
    int perm; u16* qc; u16* kc; float* HB; const float* cw; const float* cb; const float* ss;
    DI void operator()(const f32x4 (&)[2][2][4][2], const Unit&, int, int, int, int) const {}
    DI void fused(const f32x4 (&acc)[2][2][4][2], const Unit& u, int wr, int wc, int fr, int fq, LAS unsigned char* lds, int wid, int lane) const {
        LAS float* tl = (LAS float*)lds;
        LAS float* side = (LAS float*)(lds + 133120);
        const int tid = wid * 64 + lane, q = tid & 63, rsub = tid >> 6, ch = u.pn * 256 + q * 4;
        const f32x4 w0 = *(const f32x4*)(cw + ch), w1 = *(const f32x4*)(cw + 2048 + ch), w2 = *(const f32x4*)(cw + 4096 + ch), w3 = *(const f32x4*)(cw + 6144 + ch), bb = *(const f32x4*)(cb + ch);
        u16* dst = (ch < 1024) ? qc + ch : kc + (ch - 1024); const float sc = (ch < 1024) ? 1.f : 0.0625f;
#pragma unroll
        for (int ai = 0; ai < 2; ++ai) {
            if (ai == 1) __syncthreads();
#pragma unroll
            for (int m = 0; m < 4; ++m) { const float rs = rsqrtf(ss[u.pm * 256 + ai * 128 + wr * 64 + m * 16 + fr] * (1.f / 1024.f) + 1e-6f);
#pragma unroll
                for (int bj = 0; bj < 2; ++bj)
#pragma unroll
                    for (int n = 0; n < 2; ++n) *(LAS f32x4*)(tl + (wr * 64 + m * 16 + fr) * 260 + bj * 128 + wc * 32 + n * 16 + 4 * fq) = acc[ai][bj][m][n] * rs; }
            __syncthreads();
            if (tid < 192) { const int rr = tid >> 6, cq = tid & 63; const f32x4 v = *(const LAS f32x4*)(tl + ((ai == 0 ? 0 : 125) + rr) * 260 + cq * 4);
                *(f32x4*)(HB + ((size_t)u.pm * 6 + (ai == 0 ? 0 : 3) + rr) * 2048 + u.pn * 256 + cq * 4) = v; }
#pragma unroll 2
            for (int it = 0; it < 16; ++it) {
                const int row = it * 8 + rsub;
                const f32x4 x = *(const LAS f32x4*)(tl + row * 260 + q * 4);
                f32x4 p1, p2, p3; bool ok = true;
                if (row >= 3) { p1 = *(const LAS f32x4*)(tl + (row - 1) * 260 + q * 4); p2 = *(const LAS f32x4*)(tl + (row - 2) * 260 + q * 4); p3 = *(const LAS f32x4*)(tl + (row - 3) * 260 + q * 4); }
                else if (ai == 1) {
                    p1 = (row >= 1) ? *(const LAS f32x4*)(tl + (row - 1) * 260 + q * 4) : *(const LAS f32x4*)(side + 2 * 260 + q * 4);
                    p2 = (row >= 2) ? *(const LAS f32x4*)(tl + (row - 2) * 260 + q * 4) : *(const LAS f32x4*)(side + (1 + row) * 260 + q * 4);
                    p3 = *(const LAS f32x4*)(side + row * 260 + q * 4);
                } else { ok = false; p1 = x; p2 = x; p3 = x; }
                const f32x4 v = bb + w0 * p3 + w1 * p2 + w2 * p1 + w3 * x;
                if (ok) { u32x2 w; w.x = cvt_pk_bf16(sc * v[0] * sigm(v[0]), sc * v[1] * sigm(v[1])); w.y = cvt_pk_bf16(sc * v[2] * sigm(v[2]), sc * v[3] * sigm(v[3]));
                    *(u32x2*)(dst + ((size_t)u.pm * 256 + ai * 128 + row) * 1024) = w; }
            }
            if (ai == 0) { if (tid < 192) { const int rr = tid >> 6, cq = tid & 63; *(LAS f32x4*)(side + rr * 260 + cq * 4) = *(const LAS f32x4*)(tl + (125 + rr) * 260 + cq * 4); } }
        }
        __syncthreads();
    }
};
DI void qk_fix_local(int mk_tid, const float* HB, const float* cw, const float* cb, u16* dst, int chg, int pm0, int npm) {
    for (int item = mk_tid; item < npm * 3 * 64; item += 512) {
        const int cq = item & 63, rr = item >> 6, pmi = rr / 3, j = rr - pmi * 3, pm = pm0 + pmi, ch = chg + cq * 4; const bool hp = (pm & 7) != 0;
        const f32x4 z4 = (f32x4){0.f, 0.f, 0.f, 0.f};
        const float* me = HB + (size_t)pm * 6 * 2048 + ch; const float* pv = HB + (size_t)(pm - 1) * 6 * 2048 + ch;
        const f32x4 x = *(const f32x4*)(me + j * 2048);
        f32x4 p[3];
#pragma unroll
        for (int k = 1; k <= 3; ++k) { const int r = j - k; p[k - 1] = (r >= 0) ? *(const f32x4*)(me + r * 2048) : (hp ? *(const f32x4*)(pv + (6 + r) * 2048) : z4); }
        const f32x4 w0 = *(const f32x4*)(cw + ch), w1 = *(const f32x4*)(cw + 2048 + ch), w2 = *(const f32x4*)(cw + 4096 + ch), w3 = *(const f32x4*)(cw + 6144 + ch), bb = *(const f32x4*)(cb + ch);
        const f32x4 v = bb + w0 * p[2] + w1 * p[1] + w2 * p[0] + w3 * x;
        const float sc = (ch < 1024) ? 1.f : 0.0625f;
        u32x2 w; w.x = pk2(sc * v[0] * sigm(v[0]), sc * v[1] * sigm(v[1])); w.y = pk2(sc * v[2] * sigm(v[2]), sc * v[3] * sigm(v[3]));
        *(u32x2*)(dst + ((size_t)pm * 256 + j) * 1024 + (ch & 1023)) = w;
    }
}
DI void qk_fix_phase(int mk_tid, const float* HB, const float* cw, const float* cb, u16* qc, u16* kc) {
    const int gtid = blockIdx.x * 512 + mk_tid, nth = gridDim.x * 512;
    for (int item = gtid; item < 192 * 512; item += nth) {
        const int cq = item & 511, rr = item >> 9, pm = rr / 3, j = rr - pm * 3, ch = cq * 4; const bool hp = (pm & 7) != 0;
        const f32x4 z4 = (f32x4){0.f, 0.f, 0.f, 0.f};
        const float* me = HB + (size_t)pm * 6 * 2048 + ch; const float* pv = HB + (size_t)(pm - 1) * 6 * 2048 + ch;
        const f32x4 x = *(const f32x4*)(me + j * 2048);
        f32x4 p[3];
#pragma unroll
        for (int k = 1; k <= 3; ++k) { const int r = j - k; p[k - 1] = (r >= 0) ? *(const f32x4*)(me + r * 2048) : (hp ? *(const f32x4*)(pv + (6 + r) * 2048) : z4); }
        const f32x4 w0 = *(const f32x4*)(cw + ch), w1 = *(const f32x4*)(cw + 2048 + ch), w2 = *(const f32x4*)(cw + 4096 + ch), w3 = *(const f32x4*)(cw + 6144 + ch), bb = *(const f32x4*)(cb + ch);
        const f32x4 v = bb + w0 * p[2] + w1 * p[1] + w2 * p[0] + w3 * x;
        u16* dst = (ch < 1024) ? qc + ch : kc + (ch - 1024); const float sc = (ch < 1024) ? 1.f : 0.0625f;
        u32x2 w; w.x = pk2(sc * v[0] * sigm(v[0]), sc * v[1] * sigm(v[1])); w.y = pk2(sc * v[2] * sigm(v[2]), sc * v[3] * sigm(v[3]));
        *(u32x2*)(dst + ((size_t)pm * 256 + j) * 1024) = w;
    }
}

struct GD { const u16* A; const u16* Bt; int M, N, K, cshift; UE e; };

DI void cvt_w(int mk_tid, LAS unsigned char* lds, const float* W, int ldw, int col0, int ncols, int K, u16* dst, int& tb, int il, const float* gain, int vb, int VG) {
    LAS float* tile = (LAS float*)lds;
    const int tid = mk_tid, G = VG; const int ntn = ncols >> 8, nt = ntn * (K >> 6);
    int i0 = (vb - tb) % G; if (i0 < 0) i0 += G; if (vb < 0) i0 = nt;
    for (int i = i0; i < nt; i += G) {
        const int tn = i % ntn, tk = i / ntn;
        __syncthreads();
        const float* src = W + (size_t)(tk * 64) * ldw + col0 + (il ? tn * 128 : tn * 256);
#pragma unroll 16
        for (int e = tid; e < 16384; e += 512) { const int r = e >> 8, c = e & 255; const int cs = (il && c >= 128) ? c + 3072 - 128 : c; tile[r * 257 + c] = src[(size_t)r * ldw + cs]; }
        __syncthreads();
        u16* dp = dst + (size_t)(tn * 256) * K + tk * 64; const float gk0 = gain ? gain[tk * 64 + (tid & 31) * 2] : 1.f, gk1 = gain ? gain[tk * 64 + (tid & 31) * 2 + 1] : 1.f;
#pragma unroll 4
        for (int e = tid; e < 8192; e += 512) { const int n = e >> 5, k2 = (e & 31) * 2; *(unsigned*)(dp + (size_t)n * K + k2) = pk2(tile[k2 * 257 + n] * gk0, tile[(k2 + 1) * 257 + n] * gk1); }
    }
    tb = (tb + nt) % G;
}

DI void norm_rows(int mk_tid, const float* src, const float* g, u16* dst, int nrows, const LAS float* sW, const float* ifb, float* ifg) {
    const int lane = mk_tid & 63, gw = blockIdx.x * 8 + (mk_tid >> 6), nw = gridDim.x * 8;
    for (int row0 = gw; row0 < nrows; row0 += 4 * nw) {
        float4 v[4][4];
#pragma unroll
        for (int r = 0; r < 4; ++r) { const int row = row0 + r * nw; if (row < nrows) {
#pragma unroll
            for (int i = 0; i < 4; ++i) v[r][i] = *(const float4*)(src + (size_t)row * 1024 + i * 256 + lane * 4); } }
        float4 gv[4];
#pragma unroll
        for (int i = 0; i < 4; ++i) gv[i] = *(const float4*)(g + i * 256 + lane * 4);
#pragma unroll
        for (int r = 0; r < 4; ++r) { const int row = row0 + r * nw; if (row < nrows) {
            float ss = 0.f;
#pragma unroll
            for (int i = 0; i < 4; ++i) ss += v[r][i].x * v[r][i].x + v[r][i].y * v[r][i].y + v[r][i].z * v[r][i].z + v[r][i].w * v[r][i].w;
            ss = wsum(ss); const float rinv = rsqrtf(ss * (1.f / 1024.f) + 1e-6f);
#pragma unroll
            for (int i = 0; i < 4; ++i) { v[r][i].x *= rinv * gv[i].x; v[r][i].y *= rinv * gv[i].y; v[r][i].z *= rinv * gv[i].z; v[r][i].w *= rinv * gv[i].w;
                u32x2 w; w.x = pk2(v[r][i].x, v[r][i].y); w.y = pk2(v[r][i].z, v[r][i].w); *(u32x2*)(dst + (size_t)row * 1024 + i * 256 + lane * 4) = w; }
            if (sW) {
                float a0 = 0, a1 = 0, a2 = 0, a3 = 0, a4 = 0, a5 = 0, a6 = 0, a7 = 0;
#pragma unroll
                for (int i = 0; i < 4; ++i) { const float y[4] = {v[r][i].x, v[r][i].y, v[r][i].z, v[r][i].w};
#pragma unroll
                    for (int e = 0; e < 4; ++e) { const int k = i * 256 + lane * 4 + e; const LAS f32x4* wp = (const LAS f32x4*)(sW + k * 8); const f32x4 w0 = wp[0], w1 = wp[1];
                        a0 += y[e] * w0.x; a1 += y[e] * w0.y; a2 += y[e] * w0.z; a3 += y[e] * w0.w; a4 += y[e] * w1.x; a5 += y[e] * w1.y; a6 += y[e] * w1.z; a7 += y[e] * w1.w; } __builtin_amdgcn_sched_barrier(0); }
                a0 = wsum(a0); a1 = wsum(a1); a2 = wsum(a2); a3 = wsum(a3); a4 = wsum(a4); a5 = wsum(a5); a6 = wsum(a6); a7 = wsum(a7);
                if (lane == 0) { float4 o0, o1; o0.x = a0 + ifb[0]; o0.y = a1 + ifb[1]; o0.z = a2 + ifb[2]; o0.w = a3 + ifb[3]; o1.x = a4 + ifb[4]; o1.y = a5 + ifb[5]; o1.z = a6 + ifb[6]; o1.w = a7 + ifb[7];
                    *(float4*)(ifg + (size_t)row * 8) = o0; *(float4*)(ifg + (size_t)row * 8 + 4) = o1; }
            } } __builtin_amdgcn_sched_barrier(0); }
    }
}
DI void final_norm(int mk_tid, const u16* hb, float* out, const float* g) {
    const int lane = mk_tid & 63, gw = blockIdx.x * 8 + (mk_tid >> 6), nw = gridDim.x * 8;
    float4 gv[4];
#pragma unroll
    for (int i = 0; i < 4; ++i) gv[i] = *(const float4*)(g + i * 256 + lane * 4);
    for (int row0 = gw; row0 < T; row0 += 4 * nw) {
        u32x2 v[4][4];
#pragma unroll
        for (int r = 0; r < 4; ++r)
#pragma unroll
            for (int i = 0; i < 4; ++i) v[r][i] = *(const u32x2*)(hb + (size_t)(row0 + r * nw) * 1024 + i * 256 + lane * 4);
        __builtin_amdgcn_sched_barrier(0);
#pragma unroll
        for (int r = 0; r < 4; ++r) { float* p = out + (size_t)(row0 + r * nw) * 1024; float ss = 0.f; float4 f[4];
#pragma unroll
            for (int i = 0; i < 4; ++i) { f[i].x = bflo(v[r][i].x); f[i].y = bfhi(v[r][i].x); f[i].z = bflo(v[r][i].y); f[i].w = bfhi(v[r][i].y); ss += f[i].x * f[i].x + f[i].y * f[i].y + f[i].z * f[i].z + f[i].w * f[i].w; }
            ss = wsum(ss); const float rinv = rsqrtf(ss * (1.f / 1024.f) + 1e-6f);
#pragma unroll
            for (int i = 0; i < 4; ++i) { float4 o; o.x = f[i].x * rinv * gv[i].x; o.y = f[i].y * rinv * gv[i].y; o.z = f[i].z * rinv * gv[i].z; o.w = f[i].w * rinv * gv[i].w; *(float4*)(p + i * 256 + lane * 4) = o; } }
    }
}

DI void conv_qk_phase(int mk_tid, const u16* qk, const float* cw, const float* cb, u16* qc, u16* kc) {
    const int gtid = blockIdx.x * 512 + mk_tid, nth = gridDim.x * 512;
    for (int item = gtid; item < 256 * 1024; item += nth) {
        const int co = item & 255, tb = item >> 8, c0 = co * 8, t0 = tb * 16;
        float w0[8], w1[8], w2[8], w3[8], bb[8];
#pragma unroll
        for (int e = 0; e < 8; ++e) { w0[e] = cw[c0 + e]; w1[e] = cw[2048 + c0 + e]; w2[e] = cw[4096 + c0 + e]; w3[e] = cw[6144 + c0 + e]; bb[e] = cb[c0 + e]; }
        float x0[8], x1[8], x2[8], x3[8];
        if ((t0 & (SEQ - 1)) == 0) {
#pragma unroll
            for (int e = 0; e < 8; ++e) { x0[e] = 0.f; x1[e] = 0.f; x2[e] = 0.f; }
        } else {
            unpack8(*(const u32x4*)(qk + (size_t)(t0 - 3) * 2048 + c0), x0); unpack8(*(const u32x4*)(qk + (size_t)(t0 - 2) * 2048 + c0), x1); unpack8(*(const u32x4*)(qk + (size_t)(t0 - 1) * 2048 + c0), x2);
        }
        u16* dstp = (c0 < 1024) ? qc + c0 : kc + (c0 - 1024); const float sc = (c0 < 1024) ? 1.f : 0.0625f;
        for (int tt = 0; tt < 16; ++tt) {
            unpack8(*(const u32x4*)(qk + (size_t)(t0 + tt) * 2048 + c0), x3);
            float o[8];
#pragma unroll
            for (int e = 0; e < 8; ++e) { const float v = bb[e] + w0[e] * x0[e] + w1[e] * x1[e] + w2[e] * x2[e] + w3[e] * x3[e]; o[e] = sc * v * sigm(v); x0[e] = x1[e]; x1[e] = x2[e]; x2[e] = x3[e]; }
            u32x4 r; r.x = pk2(o[0], o[1]); r.y = pk2(o[2], o[3]); r.z = pk2(o[4], o[5]); r.w = pk2(o[6], o[7]);
            *(u32x4*)(dstp + (size_t)(t0 + tt) * 1024) = r;
        }
    }
}

DI float logsig(float x) { return fminf(x, 0.f) - log1pf(__expf(-fabsf(x))); }
DI void gate_prepass(int mk_tid, LAS unsigned char* lds, int bh, const float* ifg, float* gz, float* gM, float* gE, float* gms, float* gMl, float* gW) {
    const int lane = mk_tid & 63, wid = mk_tid >> 6, b = bh >> 2, h = bh & 3;
    LAS float* G = (LAS float*)lds; LAS float* CM = G + 16;
    float z0[2], z1[2], b0[2], b1[2], excm[2], incm[2];
    __syncthreads();
#pragma unroll
    for (int cc = 0; cc < 2; ++cc) { const int c = wid * 2 + cc;
        const int s0 = c * 128 + 2 * lane; const size_t t = (size_t)b * SEQ + s0;
        const float i0 = ifg[t * 8 + h], f0 = ifg[t * 8 + 4 + h], i1 = ifg[t * 8 + 8 + h], f1 = ifg[t * 8 + 12 + h];
        const float lf0 = logsig(f0), lf1 = logsig(f1), s1 = lf0 + lf1;
        float inc = s1;
#pragma unroll
        for (int d = 1; d < 64; d <<= 1) { const float o = __shfl_up(inc, d); if (lane >= d) inc += o; }
        const float exc = inc - s1; b0[cc] = exc + lf0; b1[cc] = exc + s1; z0[cc] = i0 - b0[cc]; z1[cc] = i1 - b1[cc];
        float im = fmaxf(z0[cc], z1[cc]);
#pragma unroll
        for (int d = 1; d < 64; d <<= 1) { const float o = __shfl_up(im, d); if (lane >= d) im = fmaxf(im, o); }
        float em = __shfl_up(im, 1); if (lane == 0) em = -3.0e38f;
        incm[cc] = im; excm[cc] = em;
        if (lane == 63) { G[c] = inc; CM[c] = im; }
    }
    __syncthreads();
    float m = 0.f, mst[2] = {0.f, 0.f};
    for (int c = 0; c < wid * 2; ++c) m = G[c] + fmaxf(m, CM[c]);
    mst[0] = m; m = G[wid * 2] + fmaxf(m, CM[wid * 2]); mst[1] = m;
#pragma unroll
    for (int cc = 0; cc < 2; ++cc) { const int c = wid * 2 + cc; const float m_st = mst[cc];
        const float M0 = fmaxf(m_st, fmaxf(excm[cc], z0[cc])), M1 = fmaxf(m_st, incm[cc]), Ml = fmaxf(m_st, CM[c]);
        const size_t gi = (size_t)bh * SEQ + c * 128 + 2 * lane;
        *(float2*)(gz + gi) = make_float2(z0[cc], z1[cc]); *(float2*)(gM + gi) = make_float2(M0, M1); *(float2*)(gE + gi) = make_float2(__expf(-(b0[cc] + M0)), __expf(-(b1[cc] + M1)));
        *(float2*)(gW + gi) = make_float2(__expf(z0[cc] - Ml), __expf(z1[cc] - Ml));
        if (lane == 0) { gms[bh * 16 + c] = m_st; gMl[bh * 16 + c] = Ml; }
    }
    __syncthreads();
}

DI void mlstm_state_phase(int mk_tid, LAS unsigned char* lds, u16* kc, const u16* vT, float* gW, float* gms, float* gMl, u16* CT, float* nvec,
                          const float* ifg, float* gz, float* gM, float* gE, const float* HBQ, const float* cw, const float* cb) {
    const int tid = mk_tid, lane = tid & 63, wid = tid >> 6, fr = lane & 15, fq = lane >> 4;
    LAS unsigned* slab = (LAS unsigned*)(lds + wid * 9216);
    const unsigned trbase = (unsigned)(size_t)slab + (unsigned)((8 * fq + (fr >> 2)) * 72 + 8 * (fr & 3));
    const int lr = lane >> 2, lp = lane & 3;
    for (int item = blockIdx.x; item < 256; item += gridDim.x) {
        const int bh = item >> 3, eb = item & 7, b = bh >> 2, h = bh & 3;
        gate_prepass(mk_tid, lds, bh, ifg, gz, gM, gE, gms, gMl, gW);
        qk_fix_local(mk_tid, HBQ, cw, cb, kc, 1024 + h * 256, b * 8, 8);
        asm volatile("s_waitcnt vmcnt(0)" ::: "memory"); __syncthreads();
        f32x4 acc[2][2], nac4[2] = {(f32x4){0.f, 0.f, 0.f, 0.f}, (f32x4){0.f, 0.f, 0.f, 0.f}};
        const bf16x8 ones8 = __builtin_bit_cast(bf16x8, (u32x4){0x3F803F80u, 0x3F803F80u, 0x3F803F80u, 0x3F803F80u});
#pragma unroll
        for (int dm = 0; dm < 2; ++dm)
#pragma unroll
            for (int en = 0; en < 2; ++en) acc[dm][en] = (f32x4){0.f, 0.f, 0.f, 0.f};
        u32x4 kreg[8], vreg[4][2]; float wrow[8];
        {   const size_t tbase = (size_t)b * SEQ;
#pragma unroll
            for (int i = 0; i < 8; ++i) { kreg[i] = *(const u32x4*)(kc + (tbase + i * 16 + lr) * 1024 + h * 256 + wid * 32 + lp * 8); wrow[i] = gW[(size_t)bh * SEQ + i * 16 + lr]; }
#pragma unroll
            for (int ks = 0; ks < 4; ++ks)
#pragma unroll
                for (int en = 0; en < 2; ++en) vreg[ks][en] = *(const u32x4*)(vT + (size_t)(h * 256 + eb * 32 + en * 16 + fr) * T + tbase + ks * 32 + 8 * fq); }
        for (int c = 0; c < 16; ++c) {
            u16* ct = CT + ((size_t)(bh * 16 + c) << 16);
#pragma unroll
            for (int dm = 0; dm < 2; ++dm) {
#pragma unroll
                for (int en = 0; en < 2; ++en) { const int e = eb * 32 + en * 16 + fr, d = wid * 32 + dm * 16 + 4 * fq; u32x2 w; w.x = pk2(acc[dm][en][0], acc[dm][en][1]); w.y = pk2(acc[dm][en][2], acc[dm][en][3]); *(u32x2*)(ct + e * 256 + d) = w; }
                if (eb == 0 && fr == 0) *(f32x4*)(nvec + (size_t)(bh * 16 + c) * 256 + wid * 32 + dm * 16 + 4 * fq) = nac4[dm];
            }
            if (c == 15) break;
#pragma unroll
            for (int i = 0; i < 8; ++i) { float kf[8]; unpack8(kreg[i], kf); const float w = wrow[i]; LAS unsigned* dp = slab + (i * 16 + lr) * 18 + lp * 4;
                dp[0] = pk2(kf[0] * w, kf[1] * w); dp[1] = pk2(kf[2] * w, kf[3] * w); dp[2] = pk2(kf[4] * w, kf[5] * w); dp[3] = pk2(kf[6] * w, kf[7] * w); }
            bf16x8 bfr[4][2];
#pragma unroll
            for (int ks = 0; ks < 4; ++ks)
#pragma unroll
                for (int en = 0; en < 2; ++en) bfr[ks][en] = __builtin_bit_cast(bf16x8, vreg[ks][en]);
            if (c + 1 < 15) { const size_t tbase = (size_t)b * SEQ + (c + 1) * 128;
#pragma unroll
                for (int i = 0; i < 8; ++i) { kreg[i] = *(const u32x4*)(kc + (tbase + i * 16 + lr) * 1024 + h * 256 + wid * 32 + lp * 8); wrow[i] = gW[(size_t)bh * SEQ + (c + 1) * 128 + i * 16 + lr]; }
#pragma unroll
                for (int ks = 0; ks < 4; ++ks)
#pragma unroll
                    for (int en = 0; en < 2; ++en) vreg[ks][en] = *(const u32x4*)(vT + (size_t)(h * 256 + eb * 32 + en * 16 + fr) * T + tbase + ks * 32 + 8 * fq); }
            const float dec = __expf(gms[bh * 16 + c] - gMl[bh * 16 + c]);
#pragma unroll
            for (int dm = 0; dm < 2; ++dm) { nac4[dm] *= dec;
#pragma unroll
                for (int en = 0; en < 2; ++en) acc[dm][en] *= dec; }
            __builtin_amdgcn_fence(__ATOMIC_RELEASE, "wavefront"); __builtin_amdgcn_wave_barrier(); __builtin_amdgcn_fence(__ATOMIC_ACQUIRE, "wavefront");
#pragma unroll
            for (int ks = 0; ks < 4; ++ks) {
                bf16x8 afr[2];
                {
                    s16x4 a00, a01, a10, a11; const unsigned ad = trbase + (unsigned)(ks * 32 * 72);
                    asm volatile("s_waitcnt lgkmcnt(0)\n\tds_read_b64_tr_b16 %0, %4\n\tds_read_b64_tr_b16 %1, %4 offset:288\n\tds_read_b64_tr_b16 %2, %4 offset:32\n\tds_read_b64_tr_b16 %3, %4 offset:320\n\ts_waitcnt lgkmcnt(0)"
                                 : "=&v"(a00), "=&v"(a01), "=&v"(a10), "=&v"(a11) : "v"(ad) : "memory");
                    afr[0] = __builtin_shufflevector(a00, a01, 0, 1, 2, 3, 4, 5, 6, 7); afr[1] = __builtin_shufflevector(a10, a11, 0, 1, 2, 3, 4, 5, 6, 7); }
                nac4[0] = mfma16(afr[0], ones8, nac4[0]); nac4[1] = mfma16(afr[1], ones8, nac4[1]);
#pragma unroll
                for (int dm = 0; dm < 2; ++dm)
#pragma unroll
                    for (int en = 0; en < 2; ++en) acc[dm][en] = mfma16(afr[dm], bfr[ks][en], acc[dm][en]);
            }
            __builtin_amdgcn_fence(__ATOMIC_RELEASE, "wavefront"); __builtin_amdgcn_wave_barrier(); __builtin_amdgcn_fence(__ATOMIC_ACQUIRE, "wavefront");
        }
    }
}

DI void mlstm_out_phase(int mk_tid, LAS unsigned char* lds, u16* qy, const u16* kc, const u16* vT, const u16* CT, const float* nvec, const u16* og,
                        const float* gz, const float* gM, const float* gE, const float* gms, const float* ng, int nostore, const float* HBQ, const float* cw, const float* cb) {
    const int tid = mk_tid, lane = tid & 63, wid = __builtin_amdgcn_readfirstlane(tid >> 6), fr = lane & 15, fq = lane >> 4;
    LAS u16* Ksh = (LAS u16*)lds;
    LAS u16* Vsh = (LAS u16*)(lds + 67584);
    for (int item = blockIdx.x; item < 512; item += gridDim.x) {
        const int bh = item >> 4, c = item & 15, b = bh >> 2, h = bh & 3; const size_t tbase = (size_t)b * SEQ + c * 128;
        if ((c & 1) == 0) qk_fix_local(mk_tid, HBQ, cw, cb, qy, h * 256, (int)(tbase >> 8), 1);
        __syncthreads();
        for (int e = tid; e < 4096; e += 512) { const int r = e >> 5, p = e & 31; *(LAS u32x4*)(Ksh + r * 264 + p * 8) = *(const u32x4*)(kc + (tbase + r) * 1024 + h * 256 + p * 8); }
        for (int e = tid; e < 4096; e += 512) { const int r = e >> 4, p = e & 15; *(LAS u32x4*)(Vsh + r * 136 + p * 8) = *(const u32x4*)(vT + (size_t)(h * 256 + r) * T + tbase + p * 8); }
        asm volatile("s_waitcnt vmcnt(0)" ::: "memory");
        __syncthreads();
        const int tl = wid * 16 + fr; const size_t tok = tbase + tl;
        bf16x8 qf[8];
#pragma unroll
        for (int ks = 0; ks < 8; ++ks) qf[ks] = *(const bf16x8*)(qy + tok * 1024 + h * 256 + ks * 32 + 8 * fq);
        const size_t gi = (size_t)bh * SEQ + c * 128;
        const float Mt = gM[gi + tl], en_t = gE[gi + tl], winter = __expf(gms[bh * 16 + c] - Mt);
        const u16* ct = CT + ((size_t)(bh * 16 + c) << 16);
        u32x4 cpre[8];
#pragma unroll
        for (int i = 0; i < 8; ++i) { const int e = tid + i * 512, r = e >> 5, p = e & 31; cpre[i] = *(const u32x4*)(ct + (size_t)r * 256 + p * 8); }
        bf16x8 pf[4]; float dsum = 0.f;
#pragma unroll
        for (int sp = 0; sp < 4; ++sp) {
            u32x4 pk = (u32x4){0u, 0u, 0u, 0u};
#pragma unroll
            for (int hh = 0; hh < 2; ++hh) { const int si = sp * 2 + hh;
                if (si <= wid) {
                    f32x4 st = (f32x4){0.f, 0.f, 0.f, 0.f};
#pragma unroll
                    for (int ks = 0; ks < 8; ++ks) { const bf16x8 a = *(const LAS bf16x8*)(Ksh + (si * 16 + fr) * 264 + ks * 32 + 8 * fq); st = mfma16(a, qf[ks], st); }
                    const float4 z = *(const float4*)(gz + gi + si * 16 + 4 * fq); const float zz[4] = {z.x, z.y, z.z, z.w}; float pv[4];
#pragma unroll
                    for (int j = 0; j < 4; ++j) { const int s = si * 16 + 4 * fq + j; const float p = (s <= tl) ? st[j] * __expf(zz[j] - Mt) : 0.f; dsum += p; pv[j] = p; }
                    if (hh == 0) { pk.x = pk2(pv[0], pv[1]); pk.y = pk2(pv[2], pv[3]); } else { pk.z = pk2(pv[0], pv[1]); pk.w = pk2(pv[2], pv[3]); }
                } }
            pf[sp] = __builtin_bit_cast(bf16x8, pk);
        }
        f32x4 o[16];
#pragma unroll
        for (int half = 0; half < 2; ++half) {
            __syncthreads();
#pragma unroll
            for (int i = 0; i < 8; ++i) { const int e = tid + i * 512, r = e >> 5, p = e & 31; *(LAS u32x4*)(Ksh + r * 264 + p * 8) = cpre[i]; }
            if (half == 0) {
#pragma unroll
                for (int i = 0; i < 8; ++i) { const int e = tid + i * 512, r = e >> 5, p = e & 31; cpre[i] = *(const u32x4*)(ct + (size_t)(128 + r) * 256 + p * 8); } }
            __syncthreads();
#pragma unroll
            for (int e8 = 0; e8 < 8; ++e8) { f32x4 a = (f32x4){0.f, 0.f, 0.f, 0.f};
#pragma unroll
                for (int ks = 0; ks < 8; ++ks) { const bf16x8 cf = *(const LAS bf16x8*)(Ksh + (e8 * 16 + fr) * 264 + ks * 32 + 8 * fq); a = mfma16(cf, qf[ks], a); }
                o[half * 8 + e8] = a * winter; __builtin_amdgcn_sched_barrier(0); }
        }
        const float* nv = nvec + (size_t)(bh * 16 + c) * 256; float qn = 0.f;
#pragma unroll
        for (int ks = 0; ks < 8; ++ks) { const float4 n0 = *(const float4*)(nv + ks * 32 + 8 * fq), n1 = *(const float4*)(nv + ks * 32 + 8 * fq + 4); const float nn[8] = {n0.x, n0.y, n0.z, n0.w, n1.x, n1.y, n1.z, n1.w};
#pragma unroll
            for (int j = 0; j < 8; ++j) qn += bf2f((u16)qf[ks][j]) * nn[j]; }
        qn += __shfl_xor(qn, 16); qn += __shfl_xor(qn, 32); dsum += __shfl_xor(dsum, 16); dsum += __shfl_xor(dsum, 32);
        const int nsp = (wid >> 1) + 1;
#pragma unroll
        for (int et = 0; et < 16; ++et) { __builtin_amdgcn_sched_barrier(0);
#pragma unroll
            for (int sp = 0; sp < 4; ++sp) if (sp < nsp) {
                const s16x4 lo = *(const LAS s16x4*)(Vsh + (et * 16 + fr) * 136 + sp * 32 + 4 * fq), hi = *(const LAS s16x4*)(Vsh + (et * 16 + fr) * 136 + sp * 32 + 16 + 4 * fq);
                const bf16x8 a = __builtin_shufflevector(lo, hi, 0, 1, 2, 3, 4, 5, 6, 7); o[et] = mfma16(a, pf[sp], o[et]); } }
        const float den = winter * qn + dsum, inv = 1.f / fmaxf(fabsf(den), en_t);
        float sum = 0.f;
#pragma unroll
        for (int et = 0; et < 16; ++et) { o[et] *= inv; sum += (o[et][0] + o[et][1]) + (o[et][2] + o[et][3]); }
        sum += __shfl_xor(sum, 16); sum += __shfl_xor(sum, 32); const float mu = sum * (1.f / 256.f);
        float var = 0.f;
#pragma unroll
        for (int et = 0; et < 16; ++et) { o[et] -= mu; var += (o[et][0] * o[et][0] + o[et][1] * o[et][1]) + (o[et][2] * o[et][2] + o[et][3] * o[et][3]); }
        var += __shfl_xor(var, 16); var += __shfl_xor(var, 32); const float rstd = rsqrtf(var * (1.f / 256.f) + 1e-6f);
        u32x2 ogr[16]; float4 gg[16];
#pragma unroll
        for (int et = 0; et < 16; ++et) { ogr[et] = *(const u32x2*)(og + tok * 1024 + h * 256 + et * 16 + 4 * fq); gg[et] = *(const float4*)(ng + h * 256 + et * 16 + 4 * fq); }
        __builtin_amdgcn_sched_barrier(0);
#pragma unroll
        for (int et = 0; et < 16; ++et) { const int e = h * 256 + et * 16 + 4 * fq; const float4 g4 = gg[et];
            u32x2 w; w.x = pk2(sigm(bflo(ogr[et].x)) * o[et][0] * rstd * g4.x, sigm(bfhi(ogr[et].x)) * o[et][1] * rstd * g4.y); w.y = pk2(sigm(bflo(ogr[et].y)) * o[et][2] * rstd * g4.z, sigm(bfhi(ogr[et].y)) * o[et][3] * rstd * g4.w);
            if (!nostore) *(u32x2*)(qy + tok * 1024 + e) = w; }
    }
}

DI void xattn_pair(int mk_tid, LAS unsigned char* lds, const u16* q, const u16* kmem, const u16* vTm, u16* ao, int b, int h, int qb0) {
    const int tid = mk_tid, lane = tid & 63, wid = tid >> 6, fr = lane & 15, fq = lane >> 4;
    LAS u16* Ksh = (LAS u16*)lds;
    {
        __syncthreads();
        for (int e = tid; e < 8192; e += 512) { const int r = e >> 5, p = e & 31; *(LAS u32x4*)(Ksh + r * 264 + p * 8) = *(const u32x4*)(kmem + (size_t)(b * 256 + r) * 1024 + h * 256 + p * 8); }
        __syncthreads();
        const size_t tok0 = (size_t)b * SEQ + qb0 * 128 + wid * 16 + fr, tok1 = tok0 + 128;
        bf16x8 qa[8], qb8[8];
#pragma unroll
        for (int ks = 0; ks < 8; ++ks) { qa[ks] = *(const bf16x8*)(q + tok0 * 1024 + h * 256 + ks * 32 + 8 * fq); qb8[ks] = *(const bf16x8*)(q + tok1 * 1024 + h * 256 + ks * 32 + 8 * fq); }
        float mx0 = -3.0e38f, mx1 = -3.0e38f;
#pragma unroll
        for (int mi = 0; mi < 16; ++mi) { f32x4 a = (f32x4){0.f, 0.f, 0.f, 0.f}, c = (f32x4){0.f, 0.f, 0.f, 0.f};
#pragma unroll
            for (int ks = 0; ks < 8; ++ks) { const bf16x8 kf = *(const LAS bf16x8*)(Ksh + (mi * 16 + fr) * 264 + ks * 32 + 8 * fq); a = mfma16(kf, qa[ks], a); c = mfma16(kf, qb8[ks], c); }
            mx0 = fmaxf(mx0, fmaxf(fmaxf(a[0], a[1]), fmaxf(a[2], a[3]))); mx1 = fmaxf(mx1, fmaxf(fmaxf(c[0], c[1]), fmaxf(c[2], c[3]))); __builtin_amdgcn_sched_barrier(0); }
        mx0 = fmaxf(mx0, __shfl_xor(mx0, 16)); mx0 = fmaxf(mx0, __shfl_xor(mx0, 32)); mx1 = fmaxf(mx1, __shfl_xor(mx1, 16)); mx1 = fmaxf(mx1, __shfl_xor(mx1, 32));
        bf16x8 pf0[8], pf1[8]; float sum0 = 0.f, sum1 = 0.f;
#pragma unroll
        for (int sp = 0; sp < 8; ++sp) { f32x4 a0 = (f32x4){0.f, 0.f, 0.f, 0.f}, a1 = a0, c0 = a0, c1 = a0;
#pragma unroll
            for (int ks = 0; ks < 8; ++ks) { const bf16x8 k0 = *(const LAS bf16x8*)(Ksh + (sp * 32 + fr) * 264 + ks * 32 + 8 * fq), k1 = *(const LAS bf16x8*)(Ksh + (sp * 32 + 16 + fr) * 264 + ks * 32 + 8 * fq);
                a0 = mfma16(k0, qa[ks], a0); a1 = mfma16(k1, qa[ks], a1); c0 = mfma16(k0, qb8[ks], c0); c1 = mfma16(k1, qb8[ks], c1); }
            float p[8], r[8];
#pragma unroll
            for (int j = 0; j < 4; ++j) { p[j] = __expf((a0[j] - mx0) * 0.0625f); p[4 + j] = __expf((a1[j] - mx0) * 0.0625f); sum0 += p[j] + p[4 + j];
                                          r[j] = __expf((c0[j] - mx1) * 0.0625f); r[4 + j] = __expf((c1[j] - mx1) * 0.0625f); sum1 += r[j] + r[4 + j]; }
            u32x4 pk; pk.x = pk2(p[0], p[1]); pk.y = pk2(p[2], p[3]); pk.z = pk2(p[4], p[5]); pk.w = pk2(p[6], p[7]); pf0[sp] = __builtin_bit_cast(bf16x8, pk);
            u32x4 rk; rk.x = pk2(r[0], r[1]); rk.y = pk2(r[2], r[3]); rk.z = pk2(r[4], r[5]); rk.w = pk2(r[6], r[7]); pf1[sp] = __builtin_bit_cast(bf16x8, rk); __builtin_amdgcn_sched_barrier(0); }
        sum0 += __shfl_xor(sum0, 16); sum0 += __shfl_xor(sum0, 32); sum1 += __shfl_xor(sum1, 16); sum1 += __shfl_xor(sum1, 32);
        const float iv0 = 1.f / sum0, iv1 = 1.f / sum1;
        __syncthreads();
        for (int e = tid; e < 8192; e += 512) { const int r = e >> 5, p = e & 31; *(LAS u32x4*)(Ksh + r * 264 + p * 8) = *(const u32x4*)(vTm + (size_t)(h * 256 + r) * 2048 + b * 256 + p * 8); }
        __syncthreads();
#pragma unroll 2
        for (int et = 0; et < 16; ++et) {
            f32x4 o0 = (f32x4){0.f, 0.f, 0.f, 0.f}, o1 = o0;
#pragma unroll
            for (int sp = 0; sp < 8; ++sp) { const s16x4 lo = *(const LAS s16x4*)(Ksh + (et * 16 + fr) * 264 + sp * 32 + 4 * fq), hi = *(const LAS s16x4*)(Ksh + (et * 16 + fr) * 264 + sp * 32 + 16 + 4 * fq);
                const bf16x8 a = __builtin_shufflevector(lo, hi, 0, 1, 2, 3, 4, 5, 6, 7); o0 = mfma16(a, pf0[sp], o0); o1 = mfma16(a, pf1[sp], o1); }
            u32x2 w0, w1; w0.x = pk2(o0[0] * iv0, o0[1] * iv0); w0.y = pk2(o0[2] * iv0, o0[3] * iv0); w1.x = pk2(o1[0] * iv1, o1[1] * iv1); w1.y = pk2(o1[2] * iv1, o1[3] * iv1);
            *(u32x2*)(ao + tok0 * 1024 + h * 256 + et * 16 + 4 * fq) = w0; *(u32x2*)(ao + tok1 * 1024 + h * 256 + et * 16 + 4 * fq) = w1; __builtin_amdgcn_sched_barrier(0); }
    }
}

DI void rglru_phase(int mk_tid, LAS unsigned char* lds, const u16* xr, const u16* gr, const float* cw, const float* cb, const float* wa, const float* ba, const float* wx, const float* bx, const float* lam, u16* ya, int pass, float* sumA, float* sumH) {
    const int tid = mk_tid, lane = tid & 63, wid = tid >> 6, fr = lane & 15, fq = lane >> 4;
    LAS u16* xs = (LAS u16*)(lds + wid * 8192);
    LAS float* xf = (LAS float*)(lds + wid * 8192 + 2560);
    const int tp = lane >> 3, co = lane & 7;
    for (int item = blockIdx.x * 8 + wid; item < 2048; item += gridDim.x * 8) {
        const int b = item >> 8, g = (item >> 4) & 15, seg = item & 15, ccol = g * 64 + co * 8;
        LAS u16* Wsh = (LAS u16*)(lds + 65536);
        __syncthreads();
        for (int e = tid; e < 4096; e += 512) { const int i = e >> 6, j = e & 63; Wsh[j * 72 + i] = f2bf(wa[(size_t)(g * 64 + i) * 64 + j]); Wsh[4608 + j * 72 + i] = f2bf(wx[(size_t)(g * 64 + i) * 64 + j]); }
        __syncthreads();
        if (pass == 0 && seg == 15) continue;
        float bav[4], bxv[4], c8[4], carry[4], aprod[4];
#pragma unroll
        for (int nt = 0; nt < 4; ++nt) { const int cch = g * 64 + nt * 16 + fr;
            bav[nt] = ba[cch]; bxv[nt] = bx[cch]; c8[nt] = -8.f * log1pf(__expf(-lam[cch])); carry[nt] = 0.f; aprod[nt] = 1.f;
            if (pass == 1) for (int s2 = 0; s2 < seg; ++s2) carry[nt] = sumA[(size_t)(b * 16 + s2) * 1024 + cch] * carry[nt] + sumH[(size_t)(b * 16 + s2) * 1024 + cch]; }
        float w0[8], w1[8], w2[8], w3[8], bb[8];
#pragma unroll
        for (int e = 0; e < 8; ++e) { w0[e] = cw[ccol + e]; w1[e] = cw[1024 + ccol + e]; w2[e] = cw[2048 + ccol + e]; w3[e] = cw[3072 + ccol + e]; bb[e] = cb[ccol + e]; }
        const size_t tb0 = (size_t)b * SEQ; const int sb = seg * 128;
        u32x4 rows[5]; u16 grv[4][4];
#pragma unroll
        for (int r = 0; r < 5; ++r) { const int srow = sb + 2 * tp - 3 + r; rows[r] = (srow >= 0) ? *(const u32x4*)(xr + (tb0 + srow) * 1024 + ccol) : (u32x4){0u, 0u, 0u, 0u}; }
#pragma unroll
        for (int nt = 0; nt < 4; ++nt)
#pragma unroll
            for (int j = 0; j < 4; ++j) grv[nt][j] = (pass == 1) ? gr[(tb0 + sb + 4 * fq + j) * 1024 + g * 64 + nt * 16 + fr] : (u16)0;
        for (int st = 0; st < 8; ++st) {
            u32x4 cur[5]; u16 gcur[4][4];
#pragma unroll
            for (int r = 0; r < 5; ++r) cur[r] = rows[r];
#pragma unroll
            for (int nt = 0; nt < 4; ++nt)
#pragma unroll
                for (int j = 0; j < 4; ++j) gcur[nt][j] = grv[nt][j];
            const int t0 = sb + st * 16;
            if (st + 1 < 8) {
#pragma unroll
                for (int r = 0; r < 5; ++r) rows[r] = *(const u32x4*)(xr + (tb0 + t0 + 16 + 2 * tp - 3 + r) * 1024 + ccol);
                if (pass == 1) {
#pragma unroll
                    for (int nt = 0; nt < 4; ++nt)
#pragma unroll
                        for (int j = 0; j < 4; ++j) grv[nt][j] = gr[(tb0 + t0 + 16 + 4 * fq + j) * 1024 + g * 64 + nt * 16 + fr]; }
            }
            float r0[8], r1[8], r2[8], r3[8], r4[8], oa[8], ob[8];
            unpack8(cur[0], r0); unpack8(cur[1], r1); unpack8(cur[2], r2); unpack8(cur[3], r3); unpack8(cur[4], r4);
#pragma unroll
            for (int e = 0; e < 8; ++e) { oa[e] = bb[e] + w0[e] * r0[e] + w1[e] * r1[e] + w2[e] * r2[e] + w3[e] * r3[e]; ob[e] = bb[e] + w0[e] * r1[e] + w1[e] * r2[e] + w2[e] * r3[e] + w3[e] * r4[e]; }
            { u32x4 pa, pb; pa.x = pk2(oa[0], oa[1]); pa.y = pk2(oa[2], oa[3]); pa.z = pk2(oa[4], oa[5]); pa.w = pk2(oa[6], oa[7]); pb.x = pk2(ob[0], ob[1]); pb.y = pk2(ob[2], ob[3]); pb.z = pk2(ob[4], ob[5]); pb.w = pk2(ob[6], ob[7]);
              *(LAS u32x4*)(xs + (2 * tp) * 72 + co * 8) = pa; *(LAS u32x4*)(xs + (2 * tp + 1) * 72 + co * 8) = pb;
              *(LAS f32x4*)(xf + (2 * tp) * 68 + co * 8) = (f32x4){oa[0], oa[1], oa[2], oa[3]}; *(LAS f32x4*)(xf + (2 * tp) * 68 + co * 8 + 4) = (f32x4){oa[4], oa[5], oa[6], oa[7]};
              *(LAS f32x4*)(xf + (2 * tp + 1) * 68 + co * 8) = (f32x4){ob[0], ob[1], ob[2], ob[3]}; *(LAS f32x4*)(xf + (2 * tp + 1) * 68 + co * 8 + 4) = (f32x4){ob[4], ob[5], ob[6], ob[7]}; }
            __builtin_amdgcn_fence(__ATOMIC_RELEASE, "wavefront"); __builtin_amdgcn_wave_barrier(); __builtin_amdgcn_fence(__ATOMIC_ACQUIRE, "wavefront");
            const bf16x8 af0 = *(const LAS bf16x8*)(xs + fr * 72 + 8 * fq), af1 = *(const LAS bf16x8*)(xs + fr * 72 + 32 + 8 * fq);
#pragma unroll
            for (int nt = 0; nt < 4; ++nt) {
                f32x4 aa = (f32x4){0.f, 0.f, 0.f, 0.f}, ax = (f32x4){0.f, 0.f, 0.f, 0.f};
                { const LAS u16* wp = Wsh + (nt * 16 + fr) * 72 + 8 * fq; const bf16x8 wa0 = *(const LAS bf16x8*)wp, wa1 = *(const LAS bf16x8*)(wp + 32), wx0 = *(const LAS bf16x8*)(wp + 4608), wx1 = *(const LAS bf16x8*)(wp + 4608 + 32);
                  aa = mfma16(af0, wa0, aa); aa = mfma16(af1, wa1, aa); ax = mfma16(af0, wx0, ax); ax = mfma16(af1, wx1, ax); }
                float hl[4], pa4[4]; float Al = 1.f, Hl = 0.f;
#pragma unroll
                for (int j = 0; j < 4; ++j) { const float xc = xf[(4 * fq + j) * 68 + nt * 16 + fr]; const float rr = sigm(aa[j] + bav[nt]), ii = sigm(ax[j] + bxv[nt]), la = c8[nt] * rr, av = __expf(la), x2 = 2.f * la;
                    const float om = (x2 > -0.02f) ? -x2 * (1.f + x2 * (0.5f + x2 * (1.f / 6.f))) : 1.f - av * av;
                    const float uu = __builtin_amdgcn_sqrtf(fmaxf(om, 0.f)) * ii * xc;
                    Hl = av * Hl + uu; Al *= av; hl[j] = Hl; pa4[j] = Al; }
                const float A0 = __shfl(Al, fr), H0 = __shfl(Hl, fr), A1 = __shfl(Al, fr + 16), H1 = __shfl(Hl, fr + 16), A2 = __shfl(Al, fr + 32), H2 = __shfl(Hl, fr + 32), A3 = __shfl(Al, fr + 48), H3 = __shfl(Hl, fr + 48);
                const float cin = carry[nt], c1 = A0 * cin + H0, c2 = A1 * c1 + H1, c3 = A2 * c2 + H2, c4 = A3 * c3 + H3;
                const float hin = (fq == 0) ? cin : (fq == 1) ? c1 : (fq == 2) ? c2 : c3;
                carry[nt] = c4; aprod[nt] *= (A0 * A1) * (A2 * A3);
                if (pass == 1) {
#pragma unroll
                    for (int j = 0; j < 4; ++j) { const float hv = hl[j] + pa4[j] * hin; ya[(tb0 + t0 + 4 * fq + j) * 1024 + g * 64 + nt * 16 + fr] = f2bf(gelu_t(bf2f(gcur[nt][j])) * hv); } }
            }
            __builtin_amdgcn_fence(__ATOMIC_RELEASE, "wavefront"); __builtin_amdgcn_wave_barrier(); __builtin_amdgcn_fence(__ATOMIC_ACQUIRE, "wavefront");
        }
        if (pass == 0 && fq == 0) {
#pragma unroll
            for (int nt = 0; nt < 4; ++nt) { sumA[(size_t)(b * 16 + seg) * 1024 + g * 64 + nt * 16 + fr] = aprod[nt]; sumH[(size_t)(b * 16 + seg) * 1024 + g * 64 + nt * 16 + fr] = carry[nt]; } }
    }
}

DI void ffn_act_phase(int mk_tid, const u16* up, const float* cw, const float* cb, u16* act, int part) {
    const int gtid = blockIdx.x * 512 + mk_tid, nth = gridDim.x * 512;
    for (int item = gtid; item < 192 * 1024; item += nth) {
        const int co = item % 192, tb = item / 192, c0 = co * 8, t0 = tb * 16, gc = part * 1536 + c0;
        float wg0[8], wg1[8], wg2[8], wu0[8], wu1[8], wu2[8], bg[8], bu[8];
#pragma unroll
        for (int e = 0; e < 8; ++e) { wg0[e] = cw[gc + e]; wg1[e] = cw[6144 + gc + e]; wg2[e] = cw[12288 + gc + e]; wu0[e] = cw[3072 + gc + e]; wu1[e] = cw[6144 + 3072 + gc + e]; wu2[e] = cw[12288 + 3072 + gc + e]; bg[e] = cb[gc + e]; bu[e] = cb[3072 + gc + e]; }
        float g0[8], g1[8], g2[8], u0[8], u1[8], u2[8];
        if ((t0 & (SEQ - 1)) == 0) {
#pragma unroll
            for (int e = 0; e < 8; ++e) { g0[e] = 0.f; g1[e] = 0.f; u0[e] = 0.f; u1[e] = 0.f; }
        } else {
            unpack8(*(const u32x4*)(up + (size_t)(t0 - 2) * 3072 + c0), g0); unpack8(*(const u32x4*)(up + (size_t)(t0 - 1) * 3072 + c0), g1);
            unpack8(*(const u32x4*)(up + (size_t)(t0 - 2) * 3072 + 1536 + c0), u0); unpack8(*(const u32x4*)(up + (size_t)(t0 - 1) * 3072 + 1536 + c0), u1);
        }
        for (int tt = 0; tt < 16; ++tt) {
            unpack8(*(const u32x4*)(up + (size_t)(t0 + tt) * 3072 + c0), g2); unpack8(*(const u32x4*)(up + (size_t)(t0 + tt) * 3072 + 1536 + c0), u2);
            float o[8];
#pragma unroll
            for (int e = 0; e < 8; ++e) { const float gv = bg[e] + wg0[e] * g0[e] + wg1[e] * g1[e] + wg2[e] * g2[e], uv = bu[e] + wu0[e] * u0[e] + wu1[e] * u1[e] + wu2[e] * u2[e]; o[e] = gelu_t(gv) * uv; g0[e] = g1[e]; g1[e] = g2[e]; u0[e] = u1[e]; u1[e] = u2[e]; }
            u32x4 r; r.x = pk2(o[0], o[1]); r.y = pk2(o[2], o[3]); r.z = pk2(o[4], o[5]); r.w = pk2(o[6], o[7]);
            *(u32x4*)(act + (size_t)(t0 + tt) * 3072 + gc) = r;
        }
    }
}

DI UE ue_bf16(u16* O, int ldc, int split) { UE e; e.perm = 1; e.kind = 0; e.O = O; e.ldc = ldc; e.split = split; e.gate = nullptr; e.F = nullptr; e.Fin = nullptr; e.ss = nullptr; e.smode = 0; e.HBo = nullptr; e.sso = nullptr; e.ssp = nullptr; e.cnt = nullptr; e.rflags = 0; return e; }
DI GD mkgd(const u16* A, const u16* Bt, int M, int N, int K, int cshift, UE e) { GD d; d.A = A; d.Bt = Bt; d.M = M; d.N = N; d.K = K; d.cshift = cshift; d.e = e; return d; }

#define XB_TMO      128
#define XB_XCNT(j)  (256  + 64 * (j))
#define XB_XSUB(j)  (1280 + 64 * (j))
#define XB_XGEN(j)  (2304 + 64 * (j))
#define XB_TOP      3328
#define XB_TOPGEN   3392
#define XCD_BAR_WORDS 3456
#define XB_SPIN_CAP (1u << 18)

__device__ __forceinline__ unsigned xb_ld(unsigned* p)              { return __hip_atomic_load(p, __ATOMIC_RELAXED, __HIP_MEMORY_SCOPE_AGENT); }
__device__ __forceinline__ unsigned xb_add(unsigned* p, unsigned v) { return __hip_atomic_fetch_add(p, v, __ATOMIC_RELAXED, __HIP_MEMORY_SCOPE_AGENT); }
__device__ __forceinline__ unsigned xb_xcc_id() { return (unsigned)__builtin_amdgcn_s_getreg((3 << 11) | 20) & 0xFu; }
#define XB_SPIN(cond, bar) do { unsigned _sp = 0; while (cond) { __builtin_amdgcn_s_sleep(1); \
    if ((++_sp & 255u) == 0u) { if (xb_ld(&(bar)[XB_TMO])) break; if (_sp > XB_SPIN_CAP) { atomicAdd(&(bar)[XB_TMO], 1u); break; } } } } while (0)

struct XcdBarrier {
    unsigned* bar; unsigned x;
    volatile LAS unsigned* st;
};

__device__ __forceinline__ XcdBarrier xcd_barrier_post(unsigned* bar, volatile LAS unsigned* st) {
    XcdBarrier b; b.bar = bar; b.x = xb_xcc_id(); b.st = st;
    if (threadIdx.x == 0) (void)xb_add(&bar[XB_XCNT(b.x)], 1u);
    return b;
}
__device__ __forceinline__ void xcd_barrier_complete(unsigned* bar, unsigned x, unsigned& nloc, unsigned& nx) {
    const unsigned G = gridDim.x * gridDim.y * gridDim.z;
    unsigned sum, cnt, mine, sp = 0u;
    for (;;) {
        sum = 0u; cnt = 0u; mine = 0u;
#pragma unroll
        for (unsigned j = 0; j < 16; ++j) { const unsigned c = xb_ld(&bar[XB_XCNT(j)]); sum += c; cnt += (c > 0u) ? 1u : 0u; mine = (j == x) ? c : mine; }
        if (sum == G) break;
        __builtin_amdgcn_s_sleep(1);
        if ((++sp & 255u) == 0u) { if (xb_ld(&bar[XB_TMO])) break; if (sp > XB_SPIN_CAP) { atomicAdd(&bar[XB_TMO], 1u); break; } }
    }
    nloc = mine > 0u ? mine : 1u; nx = cnt > 0u ? cnt : 1u;
}

__device__ __forceinline__ void xcd_barrier(const XcdBarrier& b) {
    asm volatile("s_waitcnt vmcnt(0)" ::: "memory");
    __syncthreads();
    if (threadIdx.x == 0) {
        unsigned* bar = b.bar;
        __builtin_amdgcn_s_waitcnt(0);
        unsigned nloc = b.st[0], nx = b.st[1];
        if (nloc == 0u) { xcd_barrier_complete(bar, b.x, nloc, nx); b.st[0] = nloc; b.st[1] = nx; }
        const unsigned old = xb_add(&bar[XB_XSUB(b.x)], 1u);
        const unsigned gen = old / nloc;
        if (old + 1u == (gen + 1u) * nloc) {
            __builtin_amdgcn_fence(__ATOMIC_RELEASE, "agent");
            asm volatile("s_waitcnt vmcnt(0)" ::: "memory");
            const unsigned og = xb_add(&bar[XB_TOP], 1u);
            const unsigned tg = og / nx;
            if (og + 1u == (tg + 1u) * nx) xb_add(&bar[XB_TOPGEN], 1u);
            else XB_SPIN(xb_ld(&bar[XB_TOPGEN]) == tg, bar);
            __builtin_amdgcn_fence(__ATOMIC_ACQUIRE, "agent");
            xb_add(&bar[XB_XGEN(b.x)], 1u);
            asm volatile("s_waitcnt vmcnt(0)" ::: "memory");
        } else {
            XB_SPIN(xb_ld(&bar[XB_XGEN(b.x)]) == gen, bar);
            __builtin_amdgcn_fence(__ATOMIC_ACQUIRE, "agent");
            asm volatile("s_waitcnt vmcnt(0)" ::: "memory");
        }
    }
    __syncthreads();
}

DI int gemm_count(int sub) { return (sub == S_GXR) ? 1 : (sub == S_GQK || sub == S_GAB || sub == S_GMIX) ? 2 : 0; }
DI GD get_gd(const Args& a, int l, int sub, int i) {
    unsigned char* ws = a.ws;
    u16* A0 = (u16*)ws; u16* A1 = (u16*)(ws + U); u16* A2 = (u16*)(ws + 2 * U); u16* A3 = (u16*)(ws + 3 * U); u16* A4 = (u16*)(ws + 4 * U); u16* A5 = (u16*)(ws + 5 * U); u16* A6 = (u16*)(ws + 6 * U);
    u16* WT = (u16*)(ws + WS_WT); u16* MEMN = (u16*)(ws + WS_MEMN); u16* KMEM = A3; u16* VTM = A3 + 2097152;
    float* SS = (float*)(ws + WS_SS);
    const size_t MW = (size_t)1024 * 1024;
    UE er = ue_bf16(nullptr, 1024, 0); er.perm = 1; er.kind = 3; er.ssp = (float*)(ws + WS_SSP); er.cnt = (unsigned*)(ws + WS_CNT) + (size_t)(l * 3 + (sub == S_GMIX ? 0 : sub == S_GWO ? 1 : 2)) * 64; er.Fin = (l == 0 && sub == S_GMIX) ? a.in[0] : a.out; er.F = a.out;
    switch (sub) {
    case S_GQK: { UE eo = ue_bf16(A1, 1024, 0); eo.ss = SS + (size_t)(l * 3) * T; eo.smode = 1; UE ev = ue_bf16(A2, T, 0); ev.ss = SS + (size_t)(l * 3) * T; ev.smode = 2;
        return i == 0 ? mkgd(A0, WT + 2 * MW, T, 1024, 1024, 0, eo) : mkgd(WT + 3 * MW, A0, 1024, T, 1024, 0, ev); }
    case S_GXR: { UE e = ue_bf16(A1, 1024, 1); e.ss = SS + (size_t)(l * 3) * T; e.smode = 1; return mkgd(A0, WT + 4 * MW, T, 4096, 1024, 0, e); }
    case S_GAB: { UE e1 = ue_bf16(nullptr, 1024, 0); e1.perm = 1; e1.kind = 1; e1.gate = A3; e1.O = A1; UE e2 = e1; e2.kind = 2; e2.gate = A4; e2.Fin = (const float*)A1; e2.O = A0;
        return i == 0 ? mkgd(A5, WT + 8 * MW, T, 1024, 1024, 0, e1) : mkgd(A6, WT + 9 * MW, T, 1024, 1024, 0, e2); }
    case S_GMIX: return i == 0 ? mkgd(MEMN, WT + MW, 2048, 1024, 1024, 0, ue_bf16(KMEM, 1024, 0)) : mkgd(WT + 2 * MW, MEMN, 1024, 2048, 1024, 64, ue_bf16(VTM, 2048, 0));
    case S_GWO: er.HBo = A0; er.sso = SS + (size_t)(l * 3 + 2) * T; er.Fin = (const float*)A1; er.rflags = 1; return mkgd(A2, WT + 3 * MW, T, 1024, 1024, 0, er);
    default: er.HBo = A0; er.sso = SS + (size_t)(l * 3 + 3) * T; er.Fin = (const float*)A0; er.rflags = 3; return mkgd(A4, WT + 11 * MW, T, 1024, 3072, 0, er);
    }
}
DI void cvt_set(int mk_tid, LAS unsigned char* lds, const Args& a, int l, int set, int vb = -2, int VG = 0) {
    if (vb == -2) { vb = (int)blockIdx.x; VG = (int)gridDim.x; }
    u16* WT = (u16*)(a.ws + WS_WT); const size_t MW = (size_t)1024 * 1024; int tb = 0; const int nj = set == 0 ? 8 : set == 1 ? 3 : 1;
    for (int j = 0; j < nj; ++j) {
        const float* W; int ldw, col0, ncols, K = 1024, il = 0; u16* dst; const float* gain = nullptr;
        if (set == 0) { const float* win = a.in[3] + (size_t)l * 1024 * 8200;
            if (j < 5) { W = win; ldw = 8200; col0 = (j == 0) ? 2048 : (j == 1) ? 5120 : (j == 2) ? 4096 : (j == 3) ? 0 : 6152; ncols = (j == 1 || j == 2) ? 1024 : 2048; dst = WT + ((j == 0) ? 0 : (j == 1) ? 2 : (j == 2) ? 3 : (j == 3) ? 4 : 6) * MW; gain = a.in[2] + l * 1024; }
            else { W = a.in[15 + (j - 5)] + l * MW; ldw = 1024; col0 = 0; ncols = 1024; dst = WT + (8 + (j - 5)) * MW; } }
        else if (set == 1) { W = (j == 0) ? a.in[19] + l * MW : (j == 1) ? a.in[20] + l * 2 * MW : a.in[21] + l * MW; ldw = (j == 1) ? 2048 : 1024; col0 = 0; ncols = (j == 1) ? 2048 : 1024; dst = WT + ((j == 0) ? 0 : (j == 1) ? 1 : 3) * MW; gain = (j == 0) ? a.in[18] + l * 1024 : nullptr; }
        else if (set == 2) { W = a.in[23] + (size_t)l * 6 * MW; ldw = 6144; col0 = 0; ncols = 6144; il = 1; dst = WT + 4 * MW; gain = a.in[22] + l * 1024; }
        else { W = a.in[26] + (size_t)l * 3 * MW; ldw = 1024; col0 = 0; ncols = 1024; K = 3072; dst = WT + 11 * MW; }
        cvt_w(mk_tid, lds, W, ldw, col0, ncols, K, dst, tb, il, gain, vb, VG);
    }
}
DI void ifg_rows(int mk_tid, LAS unsigned char* lds, const u16* hb, const float* ss, const float* win, const float* g, const float* ifb, float* ifg) {
    const int tid = mk_tid, lane = tid & 63, wid = tid >> 6;
    LAS float* sW = (LAS float*)lds;
    __syncthreads();
    for (int e = tid; e < 8192; e += 512) sW[e] = win[(size_t)(e >> 3) * 8200 + 6144 + (e & 7)] * g[e >> 3];
    __syncthreads();
    for (int r0 = blockIdx.x * 64; r0 < T; r0 += gridDim.x * 64) {
        u16 hv[8][16];
#pragma unroll
        for (int rr = 0; rr < 8; ++rr)
#pragma unroll
            for (int e = 0; e < 16; ++e) hv[rr][e] = hb[(size_t)(r0 + wid * 8 + rr) * 1024 + e * 64 + lane];
#pragma unroll
        for (int rr = 0; rr < 8; ++rr) { const int row = r0 + wid * 8 + rr;
            float a0 = 0, a1 = 0, a2 = 0, a3 = 0, a4 = 0, a5 = 0, a6 = 0, a7 = 0;
#pragma unroll
            for (int e = 0; e < 16; ++e) { const int k = e * 64 + lane; const float y = bf2f(hv[rr][e]); const LAS f32x4* wp = (const LAS f32x4*)(sW + k * 8); const f32x4 w0 = wp[0], w1 = wp[1];
                a0 += y * w0.x; a1 += y * w0.y; a2 += y * w0.z; a3 += y * w0.w; a4 += y * w1.x; a5 += y * w1.y; a6 += y * w1.z; a7 += y * w1.w; }
            a0 = wsum(a0); a1 = wsum(a1); a2 = wsum(a2); a3 = wsum(a3); a4 = wsum(a4); a5 = wsum(a5); a6 = wsum(a6); a7 = wsum(a7);
            if (lane == 0) { const float rs = rsqrtf(ss[row] * (1.f / 1024.f) + 1e-6f); float4 o0, o1; o0.x = a0 * rs + ifb[0]; o0.y = a1 * rs + ifb[1]; o0.z = a2 * rs + ifb[2]; o0.w = a3 * rs + ifb[3]; o1.x = a4 * rs + ifb[4]; o1.y = a5 * rs + ifb[5]; o1.z = a6 * rs + ifb[6]; o1.w = a7 * rs + ifb[7];
                *(float4*)(ifg + (size_t)row * 8) = o0; *(float4*)(ifg + (size_t)row * 8 + 4) = o1; }
            __builtin_amdgcn_sched_barrier(0); }
    }
    __syncthreads();
}
DI void raw_rows(int mk_tid, const float* src, u16* dst, float* ssout) {
    const int lane = mk_tid & 63, gw = blockIdx.x * 8 + (mk_tid >> 6), nw = gridDim.x * 8;
    for (int row = gw; row < T; row += nw) {
        float4 v[4]; float sq = 0.f;
#pragma unroll
        for (int i = 0; i < 4; ++i) { v[i] = *(const float4*)(src + (size_t)row * 1024 + i * 256 + lane * 4); sq += v[i].x * v[i].x + v[i].y * v[i].y + v[i].z * v[i].z + v[i].w * v[i].w; }
        sq = wsum(sq);
#pragma unroll
        for (int i = 0; i < 4; ++i) { u32x2 w; w.x = pk2(v[i].x, v[i].y); w.y = pk2(v[i].z, v[i].w); *(u32x2*)(dst + (size_t)row * 1024 + i * 256 + lane * 4) = w; }
        if (lane == 0) ssout[row] = sq;
    }
}
DI void resid_gemm(int mk_tid, LAS unsigned char* lds, const Args& a, int l, int which, const u16* A, const u16* Bt, int K, const float* Fin, u16* HBo, u16* HB2, int rflags) {
    unsigned char* ws = a.ws;
    Gemm g; g.A = A; g.Bt = Bt; g.M = T; g.N = 1024; g.K = K;
    UE3 e; e.perm = 1; e.Fin = Fin; e.F = a.out; e.HBo = HBo; e.HB2 = HB2; e.sso = (float*)(ws + WS_SS) + (size_t)(l * 3 + which + 1) * T; e.ssp = (float*)(ws + WS_SSP); e.cnt = (unsigned*)(ws + WS_CNT) + (size_t)(l * 3 + which) * 64; e.rflags = rflags;
    StaticOrder S; S.init(T, 1024, (int)gridDim.x, (int)blockIdx.x);
    for (int i = 0; ; ++i) { OneUnit O; if (!S.next(i, O.u)) break; __syncthreads(); gemm_phase<UE3, OneUnit, false>(mk_tid, lds, g, O, e, nullptr); }
}
DI void init_phase(int mk_tid, LAS unsigned char* lds, const Args& a) {
    unsigned char* ws = a.ws; float* SS = (float*)(ws + WS_SS);
    for (int i = blockIdx.x * 512 + mk_tid; i < 1024; i += gridDim.x * 512) ((unsigned*)(ws + WS_CNT))[i] = 0u;
    cvt_set(mk_tid, lds, a, 0, 0);
    raw_rows(mk_tid, a.in[0], (u16*)ws, SS);
    norm_rows(mk_tid, a.in[1], a.in[27], (u16*)(ws + WS_MEMN), 2048, nullptr, nullptr, nullptr);
}
DI void other_phase(int mk_tid, LAS unsigned char* lds, const Args& a, int l, int sub) {
    unsigned char* ws = a.ws;
    u16* A0 = (u16*)ws; u16* A1 = (u16*)(ws + U); u16* A2 = (u16*)(ws + 2 * U); u16* A3 = (u16*)(ws + 3 * U); u16* A4 = (u16*)(ws + 4 * U); u16* A5 = (u16*)(ws + 5 * U); u16* A6 = (u16*)(ws + 6 * U);
    u16* WT = (u16*)(ws + WS_WT); u16* KMEM = A3; u16* VTM = A3 + 2097152;
    float* IFG = (float*)(ws + WS_IFG); float* GZ = (float*)(ws + WS_GZ); float* GM = (float*)(ws + WS_GM); float* GE = (float*)(ws + WS_GE); float* GMS = (float*)(ws + WS_GMS); float* GML = (float*)(ws + WS_GML); float* NVEC = (float*)(ws + WS_NVEC);
    float* SS = (float*)(ws + WS_SS);
    const int tid = mk_tid, wid = tid >> 6;
    const size_t MW = (size_t)1024 * 1024;
    switch (sub) {
    case S_GQK: {
        ifg_rows(mk_tid, lds, A0, SS + (size_t)(l * 3) * T, a.in[3] + (size_t)l * 1024 * 8200, a.in[2] + l * 1024, a.in[13] + l * 8, IFG);
        Gemm g; g.A = A0; g.Bt = WT; g.M = T; g.N = 2048; g.K = 1024;
        UE6 e6; e6.perm = 0; e6.qc = A6; e6.kc = A5; e6.HB = (float*)(ws + WS_HBQ); e6.cw = a.in[11] + l * 8192; e6.cb = a.in[12] + l * 2048; e6.ss = SS + (size_t)(l * 3) * T;
        StaticOrder S; S.init(T, 2048, (int)gridDim.x, (int)blockIdx.x);
        for (int i = 0; ; ++i) { OneUnit O; if (!S.next(i, O.u)) break; __syncthreads(); gemm_phase<UE6, OneUnit, false>(mk_tid, lds, g, O, e6, nullptr); }
    } break;
    case S_STATE: mlstm_state_phase(mk_tid, lds, A5, A2, (float*)(ws + WS_GW), GMS, GML, A3, NVEC, IFG, GZ, GM, GE, (const float*)(ws + WS_HBQ), a.in[11] + l * 8192, a.in[12] + l * 2048); break;
    case S_OUT: mlstm_out_phase(mk_tid, lds, A6, A5, A2, A3, NVEC, A1, GZ, GM, GE, GMS, a.in[14] + l * 1024, 0, (const float*)(ws + WS_HBQ), a.in[11] + l * 8192, a.in[12] + l * 2048); break;
    case S_RG0: case S_RG1:
        if (sub == S_RG0) { cvt_set(mk_tid, lds, a, l, 1); __syncthreads(); }
        rglru_phase(mk_tid, lds, A1, A2, a.in[4] + l * 4096, a.in[5] + l * 1024, a.in[6] + l * 65536, a.in[7] + l * 1024, a.in[8] + l * 65536, a.in[9] + l * 1024, a.in[10] + l * 1024, A5, sub - S_RG0, (float*)(ws + WS_SUMA), (float*)(ws + WS_SUMH)); break;
    case S_GQKV: {
        Gemm g; g.A = A1; g.Bt = WT; g.M = T; g.N = 1024; g.K = 1024;
        UE eq = ue_bf16(A0, 1024, 0); eq.ss = SS + (size_t)(l * 3 + 1) * T; eq.smode = 1;
        StaticOrder S; S.init(T, 1024, (int)gridDim.x, (int)blockIdx.x);
        for (int i = 0; ; ++i) { OneUnit O; if (!S.next(i, O.u)) break; __syncthreads();
            gemm_phase<UE, OneUnit, false>(mk_tid, lds, g, O, eq, nullptr);
            asm volatile("s_waitcnt vmcnt(0)" ::: "memory"); __syncthreads();
            int t2 = mk_tid; asm volatile("" : "+v"(t2));
            xattn_pair(t2, lds, A0, KMEM, VTM, A2, O.u.pm >> 3, O.u.pn, (O.u.pm & 7) * 2); }
    } break;
    case S_GUP: {
        cvt_set(mk_tid, lds, a, l, 3);
        Gemm g; g.A = A0; g.Bt = WT + 4 * MW; g.M = T; g.N = 6144; g.K = 1024;
        UE5 e5; e5.perm = 0; e5.act = A4; e5.HB = (float*)A1; e5.cw = a.in[24] + l * 18432; e5.cb = a.in[25] + l * 6144; e5.ss = SS + (size_t)(l * 3 + 2) * T;
        StaticOrder S; S.init(T, 6144, (int)gridDim.x, (int)blockIdx.x);
        for (int i = 0; ; ++i) { OneUnit O; if (!S.next(i, O.u)) break; __syncthreads(); gemm_phase<UE5, OneUnit, false>(mk_tid, lds, g, O, e5, nullptr); }
    } break;
    case S_GDOWN: {
        if (l == 0) cvt_set(mk_tid, lds, a, 1, 0);
        StaticOrder S; S.init(T, 1024, (int)gridDim.x, (int)blockIdx.x);
        for (int i = 0; ; ++i) { Unit u; if (!S.next(i, u)) break; ffn_fix_tile(mk_tid, (const float*)A1, a.in[24] + l * 18432, a.in[25] + l * 6144, A4, u.pm); }
        asm volatile("s_waitcnt vmcnt(0)" ::: "memory"); __syncthreads();
        resid_gemm(mk_tid, lds, a, l, 2, A4, WT + 11 * MW, 3072, (const float*)A0, A0, (l == 0) ? (u16*)a.out : nullptr, 1);
    } break;
    case S_GMIX: {
        resid_gemm(mk_tid, lds, a, l, 0, A0, WT + 10 * MW, 1024, (l == 0) ? a.in[0] : a.out, A1, nullptr, (l == 0) ? 0 : 1);
        const int G = (int)gridDim.x, blk = (int)blockIdx.x; int vb = blk, VG = G;
        if (G >= 96) { VG = G - 64; vb = (blk < 32 || (blk >= G - 64 && blk < G - 32)) ? -1 : (blk < G - 64 ? blk - 32 : blk - 64); }
        __syncthreads(); cvt_set(mk_tid, lds, a, l, 2, vb, VG);
    } break;
    case S_GWO: resid_gemm(mk_tid, lds, a, l, 1, A2, WT + 3 * MW, 1024, (const float*)A1, A0, nullptr, 1); break;
    default: break;
    }
}

__global__ void __launch_bounds__(512, 2) mk_fwd(Args a) {
    extern __shared__ __attribute__((aligned(16))) unsigned char shm[];
    LAS unsigned char* lds = (LAS unsigned char*)shm;
    cg::grid_group grid = cg::this_grid();
    if (a.ph_hi < 0) grid.sync();
    volatile LAS unsigned* xst = (volatile LAS unsigned*)(lds + LDS_BYTES - 16);
    if (threadIdx.x == 0) { xst[0] = 0u; xst[1] = 0u; }
    __syncthreads();
    const XcdBarrier xbar = xcd_barrier_post((unsigned*)(a.ws + WS_BAR), xst);
    int tid0 = threadIdx.x;
    for (int ph = a.ph_lo; ph < a.ph_hi; ++ph) {
        if (ph > a.ph_lo) xcd_barrier(xbar);
        asm volatile("" : "+v"(tid0)); const int mk_tid = tid0;
        if (ph == 0) { init_phase(mk_tid, lds, a); continue; }
        if (ph == NPH - 1) { final_norm(mk_tid, (const u16*)a.ws, a.out, a.in[28]); continue; }
        const int l = (ph - 1) / PL, sub = (ph - 1) % PL;
        const int ng = gemm_count(sub);
        other_phase(mk_tid, lds, a, l, sub);
#if PROBE_DUP
        { const int bit = (sub == S_GQK || sub == S_GUP) ? 2 : (sub == S_STATE) ? 4 : (sub == S_RG0 || sub == S_RG1) ? 8 : (0) ? 16 : (sub == S_GDOWN) ? 32 : 0;
          if (PROBE_DUP & bit) { __syncthreads(); other_phase(mk_tid, lds, a, l, sub); } }
        if (PROBE_DUP & 128) xcd_barrier(xbar);
        if (PROBE_DUP & 1) for (int i = 0; i < ng; ++i) {
            GD d = get_gd(a, l, sub, i); d.e.kind = 4;
            __syncthreads();
            Gemm g; g.A = d.A; g.Bt = d.Bt; g.M = d.M; g.N = d.N; g.K = d.K;
            StaticOrder S; S.init(d.M, d.N, (int)gridDim.x, (int)((blockIdx.x + d.cshift) % gridDim.x));
            gemm_phase<UE, StaticOrder, false>(mk_tid, lds, g, S, d.e, nullptr);
        }
#endif
        for (int i = 0; i < ng; ++i) {
            GD d = get_gd(a, l, sub, i);
            __syncthreads();
            Gemm g; g.A = d.A; g.Bt = d.Bt; g.M = d.M; g.N = d.N; g.K = d.K;
            StaticOrder S; S.init(d.M, d.N, (int)gridDim.x, (int)((blockIdx.x + d.cshift) % gridDim.x));
            gemm_phase<UE, StaticOrder, false>(mk_tid, lds, g, S, d.e, nullptr);
        }
    }
}

extern "C" void kernel_launch(void* const* d_in, const int* in_sizes, int n_in, void* d_out, int out_size, void* d_ws, size_t ws_size, hipStream_t stream) {
    static int grid = 0;
    if (grid == 0) {
        if (n_in != 29 || out_size != T * 1024 || ws_size < WS_END) { fprintf(stderr, "kernel_launch: unexpected shapes (n_in %d out %d ws %zu need %zu)\n", n_in, out_size, ws_size, (size_t)WS_END); grid = -1; return; }
        int dev = 0, cus = 0, per_cu = 0;
        hipGetDevice(&dev); hipDeviceGetAttribute(&cus, hipDeviceAttributeMultiprocessorCount, dev);
        hipFuncSetAttribute((const void*)mk_fwd, hipFuncAttributeMaxDynamicSharedMemorySize, LDS_BYTES);
        hipOccupancyMaxActiveBlocksPerMultiprocessor(&per_cu, (const void*)mk_fwd, 512, LDS_BYTES);
        if (per_cu < 1) per_cu = 1;
        grid = cus * per_cu;
        (void)hipGetLastError();
    }
    if (grid < 0) return;
    Args a{};
    for (int i = 0; i < 29; ++i) a.in[i] = (const float*)d_in[i];
    a.out = (float*)d_out; a.ws = (unsigned char*)d_ws;
#if defined(MK_PER_PHASE)
    for (int ph = 0; ph < NPH; ++ph) { a.ph_lo = ph; a.ph_hi = ph + 1; hipLaunchKernelGGL(mk_fwd, dim3(grid), dim3(512), LDS_BYTES, stream, a); }
#else
    a.ph_lo = 0; a.ph_hi = NPH;
    (void)hipMemsetAsync((unsigned char*)d_ws + WS_BAR, 0, 16384, stream);
    void* args[] = {&a};
    hipError_t e = hipLaunchCooperativeKernel((void*)mk_fwd, dim3(grid), dim3(512), args, LDS_BYTES, stream);
    if (e != hipSuccess) fprintf(stderr, "cooperative launch failed: %s (grid %d)\n", hipGetErrorString(e), grid);
#endif
}
```

```cpp
#include <hip/hip_runtime.h>
#include <hip/hip_cooperative_groups.h>
#include <cstdio>
namespace cg = cooperative_groups;
namespace pg8 {
#define PG8_LAS __attribute__((address_space(3)))
typedef unsigned short bf16_t;
typedef short bf16x8 __attribute__((ext_vector_type(8)));
typedef float f32x4 __attribute__((ext_vector_type(4)));
typedef unsigned u32x4 __attribute__((ext_vector_type(4)));
constexpr int BM = 256, BK = 64, HALF = 128, HTB = HALF * BK * 2  , STAGE_BYTES = 8 * HTB, NXCD = 8, WGM = 8;

__host__ __device__ __forceinline__ int lds_byte(int r, int c) { const int st = (r >> 4) * 2 + (c >> 5), rr = r & 15, cc = c & 31, ob = rr * 64 + cc * 2; return st * 1024 + (ob ^ (((ob >> 9) & 1) << 5)); }
__host__ __device__ __forceinline__ void stage_rc(int b, int& R, int& C) { const int st = b / 1024, sb = b % 1024, swz = sb ^ (((sb >> 9) & 1) << 5); R = (st >> 1) * 16 + swz / 64; C = (st & 1) * 32 + (swz % 64) / 2; }
__host__ __device__ __forceinline__ int perm32(int rho) { const int n = rho >> 4, i = rho & 15; return 8 * (i >> 2) + 4 * n + (i & 3); }

struct Unit { int pm, pn; };
struct Gemm { const bf16_t* A; const bf16_t* Bt; int M, N, K; };

struct StaticOrder {
    int nM, nN, nwg, G, c;
    __host__ __device__ void init(int M, int N, int G_, int c_) { nM = M / BM; nN = N / BM; nwg = nM * nN; G = G_; c = c_; }
    __host__ __device__ bool next(int i, Unit& u) const {
        const long L = (long)i * G + c; if (L >= nwg) return false;
        int wgid = (int)L; { const int q = nwg / NXCD, r = nwg % NXCD, xcd = wgid % NXCD, off = wgid / NXCD; wgid = (xcd < r ? xcd * (q + 1) : r * (q + 1) + (xcd - r) * q) + off; }
        const int nig = WGM * nN, gid = wgid / nig, fm = gid * WGM, gsz = (nM - fm) < WGM ? (nM - fm) : WGM;
        u.pm = fm + ((wgid % nig) % gsz); u.pn = (wgid % nig) / gsz; return true;
    }
    __device__ __forceinline__ void a_ready(const Unit&) const {}
    __device__ __forceinline__ void done(const Unit&) const {}
};
__device__ __forceinline__ unsigned cvt_pk_bf16(float lo, float hi) { unsigned r; asm volatile("v_cvt_pk_bf16_f32 %0, %1, %2" : "=v"(r) : "v"(lo), "v"(hi)); return r; }
typedef float f32x2 __attribute__((ext_vector_type(2)));
template <class Epi, class Sched, bool STAMP = false>
__device__ __forceinline__ void gemm_phase(int mk_tid, PG8_LAS unsigned char* lds, const Gemm g, const Sched& S, const Epi& E, unsigned long long* stamps) {
    const int tid = mk_tid, wid = __builtin_amdgcn_readfirstlane(tid >> 6), lane = tid & 63, wr = wid >> 2, wc = wid & 3, fr = lane & 15, fq = lane >> 4;
    const int K = g.K, nt = K / BK;
    int ts_lo = 0, ts_hi = 0, nts = 0; const unsigned long long rt_entry = STAMP ? (unsigned long long)wall_clock64() : 0ull;
#define PG8_STAMP() do { if (STAMP && wid == 0 && nts < 64) { const unsigned long long _c = (unsigned long long)clock64(); \
        ts_lo = (lane == nts) ? (int)(unsigned)_c : ts_lo; ts_hi = (lane == nts) ? (int)(unsigned)(_c >> 32) : ts_hi; ++nts; } } while (0)
    PG8_STAMP();
    unsigned voffA[2], voffB[2];
#pragma unroll
    for (int i = 0; i < 2; ++i) { int R, C; stage_rc(tid * 16 + i * 8192, R, C); const int Rb = E.perm ? ((R & ~31) + perm32(R & 31)) : R;
        voffA[i] = (unsigned)(R * K + C) * 2u; voffB[i] = (unsigned)(Rb * K + C) * 2u; }
    const size_t kstep = (size_t)(BK * 2);
    const size_t hstep = (size_t)HALF * K * 2;
    const size_t tstep = 2 * hstep;
    const unsigned ldsw = (unsigned)wid * 1024u;
    const int aoff = lds_byte(wr * 64 + fr, fq * 8), boff = lds_byte(wc * 32 + fr, fq * 8);
#define PG8_SA(b, h) (((b) * 2 + (h)) * HTB)
#define PG8_SB(b, h) ((4 + (b) * 2 + (h)) * HTB)
#define PG8_STAGE(bufoff, gbase, voff) do { _Pragma("unroll") for (int _i = 0; _i < 2; ++_i) \
        __builtin_amdgcn_global_load_lds((const unsigned*)((const char*)(gbase) + (voff)[_i]), (PG8_LAS unsigned*)(lds + (bufoff) + ldsw + _i * 8192), 16, 0, 0); } while (0)
#define PG8_LDA(dst, b, h) do { _Pragma("unroll") for (int m = 0; m < 4; ++m) _Pragma("unroll") for (int k = 0; k < 2; ++k) dst[m][k] = *(const PG8_LAS bf16x8*)(lds + PG8_SA(b, h) + aoff + m * 2048 + k * 1024); } while (0)
#define PG8_LDB(dst, b, h) do { _Pragma("unroll") for (int n = 0; n < 2; ++n) _Pragma("unroll") for (int k = 0; k < 2; ++k) dst[n][k] = *(const PG8_LAS bf16x8*)(lds + PG8_SB(b, h) + boff + n * 2048 + k * 1024); } while (0)
#define PG8_MMA(ai, bj, At, Bt) do { __builtin_amdgcn_s_setprio(1); _Pragma("unroll") for (int m = 0; m < 4; ++m) _Pragma("unroll") for (int n = 0; n < 2; ++n) _Pragma("unroll") for (int k = 0; k < 2; ++k) \
        acc[ai][bj][m][n] = __builtin_amdgcn_mfma_f32_16x16x32_bf16(Bt[n][k], At[m][k], acc[ai][bj][m][n], 0, 0, 0); __builtin_amdgcn_s_setprio(0); } while (0)
#define PG8_WAIT_V(n) asm volatile("s_waitcnt vmcnt(" #n ")" ::: "memory")
#define PG8_WAIT_L(n) asm volatile("s_waitcnt lgkmcnt(" #n ")" ::: "memory")
#define PG8_BAR __builtin_amdgcn_s_barrier()
#define PG8_SCHED __builtin_amdgcn_sched_barrier(0)
    Unit cur, nxt; int ui = 0;
    if (!S.next(0, cur)) return;
    f32x4 acc[2][2][4][2];
#pragma unroll
    for (int a = 0; a < 2; ++a)
#pragma unroll
        for (int b = 0; b < 2; ++b)
#pragma unroll
            for (int m = 0; m < 4; ++m)
#pragma unroll
                for (int n = 0; n < 2; ++n) acc[a][b][m][n] = (f32x4){0.f, 0.f, 0.f, 0.f};
    bf16x8 At[4][2], B0[2][2], B1[2][2];
    const char* cA = (const char*)g.A + (size_t)cur.pm * tstep; const char* cB = (const char*)g.Bt + (size_t)cur.pn * tstep;
    S.a_ready(cur);
    PG8_STAGE(PG8_SB(0, 0), cB, voffB); PG8_STAGE(PG8_SA(0, 0), cA, voffA); PG8_STAGE(PG8_SB(0, 1), cB + hstep, voffB); PG8_STAGE(PG8_SA(0, 1), cA + hstep, voffA);
    if (wr == 1) PG8_BAR;
    PG8_WAIT_V(4); PG8_BAR;
    PG8_STAGE(PG8_SB(1, 0), cB + kstep, voffB); PG8_STAGE(PG8_SA(1, 0), cA + kstep, voffA); PG8_STAGE(PG8_SB(1, 1), cB + hstep + kstep, voffB);
    PG8_WAIT_V(6); PG8_BAR;
    PG8_STAMP();
    for (;;) {
        const bool has_next = S.next(ui + 1, nxt);
        const char* nA = has_next ? (const char*)g.A + (size_t)nxt.pm * tstep : cA; const char* nB = has_next ? (const char*)g.Bt + (size_t)nxt.pn * tstep : cB;
        for (int t = 0; t < nt; t += 2) {
            const bool last = (t == nt - 2);
            const char* a1 = cA + (size_t)(t + 1) * kstep;
            const char* a2 = last ? nA : cA + (size_t)(t + 2) * kstep; const char* b2 = last ? nB : cB + (size_t)(t + 2) * kstep;
            const char* a3 = a2 + kstep; const char* b3 = b2 + kstep;
            if (last && has_next) S.a_ready(nxt);
            PG8_LDB(B0, 0, 0); PG8_SCHED; PG8_LDA(At, 0, 0); PG8_STAGE(PG8_SA(1, 1), a1 + hstep, voffA);
            PG8_WAIT_L(8); PG8_BAR; PG8_WAIT_L(0); PG8_MMA(0, 0, At, B0); PG8_BAR; PG8_SCHED;
            PG8_LDB(B1, 0, 1); PG8_STAGE(PG8_SB(0, 0), b2, voffB);
            PG8_BAR; PG8_WAIT_L(0); PG8_MMA(0, 1, At, B1); PG8_BAR;
            PG8_LDA(At, 0, 1); PG8_STAGE(PG8_SA(0, 0), a2, voffA);
            PG8_BAR; PG8_WAIT_L(0); PG8_MMA(1, 0, At, B0); PG8_BAR; PG8_SCHED;
            PG8_STAGE(PG8_SB(0, 1), b2 + hstep, voffB);
            PG8_WAIT_V(6); PG8_BAR; PG8_MMA(1, 1, At, B1); PG8_BAR;
            PG8_LDB(B0, 1, 0); PG8_SCHED; PG8_LDA(At, 1, 0); PG8_STAGE(PG8_SA(0, 1), a2 + hstep, voffA);
            PG8_WAIT_L(8); PG8_BAR; PG8_WAIT_L(0); PG8_MMA(0, 0, At, B0); PG8_BAR; PG8_SCHED;
            PG8_LDB(B1, 1, 1); PG8_STAGE(PG8_SB(1, 0), b3, voffB);
            PG8_BAR; PG8_WAIT_L(0); PG8_MMA(0, 1, At, B1); PG8_BAR;
            PG8_LDA(At, 1, 1); PG8_STAGE(PG8_SA(1, 0), a3, voffA);
            PG8_BAR; PG8_WAIT_L(0); PG8_MMA(1, 0, At, B0); PG8_BAR; PG8_SCHED;
            PG8_STAGE(PG8_SB(1, 1), b3 + hstep, voffB);
            PG8_WAIT_V(6); PG8_BAR; PG8_MMA(1, 1, At, B1); PG8_BAR;
        }
        PG8_STAMP();
        if constexpr (!Epi::AFTER_DRAIN) { E(acc, cur, wr, wc, fr, fq); S.done(cur); }
        PG8_STAMP();
        if (!has_next) break;
#pragma unroll
        for (int a = 0; a < 2; ++a)
#pragma unroll
            for (int b = 0; b < 2; ++b)
#pragma unroll
                for (int m = 0; m < 4; ++m)
#pragma unroll
                    for (int n = 0; n < 2; ++n) acc[a][b][m][n] = (f32x4){0.f, 0.f, 0.f, 0.f};
        cur = nxt; cA = nA; cB = nB; ++ui;
    }
    PG8_WAIT_V(0);
    if (wr == 0) PG8_BAR;
    PG8_BAR;

    if constexpr (Epi::AFTER_DRAIN) { E.fused(acc, cur, wr, wc, fr, fq, lds, wid, lane); }
    PG8_STAMP();
    if (STAMP && wid == 0) { stamps[lane] = lane < nts ? (((unsigned long long)(unsigned)ts_hi << 32) | (unsigned)ts_lo) : 0ull;
        if (lane == 62) stamps[62] = rt_entry; if (lane == 63) stamps[63] = (unsigned long long)wall_clock64(); }
#undef PG8_STAMP
#undef PG8_SA
#undef PG8_SB
#undef PG8_STAGE
#undef PG8_LDA
#undef PG8_LDB
#undef PG8_MMA
#undef PG8_WAIT_V
#undef PG8_WAIT_L
#undef PG8_BAR
#undef PG8_SCHED
}
}

using namespace pg8;
#define DI __device__ __forceinline__
#define LAS PG8_LAS
typedef unsigned short u16;
typedef unsigned u32x2 __attribute__((ext_vector_type(2)));
typedef short s16x4 __attribute__((ext_vector_type(4)));

constexpr int T = 16384, SEQ = 2048;
constexpr int LDS_BYTES = 147456;
constexpr size_t U = (size_t)T * 1024 * 2;
constexpr size_t WS_WT = 7 * U;
constexpr size_t WS_MEMN = WS_WT + (size_t)14336 * 2048;
constexpr size_t WS_SS = WS_MEMN + 4194304;
constexpr size_t WS_SSP = WS_SS + (size_t)7 * T * 4;
constexpr size_t WS_CNT = WS_SSP + (size_t)T * 16 * 4;
constexpr size_t WS_IFG = WS_CNT + 4096;
constexpr size_t WS_GZ = WS_IFG + (size_t)T * 8 * 4;
constexpr size_t WS_GM = WS_GZ + 262144;
constexpr size_t WS_GE = WS_GM + 262144;
constexpr size_t WS_GMS = WS_GE + 262144;
constexpr size_t WS_GML = WS_GMS + 2048;
constexpr size_t WS_NVEC = WS_GML + 2048;
constexpr size_t WS_GW = WS_NVEC + 524288;
constexpr size_t WS_SUMA = WS_GW + 262144;
constexpr size_t WS_SUMH = WS_SUMA + 524288;
constexpr size_t WS_BAR = WS_SUMH + 524288;
constexpr size_t WS_HBQ = WS_BAR + 16384;
constexpr size_t WS_END = WS_HBQ + (size_t)64 * 6 * 2048 * 4;
enum { S_GQK = 0, S_STATE, S_OUT, S_GXR, S_RG0, S_RG1, S_GAB, S_GMIX, S_GQKV, S_GWO, S_GUP, S_GDOWN, PL };
constexpr int NPH = 2 * PL + 2;
#ifndef PROBE_DUP
#define PROBE_DUP 0
#endif

struct Args { const float* in[29]; float* out; unsigned char* ws; int ph_lo, ph_hi; };

DI float bf2f(u16 v) { return __uint_as_float(((unsigned)v) << 16); }
DI float bflo(unsigned v) { return __uint_as_float(v << 16); }
DI float bfhi(unsigned v) { return __uint_as_float(v & 0xffff0000u); }
DI u16 f2bf(float f) { unsigned r; asm("v_cvt_pk_bf16_f32 %0, %1, %1" : "=v"(r) : "v"(f)); return (u16)r; }
DI unsigned pk2(float lo, float hi) { unsigned r; asm("v_cvt_pk_bf16_f32 %0, %1, %2" : "=v"(r) : "v"(lo), "v"(hi)); return r; }
DI float sigm(float x) { return __builtin_amdgcn_rcpf(1.f + __expf(-x)); }
DI float gelu_t(float x) { const float u = 1.5957691216f * (x + 0.044715f * x * x * x); return x * __builtin_amdgcn_rcpf(1.f + __expf(-u)); }
DI float wsum(float v) { v += __shfl_xor(v, 1); v += __shfl_xor(v, 2); v += __shfl_xor(v, 4); v += __shfl_xor(v, 8); v += __shfl_xor(v, 16); v += __shfl_xor(v, 32); return v; }
DI void unpack8(const u32x4 r, float* f) { f[0] = bflo(r.x); f[1] = bfhi(r.x); f[2] = bflo(r.y); f[3] = bfhi(r.y); f[4] = bflo(r.z); f[5] = bfhi(r.z); f[6] = bflo(r.w); f[7] = bfhi(r.w); }
DI f32x4 mfma16(bf16x8 a, bf16x8 b, f32x4 c) { return __builtin_amdgcn_mfma_f32_16x16x32_bf16(a, b, c, 0, 0, 0); }

struct UE {
    static constexpr bool AFTER_DRAIN = false;
    int perm, kind; u16* O; int ldc, split; const u16* gate; float* F; const float* Fin; const float* ss; int smode; u16* HBo; float* sso; float* ssp; unsigned* cnt; int rflags;
    DI void operator()(const f32x4 (&acc)[2][2][4][2], const Unit& u, int wr, int wc, int fr, int fq) const {
        const int row0 = u.pm * 256 + wr * 64 + fr;
        if (kind == 4) return;
        const int col0 = u.pn * 256 + wc * 32 + 8 * fq;
        if (kind == 0) {
            float rs[2][4]; f32x4 cf[2][2];
#pragma unroll
            for (int ai = 0; ai < 2; ++ai)
#pragma unroll
                for (int m = 0; m < 4; ++m) rs[ai][m] = (smode == 1) ? ss[row0 + ai * 128 + m * 16] : 1024.f - 1e-6f * 1024.f;
#pragma unroll
            for (int bj = 0; bj < 2; ++bj)
#pragma unroll
                for (int n = 0; n < 2; ++n) cf[bj][n] = (smode == 2) ? *(const f32x4*)(ss + col0 + bj * 128 + n * 4) : (f32x4){1024.f - 1e-6f * 1024.f, 1024.f - 1e-6f * 1024.f, 1024.f - 1e-6f * 1024.f, 1024.f - 1e-6f * 1024.f};
#pragma unroll
            for (int ai = 0; ai < 2; ++ai)
#pragma unroll
                for (int m = 0; m < 4; ++m) rs[ai][m] = rsqrtf(rs[ai][m] * (1.f / 1024.f) + 1e-6f);
#pragma unroll
            for (int bj = 0; bj < 2; ++bj)
#pragma unroll
                for (int n = 0; n < 2; ++n)
#pragma unroll
                    for (int j = 0; j < 4; ++j) cf[bj][n][j] = rsqrtf(cf[bj][n][j] * (1.f / 1024.f) + 1e-6f);
            __builtin_amdgcn_sched_barrier(0);
#pragma unroll
            for (int ai = 0; ai < 2; ++ai)
#pragma unroll
                for (int m = 0; m < 4; ++m) { const int row = row0 + ai * 128 + m * 16;
#pragma unroll
                    for (int bj = 0; bj < 2; ++bj) { const int col = col0 + bj * 128;
                        u16* p = split ? O + (size_t)(col >> 10) * ((size_t)T * 1024) + (size_t)row * 1024 + (col & 1023) : O + (size_t)row * ldc + col;
                        const f32x4 v0 = acc[ai][bj][m][0] * rs[ai][m] * cf[bj][0], v1 = acc[ai][bj][m][1] * rs[ai][m] * cf[bj][1];
                        u32x4 w; w.x = cvt_pk_bf16(v0[0], v0[1]); w.y = cvt_pk_bf16(v0[2], v0[3]); w.z = cvt_pk_bf16(v1[0], v1[1]); w.w = cvt_pk_bf16(v1[2], v1[3]);
                        *(u32x4*)p = w; } }
        } else {
#pragma unroll
            for (int aim = 0; aim < 4; ++aim) { const int ai = aim >> 1, mb = (aim & 1) * 2;
                f32x4 ld[4][2][2];
#pragma unroll
                for (int m = mb; m < mb + 2; ++m)
#pragma unroll
                    for (int bj = 0; bj < 2; ++bj) { const size_t idx = (size_t)(row0 + ai * 128 + m * 16) * 1024 + col0 + bj * 128;
                        if (kind == 3) { if (rflags & 1) { ld[m][bj][0] = *(const f32x4*)((const u16*)Fin + idx); ld[m][bj][1] = (f32x4){0.f, 0.f, 0.f, 0.f}; } else { ld[m][bj][0] = *(const f32x4*)(Fin + idx); ld[m][bj][1] = *(const f32x4*)(Fin + idx + 4); } }
                        else { ld[m][bj][0] = *(const f32x4*)(gate + idx); ld[m][bj][1] = (kind == 2) ? *(const f32x4*)((const u16*)Fin + idx) : (f32x4){0.f, 0.f, 0.f, 0.f}; } }
                __builtin_amdgcn_sched_barrier(0);
#pragma unroll
                for (int m = mb; m < mb + 2; ++m) { const int row = row0 + ai * 128 + m * 16; float psq = 0.f;
#pragma unroll
                    for (int bj = 0; bj < 2; ++bj) { const size_t idx = (size_t)row * 1024 + col0 + bj * 128; const f32x4 v0 = acc[ai][bj][m][0], v1 = acc[ai][bj][m][1];
                        if (kind == 3) { f32x4 b0 = ld[m][bj][0], b1 = ld[m][bj][1];
                            if (rflags & 1) { const u32x4 rb = __builtin_bit_cast(u32x4, ld[m][bj][0]); b0 = (f32x4){bflo(rb.x), bfhi(rb.x), bflo(rb.y), bfhi(rb.y)}; b1 = (f32x4){bflo(rb.z), bfhi(rb.z), bflo(rb.w), bfhi(rb.w)}; }
                            const f32x4 h0 = b0 + v0, h1 = b1 + v1; if (rflags & 2) { *(f32x4*)(F + idx) = h0; *(f32x4*)(F + idx + 4) = h1; }
                            u32x4 hw; hw.x = cvt_pk_bf16(h0[0], h0[1]); hw.y = cvt_pk_bf16(h0[2], h0[3]); hw.z = cvt_pk_bf16(h1[0], h1[1]); hw.w = cvt_pk_bf16(h1[2], h1[3]); *(u32x4*)(HBo + idx) = hw;
                            psq += (h0[0] * h0[0] + h0[1] * h0[1]) + (h0[2] * h0[2] + h0[3] * h0[3]) + (h1[0] * h1[0] + h1[1] * h1[1]) + (h1[2] * h1[2] + h1[3] * h1[3]); }
                        else { const u32x4 gr = __builtin_bit_cast(u32x4, ld[m][bj][0]);
                            f32x4 s0, s1; s0[0] = sigm(bflo(gr.x)); s0[1] = sigm(bfhi(gr.x)); s0[2] = sigm(bflo(gr.y)); s0[3] = sigm(bfhi(gr.y)); s1[0] = sigm(bflo(gr.z)); s1[1] = sigm(bfhi(gr.z)); s1[2] = sigm(bflo(gr.w)); s1[3] = sigm(bfhi(gr.w));
                            f32x4 r0 = s0 * v0, r1 = s1 * v1;
                            if (kind == 2) { const u32x4 yb = __builtin_bit_cast(u32x4, ld[m][bj][1]);
                                r0[0] += bflo(yb.x); r0[1] += bfhi(yb.x); r0[2] += bflo(yb.y); r0[3] += bfhi(yb.y); r1[0] += bflo(yb.z); r1[1] += bfhi(yb.z); r1[2] += bflo(yb.w); r1[3] += bfhi(yb.w); }
                            u32x4 w; w.x = cvt_pk_bf16(r0[0], r0[1]); w.y = cvt_pk_bf16(r0[2], r0[3]); w.z = cvt_pk_bf16(r1[0], r1[1]); w.w = cvt_pk_bf16(r1[2], r1[3]);
                            *(u32x4*)(O + idx) = w; } }
                    if (kind == 3) { psq += __shfl_xor(psq, 16); psq += __shfl_xor(psq, 32); if (fq == 0) __hip_atomic_store(ssp + (size_t)row * 16 + u.pn * 4 + wc, psq, __ATOMIC_RELAXED, __HIP_MEMORY_SCOPE_AGENT); } }
                __builtin_amdgcn_sched_barrier(0);
            }
            if (kind == 3) {
                asm volatile("s_waitcnt vmcnt(0)" ::: "memory");
                const int lane = fq * 16 + fr; unsigned old = 0u;
                if (lane == 0) old = __hip_atomic_fetch_add(cnt + u.pm, 1u, __ATOMIC_RELAXED, __HIP_MEMORY_SCOPE_AGENT);
                old = (unsigned)__builtin_amdgcn_readfirstlane((int)old);
                if (old == 31u) {
                    for (int r = lane; r < 256; r += 64) { const size_t row = (size_t)u.pm * 256 + r; float t = 0.f;
#pragma unroll 4
                        for (int k = 0; k < 16; ++k) t += __hip_atomic_load(ssp + row * 16 + k, __ATOMIC_RELAXED, __HIP_MEMORY_SCOPE_AGENT);
                        sso[row] = t; } }
            }
        }
    }
};
struct UE3 {
    static constexpr bool AFTER_DRAIN = true;
    int perm; const float* Fin; float* F; u16* HBo; u16* HB2; float* sso; float* ssp; unsigned* cnt; int rflags;
    DI void operator()(const f32x4 (&)[2][2][4][2], const Unit&, int, int, int, int) const {}
    DI void fused(const f32x4 (&acc)[2][2][4][2], const Unit& u, int wr, int wc, int fr, int fq, LAS unsigned char* lds, int wid, int lane) const {
        LAS float* P = (LAS float*)lds;
        LAS unsigned* flag = (LAS unsigned*)(lds + 8192);
        const int tid = wid * 64 + lane, row0 = u.pm * 256 + wr * 64 + fr, col0 = u.pn * 256 + wc * 32 + 8 * fq;
#pragma unroll
        for (int aim = 0; aim < 4; ++aim) { const int ai = aim >> 1, mb = (aim & 1) * 2;
            f32x4 ld[4][2][2];
#pragma unroll
            for (int m = mb; m < mb + 2; ++m)
#pragma unroll
                for (int bj = 0; bj < 2; ++bj) { const size_t idx = (size_t)(row0 + ai * 128 + m * 16) * 1024 + col0 + bj * 128;
                    if (rflags & 1) { ld[m][bj][0] = *(const f32x4*)((const u16*)Fin + idx); ld[m][bj][1] = (f32x4){0.f, 0.f, 0.f, 0.f}; } else { ld[m][bj][0] = *(const f32x4*)(Fin + idx); ld[m][bj][1] = *(const f32x4*)(Fin + idx + 4); } }
            __builtin_amdgcn_sched_barrier(0);
#pragma unroll
            for (int m = mb; m < mb + 2; ++m) { const int row = row0 + ai * 128 + m * 16; float psq = 0.f;
#pragma unroll
                for (int bj = 0; bj < 2; ++bj) { const size_t idx = (size_t)row * 1024 + col0 + bj * 128; const f32x4 v0 = acc[ai][bj][m][0], v1 = acc[ai][bj][m][1];
                    f32x4 b0 = ld[m][bj][0], b1 = ld[m][bj][1];
                    if (rflags & 1) { const u32x4 rb = __builtin_bit_cast(u32x4, ld[m][bj][0]); b0 = (f32x4){bflo(rb.x), bfhi(rb.x), bflo(rb.y), bfhi(rb.y)}; b1 = (f32x4){bflo(rb.z), bfhi(rb.z), bflo(rb.w), bfhi(rb.w)}; }
                    const f32x4 h0 = b0 + v0, h1 = b1 + v1; if (rflags & 2) { *(f32x4*)(F + idx) = h0; *(f32x4*)(F + idx + 4) = h1; }
                    u32x4 hw; hw.x = cvt_pk_bf16(h0[0], h0[1]); hw.y = cvt_pk_bf16(h0[2], h0[3]); hw.z = cvt_pk_bf16(h1[0], h1[1]); hw.w = cvt_pk_bf16(h1[2], h1[3]); *(u32x4*)(HBo + idx) = hw; if (HB2) *(u32x4*)(HB2 + idx) = hw;
                    psq += (h0[0] * h0[0] + h0[1] * h0[1]) + (h0[2] * h0[2] + h0[3] * h0[3]) + (h1[0] * h1[0] + h1[1] * h1[1]) + (h1[2] * h1[2] + h1[3] * h1[3]); }
                psq += __shfl_xor(psq, 16); psq += __shfl_xor(psq, 32);
                if (fq == 0) P[(ai * 128 + wr * 64 + m * 16 + fr) * 4 + wc] = psq; }
            __builtin_amdgcn_sched_barrier(0);
        }
        __syncthreads();
        if (tid < 256) { const float t = (P[tid * 4] + P[tid * 4 + 1]) + (P[tid * 4 + 2] + P[tid * 4 + 3]); __hip_atomic_store(ssp + ((size_t)u.pm * 256 + tid) * 4 + u.pn, t, __ATOMIC_RELAXED, __HIP_MEMORY_SCOPE_AGENT); }
        asm volatile("s_waitcnt vmcnt(0)" ::: "memory");
        __syncthreads();
        if (tid == 0) flag[0] = __hip_atomic_fetch_add(cnt + u.pm, 1u, __ATOMIC_RELAXED, __HIP_MEMORY_SCOPE_AGENT);
        __syncthreads();
        if (flag[0] == 3u && tid < 256) { const size_t row = (size_t)u.pm * 256 + tid;
            const float t0 = __hip_atomic_load(ssp + row * 4, __ATOMIC_RELAXED, __HIP_MEMORY_SCOPE_AGENT), t1 = __hip_atomic_load(ssp + row * 4 + 1, __ATOMIC_RELAXED, __HIP_MEMORY_SCOPE_AGENT),
                        t2 = __hip_atomic_load(ssp + row * 4 + 2, __ATOMIC_RELAXED, __HIP_MEMORY_SCOPE_AGENT), t3 = __hip_atomic_load(ssp + row * 4 + 3, __ATOMIC_RELAXED, __HIP_MEMORY_SCOPE_AGENT);
            sso[row] = (t0 + t1) + (t2 + t3); }
        __syncthreads();
    }
};
struct OneUnit { Unit u; DI bool next(int i, Unit& o) const { if (i != 0) return false; o = u; return true; } DI void a_ready(const Unit&) const {} DI void done(const Unit&) const {} };
struct UE5 {
    static constexpr bool AFTER_DRAIN = true;
    int perm; u16* act; float* HB; const float* cw; const float* cb; const float* ss;
    DI void operator()(const f32x4 (&)[2][2][4][2], const Unit&, int, int, int, int) const {}
    DI void fused(const f32x4 (&acc)[2][2][4][2], const Unit& u, int wr, int wc, int fr, int fq, LAS unsigned char* lds, int wid, int lane) const {
        LAS float* tl = (LAS float*)lds;
        LAS float* side = (LAS float*)(lds + 133120);
        const int tid = wid * 64 + lane, q = tid & 31, rsub = tid >> 5, ch = u.pn * 128 + q * 4;
        const f32x4 g0 = *(const f32x4*)(cw + ch), g1 = *(const f32x4*)(cw + 6144 + ch), g2 = *(const f32x4*)(cw + 12288 + ch), gb = *(const f32x4*)(cb + ch);
        const f32x4 u0 = *(const f32x4*)(cw + 3072 + ch), u1 = *(const f32x4*)(cw + 6144 + 3072 + ch), u2 = *(const f32x4*)(cw + 12288 + 3072 + ch), ub = *(const f32x4*)(cb + 3072 + ch);
#pragma unroll
        for (int ai = 0; ai < 2; ++ai) {
            if (ai == 1) {
                __syncthreads();
            }
#pragma unroll
            for (int m = 0; m < 4; ++m) { const float rs = rsqrtf(ss[u.pm * 256 + ai * 128 + wr * 64 + m * 16 + fr] * (1.f / 1024.f) + 1e-6f);
#pragma unroll
                for (int bj = 0; bj < 2; ++bj)
#pragma unroll
                    for (int n = 0; n < 2; ++n) *(LAS f32x4*)(tl + (wr * 64 + m * 16 + fr) * 260 + bj * 128 + wc * 32 + n * 16 + 4 * fq) = acc[ai][bj][m][n] * rs; }
            __syncthreads();
            if (ai == 0) {
                if (tid < 128) { const int rr = tid >> 6, cq = tid & 63; const f32x4 v = *(const LAS f32x4*)(tl + rr * 260 + cq * 4);
                    *(f32x4*)(HB + ((size_t)u.pm * 4 + rr) * 6144 + (cq < 32 ? u.pn * 128 + cq * 4 : 3072 + u.pn * 128 + (cq - 32) * 4)) = v; }
            } else {
                if (tid < 128) { const int rr = tid >> 6, cq = tid & 63; const f32x4 v = *(const LAS f32x4*)(tl + (126 + rr) * 260 + cq * 4);
                    *(f32x4*)(HB + ((size_t)u.pm * 4 + 2 + rr) * 6144 + (cq < 32 ? u.pn * 128 + cq * 4 : 3072 + u.pn * 128 + (cq - 32) * 4)) = v; }
            }
#pragma unroll 2
            for (int it = 0; it < 8; ++it) {
                const int row = it * 16 + rsub;
                const f32x4 xg = *(const LAS f32x4*)(tl + row * 260 + q * 4), xu = *(const LAS f32x4*)(tl + row * 260 + 128 + q * 4);
                f32x4 p1g, p1u, p2g, p2u; bool ok = true;
                if (row >= 2) { p1g = *(const LAS f32x4*)(tl + (row - 1) * 260 + q * 4); p1u = *(const LAS f32x4*)(tl + (row - 1) * 260 + 128 + q * 4); p2g = *(const LAS f32x4*)(tl + (row - 2) * 260 + q * 4); p2u = *(const LAS f32x4*)(tl + (row - 2) * 260 + 128 + q * 4); }
                else if (ai == 1) {
                    if (row == 1) { p1g = *(const LAS f32x4*)(tl + q * 4); p1u = *(const LAS f32x4*)(tl + 128 + q * 4); p2g = *(const LAS f32x4*)(side + 260 + q * 4); p2u = *(const LAS f32x4*)(side + 260 + 128 + q * 4); }
                    else { p1g = *(const LAS f32x4*)(side + 260 + q * 4); p1u = *(const LAS f32x4*)(side + 260 + 128 + q * 4); p2g = *(const LAS f32x4*)(side + q * 4); p2u = *(const LAS f32x4*)(side + 128 + q * 4); }
                } else { ok = false; p1g = xg; p1u = xu; p2g = xg; p2u = xu; }
                const f32x4 gv = gb + g0 * p2g + g1 * p1g + g2 * xg, uv = ub + u0 * p2u + u1 * p1u + u2 * xu;
                if (ok) { u32x2 w; w.x = cvt_pk_bf16(gelu_t(gv[0]) * uv[0], gelu_t(gv[1]) * uv[1]); w.y = cvt_pk_bf16(gelu_t(gv[2]) * uv[2], gelu_t(gv[3]) * uv[3]);
                    *(u32x2*)(act + ((size_t)u.pm * 256 + ai * 128 + row) * 3072 + ch) = w; }
            }
            if (ai == 0) {
                if (tid < 128) { const int rr = tid >> 6, cq = tid & 63; *(LAS f32x4*)(side + rr * 260 + cq * 4) = *(const LAS f32x4*)(tl + (126 + rr) * 260 + cq * 4); }
            }
        }
        __syncthreads();
    }
};
DI void ffn_fix_tile(int mk_tid, const float* HB, const float* cw, const float* cb, u16* act, int pm) {
    for (int item = mk_tid; item < 2 * 768; item += 512) {
        const int cq = item % 768, j = item / 768, ch = cq * 4; const bool hp = (pm & 7) != 0;
        const f32x4 z4 = (f32x4){0.f, 0.f, 0.f, 0.f};
        const float* cur = HB + ((size_t)pm * 4 + j) * 6144 + ch; const float* f0 = HB + ((size_t)pm * 4) * 6144 + ch;
        const float* l0 = HB + ((size_t)(pm - 1) * 4 + 2) * 6144 + ch; const float* l1 = HB + ((size_t)(pm - 1) * 4 + 3) * 6144 + ch;
        const f32x4 xg = *(const f32x4*)cur, xu = *(const f32x4*)(cur + 3072);
        f32x4 p1g, p1u, p2g, p2u;
        if (j == 1) { p1g = *(const f32x4*)f0; p1u = *(const f32x4*)(f0 + 3072); p2g = hp ? *(const f32x4*)l1 : z4; p2u = hp ? *(const f32x4*)(l1 + 3072) : z4; }
        else { p1g = hp ? *(const f32x4*)l1 : z4; p1u = hp ? *(const f32x4*)(l1 + 3072) : z4; p2g = hp ? *(const f32x4*)l0 : z4; p2u = hp ? *(const f32x4*)(l0 + 3072) : z4; }
        const f32x4 wg0 = *(const f32x4*)(cw + ch), wg1 = *(const f32x4*)(cw + 6144 + ch), wg2 = *(const f32x4*)(cw + 12288 + ch), bg = *(const f32x4*)(cb + ch);
        const f32x4 wu0 = *(const f32x4*)(cw + 3072 + ch), wu1 = *(const f32x4*)(cw + 6144 + 3072 + ch), wu2 = *(const f32x4*)(cw + 12288 + 3072 + ch), bu = *(const f32x4*)(cb + 3072 + ch);
        const f32x4 gv = bg + wg0 * p2g + wg1 * p1g + wg2 * xg, uv = bu + wu0 * p2u + wu1 * p1u + wu2 * xu;
        u32x2 w; w.x = pk2(gelu_t(gv[0]) * uv[0], gelu_t(gv[1]) * uv[1]); w.y = pk2(gelu_t(gv[2]) * uv[2], gelu_t(gv[3]) * uv[3]);
        *(u32x2*)(act + ((size_t)pm * 256 + j) * 3072 + ch) = w;
    }
}

struct UE6 {
    static constexpr bool AFTER_DRAIN = true;
    int perm; u16* qc; u16* kc; float* HB; const float* cw; const float* cb; const float* ss;
    DI void operator()(const f32x4 (&)[2][2][4][2], const Unit&, int, int, int, int) const {}
    DI void fused(const f32x4 (&acc)[2][2][4][2], const Unit& u, int wr, int wc, int fr, int fq, LAS unsigned char* lds, int wid, int lane) const {
        LAS float* tl = (LAS float*)lds;
        LAS float* side = (LAS float*)(lds + 133120);
        const int tid = wid * 64 + lane, q = tid & 63, rsub = tid >> 6, ch = u.pn * 256 + q * 4;
        const f32x4 w0 = *(const f32x4*)(cw + ch), w1 = *(const f32x4*)(cw + 2048 + ch), w2 = *(const f32x4*)(cw + 4096 + ch), w3 = *(const f32x4*)(cw + 6144 + ch), bb = *(const f32x4*)(cb + ch);
        u16* dst = (ch < 1024) ? qc + ch : kc + (ch - 1024); const float sc = (ch < 1024) ? 1.f : 0.0625f;
#pragma unroll
        for (int ai = 0; ai < 2; ++ai) {
            if (ai == 1) __syncthreads();
#pragma unroll
            for (int m = 0; m < 4; ++m) { const float rs = rsqrtf(ss[u.pm * 256 + ai * 128 + wr * 64 + m * 16 + fr] * (1.f / 1024.f) + 1e-6f);
#pragma unroll
                for (int bj = 0; bj < 2; ++bj)
#pragma unroll
                    for (int n = 0; n < 2; ++n) *(LAS f32x4*)(tl + (wr * 64 + m * 16 + fr) * 260 + bj * 128 + wc * 32 + n * 16 + 4 * fq) = acc[ai][bj][m][n] * rs; }
            __syncthreads();
            if (tid < 192) { const int rr = tid >> 6, cq = tid & 63; const f32x4 v = *(const LAS f32x4*)(tl + ((ai == 0 ? 0 : 125) + rr) * 260 + cq * 4);
                *(f32x4*)(HB + ((size_t)u.pm * 6 + (ai == 0 ? 0 : 3) + rr) * 2048 + u.pn * 256 + cq * 4) = v; }
#pragma unroll 2
            for (int it = 0; it < 16; ++it) {
                const int row = it * 8 + rsub;
                const f32x4 x = *(const LAS f32x4*)(tl + row * 260 + q * 4);
                f32x4 p1, p2, p3; bool ok = true;
                if (row >= 3) { p1 = *(const LAS f32x4*)(tl + (row - 1) * 260 + q * 4); p2 = *(const LAS f32x4*)(tl + (row - 2) * 260 + q * 4); p3 = *(const LAS f32x4*)(tl + (row - 3) * 260 + q * 4); }
                else if (ai == 1) {
                    p1 = (row >= 1) ? *(const LAS f32x4*)(tl + (row - 1) * 260 + q * 4) : *(const LAS f32x4*)(side + 2 * 260 + q * 4);
                    p2 = (row >= 2) ? *(const LAS f32x4*)(tl + (row - 2) * 260 + q * 4) : *(const LAS f32x4*)(side + (1 + row) * 260 + q * 4);
                    p3 = *(const LAS f32x4*)(side + row * 260 + q * 4);
                } else { ok = false; p1 = x; p2 = x; p3 = x; }
                const f32x4 v = bb + w0 * p3 + w1 * p2 + w2 * p1 + w3 * x;
                if (ok) { u32x2 w; w.x = cvt_pk_bf16(sc * v[0] * sigm(v[0]), sc * v[1] * sigm(v[1])); w.y = cvt_pk_bf16(sc * v[2] * sigm(v[2]), sc * v[3] * sigm(v[3]));
                    *(u32x2*)(dst + ((size_t)u.pm * 256 + ai * 128 + row) * 1024) = w; }
            }
            if (ai == 0) { if (tid < 192) { const int rr = tid >> 6, cq = tid & 63; *(LAS f32x4*)(side + rr * 260 + cq * 4) = *(const LAS f32x4*)(tl + (125 + rr) * 260 + cq * 4); } }
        }
        __syncthreads();
    }
};
DI void qk_fix_local(int mk_tid, const float* HB, const float* cw, const float* cb, u16* dst, int chg, int pm0, int npm) {
    for (int item = mk_tid; item < npm * 3 * 64; item += 512) {
        const int cq = item & 63, rr = item >> 6, pmi = rr / 3, j = rr - pmi * 3, pm = pm0 + pmi, ch = chg + cq * 4; const bool hp = (pm & 7) != 0;
        const f32x4 z4 = (f32x4){0.f, 0.f, 0.f, 0.f};
        const float* me = HB + (size_t)pm * 6 * 2048 + ch; const float* pv = HB + (size_t)(pm - 1) * 6 * 2048 + ch;
        const f32x4 x = *(const f32x4*)(me + j * 2048);
        f32x4 p[3];
#pragma unroll
        for (int k = 1; k <= 3; ++k) { const int r = j - k; p[k - 1] = (r >= 0) ? *(const f32x4*)(me + r * 2048) : (hp ? *(const f32x4*)(pv + (6 + r) * 2048) : z4); }
        const f32x4 w0 = *(const f32x4*)(cw + ch), w1 = *(const f32x4*)(cw + 2048 + ch), w2 = *(const f32x4*)(cw + 4096 + ch), w3 = *(const f32x4*)(cw + 6144 + ch), bb = *(const f32x4*)(cb + ch);
        const f32x4 v = bb + w0 * p[2] + w1 * p[1] + w2 * p[0] + w3 * x;
        const float sc = (ch < 1024) ? 1.f : 0.0625f;
        u32x2 w; w.x = pk2(sc * v[0] * sigm(v[0]), sc * v[1] * sigm(v[1])); w.y = pk2(sc * v[2] * sigm(v[2]), sc * v[3] * sigm(v[3]));
        *(u32x2*)(dst + ((size_t)pm * 256 + j) * 1024 + (ch & 1023)) = w;
    }
}
DI void qk_fix_phase(int mk_tid, const float* HB, const float* cw, const float* cb, u16* qc, u16* kc) {
    const int gtid = blockIdx.x * 512 + mk_tid, nth = gridDim.x * 512;
    for (int item = gtid; item < 192 * 512; item += nth) {
        const int cq = item & 511, rr = item >> 9, pm = rr / 3, j = rr - pm * 3, ch = cq * 4; const bool hp = (pm & 7) != 0;
        const f32x4 z4 = (f32x4){0.f, 0.f, 0.f, 0.f};
        const float* me = HB + (size_t)pm * 6 * 2048 + ch; const float* pv = HB + (size_t)(pm - 1) * 6 * 2048 + ch;
        const f32x4 x = *(const f32x4*)(me + j * 2048);
        f32x4 p[3];
#pragma unroll
        for (int k = 1; k <= 3; ++k) { const int r = j - k; p[k - 1] = (r >= 0) ? *(const f32x4*)(me + r * 2048) : (hp ? *(const f32x4*)(pv + (6 + r) * 2048) : z4); }
        const f32x4 w0 = *(const f32x4*)(cw + ch), w1 = *(const f32x4*)(cw + 2048 + ch), w2 = *(const f32x4*)(cw + 4096 + ch), w3 = *(const f32x4*)(cw + 6144 + ch), bb = *(const f32x4*)(cb + ch);
        const f32x4 v = bb + w0 * p[2] + w1 * p[1] + w2 * p[0] + w3 * x;
        u16* dst = (ch < 1024) ? qc + ch : kc + (ch - 1024); const float sc = (ch < 1024) ? 1.f : 0.0625f;
        u32x2 w; w.x = pk2(sc * v[0] * sigm(v[0]), sc * v[1] * sigm(v[1])); w.y = pk2(sc * v[2] * sigm(v[2]), sc * v[3] * sigm(v[3]));
        *(u32x2*)(dst + ((size_t)pm * 256 + j) * 1024) = w;
    }
}

struct GD { const u16* A; const u16* Bt; int M, N, K, cshift; UE e; };

DI void cvt_w(int mk_tid, LAS unsigned char* lds, const float* W, int ldw, int col0, int ncols, int K, u16* dst, int& tb, int il, const float* gain, int vb, int VG) {
    LAS float* tile = (LAS float*)lds;
    const int tid = mk_tid, G = VG; const int ntn = ncols >> 8, nt = ntn * (K >> 6);
    int i0 = (vb - tb) % G; if (i0 < 0) i0 += G; if (vb < 0) i0 = nt;
    for (int i = i0; i < nt; i += G) {
        const int tn = i % ntn, tk = i / ntn;
        __syncthreads();
        const float* src = W + (size_t)(tk * 64) * ldw + col0 + (il ? tn * 128 : tn * 256);
#pragma unroll 16
        for (int e = tid; e < 16384; e += 512) { const int r = e >> 8, c = e & 255; const int cs = (il && c >= 128) ? c + 3072 - 128 : c; tile[r * 257 + c] = src[(size_t)r * ldw + cs]; }
        __syncthreads();
        u16* dp = dst + (size_t)(tn * 256) * K + tk * 64; const float gk0 = gain ? gain[tk * 64 + (tid & 31) * 2] : 1.f, gk1 = gain ? gain[tk * 64 + (tid & 31) * 2 + 1] : 1.f;
#pragma unroll 4
        for (int e = tid; e < 8192; e += 512) { const int n = e >> 5, k2 = (e & 31) * 2; *(unsigned*)(dp + (size_t)n * K + k2) = pk2(tile[k2 * 257 + n] * gk0, tile[(k2 + 1) * 257 + n] * gk1); }
    }
    tb = (tb + nt) % G;
}

DI void norm_rows(int mk_tid, const float* src, const float* g, u16* dst, int nrows, const LAS float* sW, const float* ifb, float* ifg) {
    const int lane = mk_tid & 63, gw = blockIdx.x * 8 + (mk_tid >> 6), nw = gridDim.x * 8;
    for (int row0 = gw; row0 < nrows; row0 += 4 * nw) {
        float4 v[4][4];
#pragma unroll
        for (int r = 0; r < 4; ++r) { const int row = row0 + r * nw; if (row < nrows) {
#pragma unroll
            for (int i = 0; i < 4; ++i) v[r][i] = *(const float4*)(src + (size_t)row * 1024 + i * 256 + lane * 4); } }
        float4 gv[4];
#pragma unroll
        for (int i = 0; i < 4; ++i) gv[i] = *(const float4*)(g + i * 256 + lane * 4);
#pragma unroll
        for (int r = 0; r < 4; ++r) { const int row = row0 + r * nw; if (row < nrows) {
            float ss = 0.f;
#pragma unroll
            for (int i = 0; i < 4; ++i) ss += v[r][i].x * v[r][i].x + v[r][i].y * v[r][i].y + v[r][i].z * v[r][i].z + v[r][i].w * v[r][i].w;
            ss = wsum(ss); const float rinv = rsqrtf(ss * (1.f / 1024.f) + 1e-6f);
#pragma unroll
            for (int i = 0; i < 4; ++i) { v[r][i].x *= rinv * gv[i].x; v[r][i].y *= rinv * gv[i].y; v[r][i].z *= rinv * gv[i].z; v[r][i].w *= rinv * gv[i].w;
                u32x2 w; w.x = pk2(v[r][i].x, v[r][i].y); w.y = pk2(v[r][i].z, v[r][i].w); *(u32x2*)(dst + (size_t)row * 1024 + i * 256 + lane * 4) = w; }
            if (sW) {
                float a0 = 0, a1 = 0, a2 = 0, a3 = 0, a4 = 0, a5 = 0, a6 = 0, a7 = 0;
#pragma unroll
                for (int i = 0; i < 4; ++i) { const float y[4] = {v[r][i].x, v[r][i].y, v[r][i].z, v[r][i].w};
#pragma unroll
                    for (int e = 0; e < 4; ++e) { const int k = i * 256 + lane * 4 + e; const LAS f32x4* wp = (const LAS f32x4*)(sW + k * 8); const f32x4 w0 = wp[0], w1 = wp[1];
                        a0 += y[e] * w0.x; a1 += y[e] * w0.y; a2 += y[e] * w0.z; a3 += y[e] * w0.w; a4 += y[e] * w1.x; a5 += y[e] * w1.y; a6 += y[e] * w1.z; a7 += y[e] * w1.w; } __builtin_amdgcn_sched_barrier(0); }
                a0 = wsum(a0); a1 = wsum(a1); a2 = wsum(a2); a3 = wsum(a3); a4 = wsum(a4); a5 = wsum(a5); a6 = wsum(a6); a7 = wsum(a7);
                if (lane == 0) { float4 o0, o1; o0.x = a0 + ifb[0]; o0.y = a1 + ifb[1]; o0.z = a2 + ifb[2]; o0.w = a3 + ifb[3]; o1.x = a4 + ifb[4]; o1.y = a5 + ifb[5]; o1.z = a6 + ifb[6]; o1.w = a7 + ifb[7];
                    *(float4*)(ifg + (size_t)row * 8) = o0; *(float4*)(ifg + (size_t)row * 8 + 4) = o1; }
            } } __builtin_amdgcn_sched_barrier(0); }
    }
}
DI void final_norm(int mk_tid, const u16* hb, float* out, const float* g) {
    const int lane = mk_tid & 63, gw = blockIdx.x * 8 + (mk_tid >> 6), nw = gridDim.x * 8;
    float4 gv[4];
#pragma unroll
    for (int i = 0; i < 4; ++i) gv[i] = *(const float4*)(g + i * 256 + lane * 4);
    for (int row0 = gw; row0 < T; row0 += 4 * nw) {
        u32x2 v[4][4];
#pragma unroll
        for (int r = 0; r < 4; ++r)
#pragma unroll
            for (int i = 0; i < 4; ++i) v[r][i] = *(const u32x2*)(hb + (size_t)(row0 + r * nw) * 1024 + i * 256 + lane * 4);
        __builtin_amdgcn_sched_barrier(0);
#pragma unroll
        for (int r = 0; r < 4; ++r) { float* p = out + (size_t)(row0 + r * nw) * 1024; float ss = 0.f; float4 f[4];
#pragma unroll
            for (int i = 0; i < 4; ++i) { f[i].x = bflo(v[r][i].x); f[i].y = bfhi(v[r][i].x); f[i].z = bflo(v[r][i].y); f[i].w = bfhi(v[r][i].y); ss += f[i].x * f[i].x + f[i].y * f[i].y + f[i].z * f[i].z + f[i].w * f[i].w; }
            ss = wsum(ss); const float rinv = rsqrtf(ss * (1.f / 1024.f) + 1e-6f);
#pragma unroll
            for (int i = 0; i < 4; ++i) { float4 o; o.x = f[i].x * rinv * gv[i].x; o.y = f[i].y * rinv * gv[i].y; o.z = f[i].z * rinv * gv[i].z; o.w = f[i].w * rinv * gv[i].w; *(float4*)(p + i * 256 + lane * 4) = o; } }
    }
}

DI void conv_qk_phase(int mk_tid, const u16* qk, const float* cw, const float* cb, u16* qc, u16* kc) {
    const int gtid = blockIdx.x * 512 + mk_tid, nth = gridDim.x * 512;
    for (int item = gtid; item < 256 * 1024; item += nth) {
        const int co = item & 255, tb = item >> 8, c0 = co * 8, t0 = tb * 16;
        float w0[8], w1[8], w2[8], w3[8], bb[8];
#pragma unroll
        for (int e = 0; e < 8; ++e) { w0[e] = cw[c0 + e]; w1[e] = cw[2048 + c0 + e]; w2[e] = cw[4096 + c0 + e]; w3[e] = cw[6144 + c0 + e]; bb[e] = cb[c0 + e]; }
        float x0[8], x1[8], x2[8], x3[8];
        if ((t0 & (SEQ - 1)) == 0) {
#pragma unroll
            for (int e = 0; e < 8; ++e) { x0[e] = 0.f; x1[e] = 0.f; x2[e] = 0.f; }
        } else {
            unpack8(*(const u32x4*)(qk + (size_t)(t0 - 3) * 2048 + c0), x0); unpack8(*(const u32x4*)(qk + (size_t)(t0 - 2) * 2048 + c0), x1); unpack8(*(const u32x4*)(qk + (size_t)(t0 - 1) * 2048 + c0), x2);
        }
        u16* dstp = (c0 < 1024) ? qc + c0 : kc + (c0 - 1024); const float sc = (c0 < 1024) ? 1.f : 0.0625f;
        for (int tt = 0; tt < 16; ++tt) {
            unpack8(*(const u32x4*)(qk + (size_t)(t0 + tt) * 2048 + c0), x3);
            float o[8];
#pragma unroll
            for (int e = 0; e < 8; ++e) { const float v = bb[e] + w0[e] * x0[e] + w1[e] * x1[e] + w2[e] * x2[e] + w3[e] * x3[e]; o[e] = sc * v * sigm(v); x0[e] = x1[e]; x1[e] = x2[e]; x2[e] = x3[e]; }
            u32x4 r; r.x = pk2(o[0], o[1]); r.y = pk2(o[2], o[3]); r.z = pk2(o[4], o[5]); r.w = pk2(o[6], o[7]);
            *(u32x4*)(dstp + (size_t)(t0 + tt) * 1024) = r;
        }
    }
}

DI float logsig(float x) { return fminf(x, 0.f) - log1pf(__expf(-fabsf(x))); }
DI void gate_prepass(int mk_tid, LAS unsigned char* lds, int bh, const float* ifg, float* gz, float* gM, float* gE, float* gms, float* gMl, float* gW) {
    const int lane = mk_tid & 63, wid = mk_tid >> 6, b = bh >> 2, h = bh & 3;
    LAS float* G = (LAS float*)lds; LAS float* CM = G + 16;
    float z0[2], z1[2], b0[2], b1[2], excm[2], incm[2];
    __syncthreads();
#pragma unroll
    for (int cc = 0; cc < 2; ++cc) { const int c = wid * 2 + cc;
        const int s0 = c * 128 + 2 * lane; const size_t t = (size_t)b * SEQ + s0;
        const float i0 = ifg[t * 8 + h], f0 = ifg[t * 8 + 4 + h], i1 = ifg[t * 8 + 8 + h], f1 = ifg[t * 8 + 12 + h];
        const float lf0 = logsig(f0), lf1 = logsig(f1), s1 = lf0 + lf1;
        float inc = s1;
#pragma unroll
        for (int d = 1; d < 64; d <<= 1) { const float o = __shfl_up(inc, d); if (lane >= d) inc += o; }
        const float exc = inc - s1; b0[cc] = exc + lf0; b1[cc] = exc + s1; z0[cc] = i0 - b0[cc]; z1[cc] = i1 - b1[cc];
        float im = fmaxf(z0[cc], z1[cc]);
#pragma unroll
        for (int d = 1; d < 64; d <<= 1) { const float o = __shfl_up(im, d); if (lane >= d) im = fmaxf(im, o); }
        float em = __shfl_up(im, 1); if (lane == 0) em = -3.0e38f;
        incm[cc] = im; excm[cc] = em;
        if (lane == 63) { G[c] = inc; CM[c] = im; }
    }
    __syncthreads();
    float m = 0.f, mst[2] = {0.f, 0.f};
    for (int c = 0; c < wid * 2; ++c) m = G[c] + fmaxf(m, CM[c]);
    mst[0] = m; m = G[wid * 2] + fmaxf(m, CM[wid * 2]); mst[1] = m;
#pragma unroll
    for (int cc = 0; cc < 2; ++cc) { const int c = wid * 2 + cc; const float m_st = mst[cc];
        const float M0 = fmaxf(m_st, fmaxf(excm[cc], z0[cc])), M1 = fmaxf(m_st, incm[cc]), Ml = fmaxf(m_st, CM[c]);
        const size_t gi = (size_t)bh * SEQ + c * 128 + 2 * lane;
        *(float2*)(gz + gi) = make_float2(z0[cc], z1[cc]); *(float2*)(gM + gi) = make_float2(M0, M1); *(float2*)(gE + gi) = make_float2(__expf(-(b0[cc] + M0)), __expf(-(b1[cc] + M1)));
        *(float2*)(gW + gi) = make_float2(__expf(z0[cc] - Ml), __expf(z1[cc] - Ml));
        if (lane == 0) { gms[bh * 16 + c] = m_st; gMl[bh * 16 + c] = Ml; }
    }
    __syncthreads();
}

DI void mlstm_state_phase(int mk_tid, LAS unsigned char* lds, u16* kc, const u16* vT, float* gW, float* gms, float* gMl, u16* CT, float* nvec,
                          const float* ifg, float* gz, float* gM, float* gE, const float* HBQ, const float* cw, const float* cb) {
    const int tid = mk_tid, lane = tid & 63, wid = tid >> 6, fr = lane & 15, fq = lane >> 4;
    LAS unsigned* slab = (LAS unsigned*)(lds + wid * 9216);
    const unsigned trbase = (unsigned)(size_t)slab + (unsigned)((8 * fq + (fr >> 2)) * 72 + 8 * (fr & 3));
    const int lr = lane >> 2, lp = lane & 3;
    for (int item = blockIdx.x; item < 256; item += gridDim.x) {
        const int bh = item >> 3, eb = item & 7, b = bh >> 2, h = bh & 3;
        gate_prepass(mk_tid, lds, bh, ifg, gz, gM, gE, gms, gMl, gW);
        qk_fix_local(mk_tid, HBQ, cw, cb, kc, 1024 + h * 256, b * 8, 8);
        asm volatile("s_waitcnt vmcnt(0)" ::: "memory"); __syncthreads();
        f32x4 acc[2][2], nac4[2] = {(f32x4){0.f, 0.f, 0.f, 0.f}, (f32x4){0.f, 0.f, 0.f, 0.f}};
        const bf16x8 ones8 = __builtin_bit_cast(bf16x8, (u32x4){0x3F803F80u, 0x3F803F80u, 0x3F803F80u, 0x3F803F80u});
#pragma unroll
        for (int dm = 0; dm < 2; ++dm)
#pragma unroll
            for (int en = 0; en < 2; ++en) acc[dm][en] = (f32x4){0.f, 0.f, 0.f, 0.f};
        u32x4 kreg[8], vreg[4][2]; float wrow[8];
        {   const size_t tbase = (size_t)b * SEQ;
#pragma unroll
            for (int i = 0; i < 8; ++i) { kreg[i] = *(const u32x4*)(kc + (tbase + i * 16 + lr) * 1024 + h * 256 + wid * 32 + lp * 8); wrow[i] = gW[(size_t)bh * SEQ + i * 16 + lr]; }
#pragma unroll
            for (int ks = 0; ks < 4; ++ks)
#pragma unroll
                for (int en = 0; en < 2; ++en) vreg[ks][en] = *(const u32x4*)(vT + (size_t)(h * 256 + eb * 32 + en * 16 + fr) * T + tbase + ks * 32 + 8 * fq); }
        for (int c = 0; c < 16; ++c) {
            u16* ct = CT + ((size_t)(bh * 16 + c) << 16);
#pragma unroll
            for (int dm = 0; dm < 2; ++dm) {
#pragma unroll
                for (int en = 0; en < 2; ++en) { const int e = eb * 32 + en * 16 + fr, d = wid * 32 + dm * 16 + 4 * fq; u32x2 w; w.x = pk2(acc[dm][en][0], acc[dm][en][1]); w.y = pk2(acc[dm][en][2], acc[dm][en][3]); *(u32x2*)(ct + e * 256 + d) = w; }
                if (eb == 0 && fr == 0) *(f32x4*)(nvec + (size_t)(bh * 16 + c) * 256 + wid * 32 + dm * 16 + 4 * fq) = nac4[dm];
            }
            if (c == 15) break;
#pragma unroll
            for (int i = 0; i < 8; ++i) { float kf[8]; unpack8(kreg[i], kf); const float w = wrow[i]; LAS unsigned* dp = slab + (i * 16 + lr) * 18 + lp * 4;
                dp[0] = pk2(kf[0] * w, kf[1] * w); dp[1] = pk2(kf[2] * w, kf[3] * w); dp[2] = pk2(kf[4] * w, kf[5] * w); dp[3] = pk2(kf[6] * w, kf[7] * w); }
            bf16x8 bfr[4][2];
#pragma unroll
            for (int ks = 0; ks < 4; ++ks)
#pragma unroll
                for (int en = 0; en < 2; ++en) bfr[ks][en] = __builtin_bit_cast(bf16x8, vreg[ks][en]);
            if (c + 1 < 15) { const size_t tbase = (size_t)b * SEQ + (c + 1) * 128;
#pragma unroll
                for (int i = 0; i < 8; ++i) { kreg[i] = *(const u32x4*)(kc + (tbase + i * 16 + lr) * 1024 + h * 256 + wid * 32 + lp * 8); wrow[i] = gW[(size_t)bh * SEQ + (c + 1) * 128 + i * 16 + lr]; }
#pragma unroll
                for (int ks = 0; ks < 4; ++ks)
#pragma unroll
                    for (int en = 0; en < 2; ++en) vreg[ks][en] = *(const u32x4*)(vT + (size_t)(h * 256 + eb * 32 + en * 16 + fr) * T + tbase + ks * 32 + 8 * fq); }
            const float dec = __expf(gms[bh * 16 + c] - gMl[bh * 16 + c]);
#pragma unroll
            for (int dm = 0; dm < 2; ++dm) { nac4[dm] *= dec;
#pragma unroll
                for (int en = 0; en < 2; ++en) acc[dm][en] *= dec; }
            __builtin_amdgcn_fence(__ATOMIC_RELEASE, "wavefront"); __builtin_amdgcn_wave_barrier(); __builtin_amdgcn_fence(__ATOMIC_ACQUIRE, "wavefront");
#pragma unroll
            for (int ks = 0; ks < 4; ++ks) {
                bf16x8 afr[2];
                {
                    s16x4 a00, a01, a10, a11; const unsigned ad = trbase + (unsigned)(ks * 32 * 72);
                    asm volatile("s_waitcnt lgkmcnt(0)\n\tds_read_b64_tr_b16 %0, %4\n\tds_read_b64_tr_b16 %1, %4 offset:288\n\tds_read_b64_tr_b16 %2, %4 offset:32\n\tds_read_b64_tr_b16 %3, %4 offset:320\n\ts_waitcnt lgkmcnt(0)"
                                 : "=&v"(a00), "=&v"(a01), "=&v"(a10), "=&v"(a11) : "v"(ad) : "memory");
                    afr[0] = __builtin_shufflevector(a00, a01, 0, 1, 2, 3, 4, 5, 6, 7); afr[1] = __builtin_shufflevector(a10, a11, 0, 1, 2, 3, 4, 5, 6, 7); }
                nac4[0] = mfma16(afr[0], ones8, nac4[0]); nac4[1] = mfma16(afr[1], ones8, nac4[1]);
#pragma unroll
                for (int dm = 0; dm < 2; ++dm)
#pragma unroll
                    for (int en = 0; en < 2; ++en) acc[dm][en] = mfma16(afr[dm], bfr[ks][en], acc[dm][en]);
            }
            __builtin_amdgcn_fence(__ATOMIC_RELEASE, "wavefront"); __builtin_amdgcn_wave_barrier(); __builtin_amdgcn_fence(__ATOMIC_ACQUIRE, "wavefront");
        }
    }
}

DI void mlstm_out_phase(int mk_tid, LAS unsigned char* lds, u16* qy, const u16* kc, const u16* vT, const u16* CT, const float* nvec, const u16* og,
                        const float* gz, const float* gM, const float* gE, const float* gms, const float* ng, int nostore, const float* HBQ, const float* cw, const float* cb) {
    const int tid = mk_tid, lane = tid & 63, wid = __builtin_amdgcn_readfirstlane(tid >> 6), fr = lane & 15, fq = lane >> 4;
    LAS u16* Ksh = (LAS u16*)lds;
    LAS u16* Vsh = (LAS u16*)(lds + 67584);
    for (int item = blockIdx.x; item < 512; item += gridDim.x) {
        const int bh = item >> 4, c = item & 15, b = bh >> 2, h = bh & 3; const size_t tbase = (size_t)b * SEQ + c * 128;
        if ((c & 1) == 0) qk_fix_local(mk_tid, HBQ, cw, cb, qy, h * 256, (int)(tbase >> 8), 1);
        __syncthreads();
        for (int e = tid; e < 4096; e += 512) { const int r = e >> 5, p = e & 31; *(LAS u32x4*)(Ksh + r * 264 + p * 8) = *(const u32x4*)(kc + (tbase + r) * 1024 + h * 256 + p * 8); }
        for (int e = tid; e < 4096; e += 512) { const int r = e >> 4, p = e & 15; *(LAS u32x4*)(Vsh + r * 136 + p * 8) = *(const u32x4*)(vT + (size_t)(h * 256 + r) * T + tbase + p * 8); }
        asm volatile("s_waitcnt vmcnt(0)" ::: "memory");
        __syncthreads();
        const int tl = wid * 16 + fr; const size_t tok = tbase + tl;
        bf16x8 qf[8];
#pragma unroll
        for (int ks = 0; ks < 8; ++ks) qf[ks] = *(const bf16x8*)(qy + tok * 1024 + h * 256 + ks * 32 + 8 * fq);
        const size_t gi = (size_t)bh * SEQ + c * 128;
        const float Mt = gM[gi + tl], en_t = gE[gi + tl], winter = __expf(gms[bh * 16 + c] - Mt);
        const u16* ct = CT + ((size_t)(bh * 16 + c) << 16);
        u32x4 cpre[8];
#pragma unroll
        for (int i = 0; i < 8; ++i) { const int e = tid + i * 512, r = e >> 5, p = e & 31; cpre[i] = *(const u32x4*)(ct + (size_t)r * 256 + p * 8); }
        bf16x8 pf[4]; float dsum = 0.f;
#pragma unroll
        for (int sp = 0; sp < 4; ++sp) {
            u32x4 pk = (u32x4){0u, 0u, 0u, 0u};
#pragma unroll
            for (int hh = 0; hh < 2; ++hh) { const int si = sp * 2 + hh;
                if (si <= wid) {
                    f32x4 st = (f32x4){0.f, 0.f, 0.f, 0.f};
#pragma unroll
                    for (int ks = 0; ks < 8; ++ks) { const bf16x8 a = *(const LAS bf16x8*)(Ksh + (si * 16 + fr) * 264 + ks * 32 + 8 * fq); st = mfma16(a, qf[ks], st); }
                    const float4 z = *(const float4*)(gz + gi + si * 16 + 4 * fq); const float zz[4] = {z.x, z.y, z.z, z.w}; float pv[4];
#pragma unroll
                    for (int j = 0; j < 4; ++j) { const int s = si * 16 + 4 * fq + j; const float p = (s <= tl) ? st[j] * __expf(zz[j] - Mt) : 0.f; dsum += p; pv[j] = p; }
                    if (hh == 0) { pk.x = pk2(pv[0], pv[1]); pk.y = pk2(pv[2], pv[3]); } else { pk.z = pk2(pv[0], pv[1]); pk.w = pk2(pv[2], pv[3]); }
                } }
            pf[sp] = __builtin_bit_cast(bf16x8, pk);
        }
        f32x4 o[16];
#pragma unroll
        for (int half = 0; half < 2; ++half) {
            __syncthreads();
#pragma unroll
            for (int i = 0; i < 8; ++i) { const int e = tid + i * 512, r = e >> 5, p = e & 31; *(LAS u32x4*)(Ksh + r * 264 + p * 8) = cpre[i]; }
            if (half == 0) {
#pragma unroll
                for (int i = 0; i < 8; ++i) { const int e = tid + i * 512, r = e >> 5, p = e & 31; cpre[i] = *(const u32x4*)(ct + (size_t)(128 + r) * 256 + p * 8); } }
            __syncthreads();
#pragma unroll
            for (int e8 = 0; e8 < 8; ++e8) { f32x4 a = (f32x4){0.f, 0.f, 0.f, 0.f};
#pragma unroll
                for (int ks = 0; ks < 8; ++ks) { const bf16x8 cf = *(const LAS bf16x8*)(Ksh + (e8 * 16 + fr) * 264 + ks * 32 + 8 * fq); a = mfma16(cf, qf[ks], a); }
                o[half * 8 + e8] = a * winter; __builtin_amdgcn_sched_barrier(0); }
        }
        const float* nv = nvec + (size_t)(bh * 16 + c) * 256; float qn = 0.f;
#pragma unroll
        for (int ks = 0; ks < 8; ++ks) { const float4 n0 = *(const float4*)(nv + ks * 32 + 8 * fq), n1 = *(const float4*)(nv + ks * 32 + 8 * fq + 4); const float nn[8] = {n0.x, n0.y, n0.z, n0.w, n1.x, n1.y, n1.z, n1.w};
#pragma unroll
            for (int j = 0; j < 8; ++j) qn += bf2f((u16)qf[ks][j]) * nn[j]; }
        qn += __shfl_xor(qn, 16); qn += __shfl_xor(qn, 32); dsum += __shfl_xor(dsum, 16); dsum += __shfl_xor(dsum, 32);
        const int nsp = (wid >> 1) + 1;
#pragma unroll
        for (int et = 0; et < 16; ++et) { __builtin_amdgcn_sched_barrier(0);
#pragma unroll
            for (int sp = 0; sp < 4; ++sp) if (sp < nsp) {
                const s16x4 lo = *(const LAS s16x4*)(Vsh + (et * 16 + fr) * 136 + sp * 32 + 4 * fq), hi = *(const LAS s16x4*)(Vsh + (et * 16 + fr) * 136 + sp * 32 + 16 + 4 * fq);
                const bf16x8 a = __builtin_shufflevector(lo, hi, 0, 1, 2, 3, 4, 5, 6, 7); o[et] = mfma16(a, pf[sp], o[et]); } }
        const float den = winter * qn + dsum, inv = 1.f / fmaxf(fabsf(den), en_t);
        float sum = 0.f;
#pragma unroll
        for (int et = 0; et < 16; ++et) { o[et] *= inv; sum += (o[et][0] + o[et][1]) + (o[et][2] + o[et][3]); }
        sum += __shfl_xor(sum, 16); sum += __shfl_xor(sum, 32); const float mu = sum * (1.f / 256.f);
        float var = 0.f;
#pragma unroll
        for (int et = 0; et < 16; ++et) { o[et] -= mu; var += (o[et][0] * o[et][0] + o[et][1] * o[et][1]) + (o[et][2] * o[et][2] + o[et][3] * o[et][3]); }
        var += __shfl_xor(var, 16); var += __shfl_xor(var, 32); const float rstd = rsqrtf(var * (1.f / 256.f) + 1e-6f);
        u32x2 ogr[16]; float4 gg[16];
#pragma unroll
        for (int et = 0; et < 16; ++et) { ogr[et] = *(const u32x2*)(og + tok * 1024 + h * 256 + et * 16 + 4 * fq); gg[et] = *(const float4*)(ng + h * 256 + et * 16 + 4 * fq); }
        __builtin_amdgcn_sched_barrier(0);
#pragma unroll
        for (int et = 0; et < 16; ++et) { const int e = h * 256 + et * 16 + 4 * fq; const float4 g4 = gg[et];
            u32x2 w; w.x = pk2(sigm(bflo(ogr[et].x)) * o[et][0] * rstd * g4.x, sigm(bfhi(ogr[et].x)) * o[et][1] * rstd * g4.y); w.y = pk2(sigm(bflo(ogr[et].y)) * o[et][2] * rstd * g4.z, sigm(bfhi(ogr[et].y)) * o[et][3] * rstd * g4.w);
            if (!nostore) *(u32x2*)(qy + tok * 1024 + e) = w; }
    }
}

DI void xattn_pair(int mk_tid, LAS unsigned char* lds, const u16* q, const u16* kmem, const u16* vTm, u16* ao, int b, int h, int qb0) {
    const int tid = mk_tid, lane = tid & 63, wid = tid >> 6, fr = lane & 15, fq = lane >> 4;
    LAS u16* Ksh = (LAS u16*)lds;
    {
        __syncthreads();
        for (int e = tid; e < 8192; e += 512) { const int r = e >> 5, p = e & 31; *(LAS u32x4*)(Ksh + r * 264 + p * 8) = *(const u32x4*)(kmem + (size_t)(b * 256 + r) * 1024 + h * 256 + p * 8); }
        __syncthreads();
        const size_t tok0 = (size_t)b * SEQ + qb0 * 128 + wid * 16 + fr, tok1 = tok0 + 128;
        bf16x8 qa[8], qb8[8];
#pragma unroll
        for (int ks = 0; ks < 8; ++ks) { qa[ks] = *(const bf16x8*)(q + tok0 * 1024 + h * 256 + ks * 32 + 8 * fq); qb8[ks] = *(const bf16x8*)(q + tok1 * 1024 + h * 256 + ks * 32 + 8 * fq); }
        float mx0 = -3.0e38f, mx1 = -3.0e38f;
#pragma unroll
        for (int mi = 0; mi < 16; ++mi) { f32x4 a = (f32x4){0.f, 0.f, 0.f, 0.f}, c = (f32x4){0.f, 0.f, 0.f, 0.f};
#pragma unroll
            for (int ks = 0; ks < 8; ++ks) { const bf16x8 kf = *(const LAS bf16x8*)(Ksh + (mi * 16 + fr) * 264 + ks * 32 + 8 * fq); a = mfma16(kf, qa[ks], a); c = mfma16(kf, qb8[ks], c); }
            mx0 = fmaxf(mx0, fmaxf(fmaxf(a[0], a[1]), fmaxf(a[2], a[3]))); mx1 = fmaxf(mx1, fmaxf(fmaxf(c[0], c[1]), fmaxf(c[2], c[3]))); __builtin_amdgcn_sched_barrier(0); }
        mx0 = fmaxf(mx0, __shfl_xor(mx0, 16)); mx0 = fmaxf(mx0, __shfl_xor(mx0, 32)); mx1 = fmaxf(mx1, __shfl_xor(mx1, 16)); mx1 = fmaxf(mx1, __shfl_xor(mx1, 32));
        bf16x8 pf0[8], pf1[8]; float sum0 = 0.f, sum1 = 0.f;
#pragma unroll
        for (int sp = 0; sp < 8; ++sp) { f32x4 a0 = (f32x4){0.f, 0.f, 0.f, 0.f}, a1 = a0, c0 = a0, c1 = a0;
#pragma unroll
            for (int ks = 0; ks < 8; ++ks) { const bf16x8 k0 = *(const LAS bf16x8*)(Ksh + (sp * 32 + fr) * 264 + ks * 32 + 8 * fq), k1 = *(const LAS bf16x8*)(Ksh + (sp * 32 + 16 + fr) * 264 + ks * 32 + 8 * fq);
                a0 = mfma16(k0, qa[ks], a0); a1 = mfma16(k1, qa[ks], a1); c0 = mfma16(k0, qb8[ks], c0); c1 = mfma16(k1, qb8[ks], c1); }
            float p[8], r[8];
#pragma unroll
            for (int j = 0; j < 4; ++j) { p[j] = __expf((a0[j] - mx0) * 0.0625f); p[4 + j] = __expf((a1[j] - mx0) * 0.0625f); sum0 += p[j] + p[4 + j];
                                          r[j] = __expf((c0[j] - mx1) * 0.0625f); r[4 + j] = __expf((c1[j] - mx1) * 0.0625f); sum1 += r[j] + r[4 + j]; }
            u32x4 pk; pk.x = pk2(p[0], p[1]); pk.y = pk2(p[2], p[3]); pk.z = pk2(p[4], p[5]); pk.w = pk2(p[6], p[7]); pf0[sp] = __builtin_bit_cast(bf16x8, pk);
            u32x4 rk; rk.x = pk2(r[0], r[1]); rk.y = pk2(r[2], r[3]); rk.z = pk2(r[4], r[5]); rk.w = pk2(r[6], r[7]); pf1[sp] = __builtin_bit_cast(bf16x8, rk); __builtin_amdgcn_sched_barrier(0); }
        sum0 += __shfl_xor(sum0, 16); sum0 += __shfl_xor(sum0, 32); sum1 += __shfl_xor(sum1, 16); sum1 += __shfl_xor(sum1, 32);
        const float iv0 = 1.f / sum0, iv1 = 1.f / sum1;
        __syncthreads();
        for (int e = tid; e < 8192; e += 512) { const int r = e >> 5, p = e & 31; *(LAS u32x4*)(Ksh + r * 264 + p * 8) = *(const u32x4*)(vTm + (size_t)(h * 256 + r) * 2048 + b * 256 + p * 8); }
        __syncthreads();
#pragma unroll 2
        for (int et = 0; et < 16; ++et) {
            f32x4 o0 = (f32x4){0.f, 0.f, 0.f, 0.f}, o1 = o0;
#pragma unroll
            for (int sp = 0; sp < 8; ++sp) { const s16x4 lo = *(const LAS s16x4*)(Ksh + (et * 16 + fr) * 264 + sp * 32 + 4 * fq), hi = *(const LAS s16x4*)(Ksh + (et * 16 + fr) * 264 + sp * 32 + 16 + 4 * fq);
                const bf16x8 a = __builtin_shufflevector(lo, hi, 0, 1, 2, 3, 4, 5, 6, 7); o0 = mfma16(a, pf0[sp], o0); o1 = mfma16(a, pf1[sp], o1); }
            u32x2 w0, w1; w0.x = pk2(o0[0] * iv0, o0[1] * iv0); w0.y = pk2(o0[2] * iv0, o0[3] * iv0); w1.x = pk2(o1[0] * iv1, o1[1] * iv1); w1.y = pk2(o1[2] * iv1, o1[3] * iv1);
            *(u32x2*)(ao + tok0 * 1024 + h * 256 + et * 16 + 4 * fq) = w0; *(u32x2*)(ao + tok1 * 1024 + h * 256 + et * 16 + 4 * fq) = w1; __builtin_amdgcn_sched_barrier(0); }
    }
}

DI void rglru_phase(int mk_tid, LAS unsigned char* lds, const u16* xr, const u16* gr, const float* cw, const float* cb, const float* wa, const float* ba, const float* wx, const float* bx, const float* lam, u16* ya, int pass, float* sumA, float* sumH) {
    const int tid = mk_tid, lane = tid & 63, wid = tid >> 6, fr = lane & 15, fq = lane >> 4;
    LAS u16* xs = (LAS u16*)(lds + wid * 8192);
    LAS float* xf = (LAS float*)(lds + wid * 8192 + 2560);
    const int tp = lane >> 3, co = lane & 7;
    for (int item = blockIdx.x * 8 + wid; item < 2048; item += gridDim.x * 8) {
        const int b = item >> 8, g = (item >> 4) & 15, seg = item & 15, ccol = g * 64 + co * 8;
        LAS u16* Wsh = (LAS u16*)(lds + 65536);
        __syncthreads();
        for (int e = tid; e < 4096; e += 512) { const int i = e >> 6, j = e & 63; Wsh[j * 72 + i] = f2bf(wa[(size_t)(g * 64 + i) * 64 + j]); Wsh[4608 + j * 72 + i] = f2bf(wx[(size_t)(g * 64 + i) * 64 + j]); }
        __syncthreads();
        if (pass == 0 && seg == 15) continue;
        float bav[4], bxv[4], c8[4], carry[4], aprod[4];
#pragma unroll
        for (int nt = 0; nt < 4; ++nt) { const int cch = g * 64 + nt * 16 + fr;
            bav[nt] = ba[cch]; bxv[nt] = bx[cch]; c8[nt] = -8.f * log1pf(__expf(-lam[cch])); carry[nt] = 0.f; aprod[nt] = 1.f;
            if (pass == 1) for (int s2 = 0; s2 < seg; ++s2) carry[nt] = sumA[(size_t)(b * 16 + s2) * 1024 + cch] * carry[nt] + sumH[(size_t)(b * 16 + s2) * 1024 + cch]; }
        float w0[8], w1[8], w2[8], w3[8], bb[8];
#pragma unroll
        for (int e = 0; e < 8; ++e) { w0[e] = cw[ccol + e]; w1[e] = cw[1024 + ccol + e]; w2[e] = cw[2048 + ccol + e]; w3[e] = cw[3072 + ccol + e]; bb[e] = cb[ccol + e]; }
        const size_t tb0 = (size_t)b * SEQ; const int sb = seg * 128;
        u32x4 rows[5]; u16 grv[4][4];
#pragma unroll
        for (int r = 0; r < 5; ++r) { const int srow = sb + 2 * tp - 3 + r; rows[r] = (srow >= 0) ? *(const u32x4*)(xr + (tb0 + srow) * 1024 + ccol) : (u32x4){0u, 0u, 0u, 0u}; }
#pragma unroll
        for (int nt = 0; nt < 4; ++nt)
#pragma unroll
            for (int j = 0; j < 4; ++j) grv[nt][j] = (pass == 1) ? gr[(tb0 + sb + 4 * fq + j) * 1024 + g * 64 + nt * 16 + fr] : (u16)0;
        for (int st = 0; st < 8; ++st) {
            u32x4 cur[5]; u16 gcur[4][4];
#pragma unroll
            for (int r = 0; r < 5; ++r) cur[r] = rows[r];
#pragma unroll
            for (int nt = 0; nt < 4; ++nt)
#pragma unroll
                for (int j = 0; j < 4; ++j) gcur[nt][j] = grv[nt][j];
            const int t0 = sb + st * 16;
            if (st + 1 < 8) {
#pragma unroll
                for (int r = 0; r < 5; ++r) rows[r] = *(const u32x4*)(xr + (tb0 + t0 + 16 + 2 * tp - 3 + r) * 1024 + ccol);
                if (pass == 1) {
#pragma unroll
                    for (int nt = 0; nt < 4; ++nt)
#pragma unroll
                        for (int j = 0; j < 4; ++j) grv[nt][j] = gr[(tb0 + t0 + 16 + 4 * fq + j) * 1024 + g * 64 + nt * 16 + fr]; }
            }
            float r0[8], r1[8], r2[8], r3[8], r4[8], oa[8], ob[8];
            unpack8(cur[0], r0); unpack8(cur[1], r1); unpack8(cur[2], r2); unpack8(cur[3], r3); unpack8(cur[4], r4);
#pragma unroll
            for (int e = 0; e < 8; ++e) { oa[e] = bb[e] + w0[e] * r0[e] + w1[e] * r1[e] + w2[e] * r2[e] + w3[e] * r3[e]; ob[e] = bb[e] + w0[e] * r1[e] + w1[e] * r2[e] + w2[e] * r3[e] + w3[e] * r4[e]; }
            { u32x4 pa, pb; pa.x = pk2(oa[0], oa[1]); pa.y = pk2(oa[2], oa[3]); pa.z = pk2(oa[4], oa[5]); pa.w = pk2(oa[6], oa[7]); pb.x = pk2(ob[0], ob[1]); pb.y = pk2(ob[2], ob[3]); pb.z = pk2(ob[4], ob[5]); pb.w = pk2(ob[6], ob[7]);
              *(LAS u32x4*)(xs + (2 * tp) * 72 + co * 8) = pa; *(LAS u32x4*)(xs + (2 * tp + 1) * 72 + co * 8) = pb;
              *(LAS f32x4*)(xf + (2 * tp) * 68 + co * 8) = (f32x4){oa[0], oa[1], oa[2], oa[3]}; *(LAS f32x4*)(xf + (2 * tp) * 68 + co * 8 + 4) = (f32x4){oa[4], oa[5], oa[6], oa[7]};
              *(LAS f32x4*)(xf + (2 * tp + 1) * 68 + co * 8) = (f32x4){ob[0], ob[1], ob[2], ob[3]}; *(LAS f32x4*)(xf + (2 * tp + 1) * 68 + co * 8 + 4) = (f32x4){ob[4], ob[5], ob[6], ob[7]}; }
            __builtin_amdgcn_fence(__ATOMIC_RELEASE, "wavefront"); __builtin_amdgcn_wave_barrier(); __builtin_amdgcn_fence(__ATOMIC_ACQUIRE, "wavefront");
            const bf16x8 af0 = *(const LAS bf16x8*)(xs + fr * 72 + 8 * fq), af1 = *(const LAS bf16x8*)(xs + fr * 72 + 32 + 8 * fq);
#pragma unroll
            for (int nt = 0; nt < 4; ++nt) {
                f32x4 aa = (f32x4){0.f, 0.f, 0.f, 0.f}, ax = (f32x4){0.f, 0.f, 0.f, 0.f};
                { const LAS u16* wp = Wsh + (nt * 16 + fr) * 72 + 8 * fq; const bf16x8 wa0 = *(const LAS bf16x8*)wp, wa1 = *(const LAS bf16x8*)(wp + 32), wx0 = *(const LAS bf16x8*)(wp + 4608), wx1 = *(const LAS bf16x8*)(wp + 4608 + 32);
                  aa = mfma16(af0, wa0, aa); aa = mfma16(af1, wa1, aa); ax = mfma16(af0, wx0, ax); ax = mfma16(af1, wx1, ax); }
                float hl[4], pa4[4]; float Al = 1.f, Hl = 0.f;
#pragma unroll
                for (int j = 0; j < 4; ++j) { const float xc = xf[(4 * fq + j) * 68 + nt * 16 + fr]; const float rr = sigm(aa[j] + bav[nt]), ii = sigm(ax[j] + bxv[nt]), la = c8[nt] * rr, av = __expf(la), x2 = 2.f * la;
                    const float om = (x2 > -0.02f) ? -x2 * (1.f + x2 * (0.5f + x2 * (1.f / 6.f))) : 1.f - av * av;
                    const float uu = __builtin_amdgcn_sqrtf(fmaxf(om, 0.f)) * ii * xc;
                    Hl = av * Hl + uu; Al *= av; hl[j] = Hl; pa4[j] = Al; }
                const float A0 = __shfl(Al, fr), H0 = __shfl(Hl, fr), A1 = __shfl(Al, fr + 16), H1 = __shfl(Hl, fr + 16), A2 = __shfl(Al, fr + 32), H2 = __shfl(Hl, fr + 32), A3 = __shfl(Al, fr + 48), H3 = __shfl(Hl, fr + 48);
                const float cin = carry[nt], c1 = A0 * cin + H0, c2 = A1 * c1 + H1, c3 = A2 * c2 + H2, c4 = A3 * c3 + H3;
                const float hin = (fq == 0) ? cin : (fq == 1) ? c1 : (fq == 2) ? c2 : c3;
                carry[nt] = c4; aprod[nt] *= (A0 * A1) * (A2 * A3);
                if (pass == 1) {
#pragma unroll
                    for (int j = 0; j < 4; ++j) { const float hv = hl[j] + pa4[j] * hin; ya[(tb0 + t0 + 4 * fq + j) * 1024 + g * 64 + nt * 16 + fr] = f2bf(gelu_t(bf2f(gcur[nt][j])) * hv); } }
            }
            __builtin_amdgcn_fence(__ATOMIC_RELEASE, "wavefront"); __builtin_amdgcn_wave_barrier(); __builtin_amdgcn_fence(__ATOMIC_ACQUIRE, "wavefront");
        }
        if (pass == 0 && fq == 0) {
#pragma unroll
            for (int nt = 0; nt < 4; ++nt) { sumA[(size_t)(b * 16 + seg) * 1024 + g * 64 + nt * 16 + fr] = aprod[nt]; sumH[(size_t)(b * 16 + seg) * 1024 + g * 64 + nt * 16 + fr] = carry[nt]; } }
    }
}

DI void ffn_act_phase(int mk_tid, const u16* up, const float* cw, const float* cb, u16* act, int part) {
    const int gtid = blockIdx.x * 512 + mk_tid, nth = gridDim.x * 512;
    for (int item = gtid; item < 192 * 1024; item += nth) {
        const int co = item % 192, tb = item / 192, c0 = co * 8, t0 = tb * 16, gc = part * 1536 + c0;
        float wg0[8], wg1[8], wg2[8], wu0[8], wu1[8], wu2[8], bg[8], bu[8];
#pragma unroll
        for (int e = 0; e < 8; ++e) { wg0[e] = cw[gc + e]; wg1[e] = cw[6144 + gc + e]; wg2[e] = cw[12288 + gc + e]; wu0[e] = cw[3072 + gc + e]; wu1[e] = cw[6144 + 3072 + gc + e]; wu2[e] = cw[12288 + 3072 + gc + e]; bg[e] = cb[gc + e]; bu[e] = cb[3072 + gc + e]; }
        float g0[8], g1[8], g2[8], u0[8], u1[8], u2[8];
        if ((t0 & (SEQ - 1)) == 0) {
#pragma unroll
            for (int e = 0; e < 8; ++e) { g0[e] = 0.f; g1[e] = 0.f; u0[e] = 0.f; u1[e] = 0.f; }
        } else {
            unpack8(*(const u32x4*)(up + (size_t)(t0 - 2) * 3072 + c0), g0); unpack8(*(const u32x4*)(up + (size_t)(t0 - 1) * 3072 + c0), g1);
            unpack8(*(const u32x4*)(up + (size_t)(t0 - 2) * 3072 + 1536 + c0), u0); unpack8(*(const u32x4*)(up + (size_t)(t0 - 1) * 3072 + 1536 + c0), u1);
        }
        for (int tt = 0; tt < 16; ++tt) {
            unpack8(*(const u32x4*)(up + (size_t)(t0 + tt) * 3072 + c0), g2); unpack8(*(const u32x4*)(up + (size_t)(t0 + tt) * 3072 + 1536 + c0), u2);
            float o[8];
#pragma unroll
            for (int e = 0; e < 8; ++e) { const float gv = bg[e] + wg0[e] * g0[e] + wg1[e] * g1[e] + wg2[e] * g2[e], uv = bu[e] + wu0[e] * u0[e] + wu1[e] * u1[e] + wu2[e] * u2[e]; o[e] = gelu_t(gv) * uv; g0[e] = g1[e]; g1[e] = g2[e]; u0[e] = u1[e]; u1[e] = u2[e]; }
            u32x4 r; r.x = pk2(o[0], o[1]); r.y = pk2(o[2], o[3]); r.z = pk2(o[4], o[5]); r.w = pk2(o[6], o[7]);
            *(u32x4*)(act + (size_t)(t0 + tt) * 3072 + gc) = r;
        }
    }
}

DI UE ue_bf16(u16* O, int ldc, int split) { UE e; e.perm = 1; e.kind = 0; e.O = O; e.ldc = ldc; e.split = split; e.gate = nullptr; e.F = nullptr; e.Fin = nullptr; e.ss = nullptr; e.smode = 0; e.HBo = nullptr; e.sso = nullptr; e.ssp = nullptr; e.cnt = nullptr; e.rflags = 0; return e; }
DI GD mkgd(const u16* A, const u16* Bt, int M, int N, int K, int cshift, UE e) { GD d; d.A = A; d.Bt = Bt; d.M = M; d.N = N; d.K = K; d.cshift = cshift; d.e = e; return d; }

#define XB_TMO      128
#define XB_XCNT(j)  (256  + 64 * (j))
#define XB_XSUB(j)  (1280 + 64 * (j))
#define XB_XGEN(j)  (2304 + 64 * (j))
#define XB_TOP      3328
#define XB_TOPGEN   3392
#define XCD_BAR_WORDS 3456
#define XB_SPIN_CAP (1u << 18)

__device__ __forceinline__ unsigned xb_ld(unsigned* p)              { return __hip_atomic_load(p, __ATOMIC_RELAXED, __HIP_MEMORY_SCOPE_AGENT); }
__device__ __forceinline__ unsigned xb_add(unsigned* p, unsigned v) { return __hip_atomic_fetch_add(p, v, __ATOMIC_RELAXED, __HIP_MEMORY_SCOPE_AGENT); }
__device__ __forceinline__ unsigned xb_xcc_id() { return (unsigned)__builtin_amdgcn_s_getreg((3 << 11) | 20) & 0xFu; }
#define XB_SPIN(cond, bar) do { unsigned _sp = 0; while (cond) { __builtin_amdgcn_s_sleep(1); \
    if ((++_sp & 255u) == 0u) { if (xb_ld(&(bar)[XB_TMO])) break; if (_sp > XB_SPIN_CAP) { atomicAdd(&(bar)[XB_TMO], 1u); break; } } } } while (0)

struct XcdBarrier {
    unsigned* bar; unsigned x;
    volatile LAS unsigned* st;
};

__device__ __forceinline__ XcdBarrier xcd_barrier_post(unsigned* bar, volatile LAS unsigned* st) {
    XcdBarrier b; b.bar = bar; b.x = xb_xcc_id(); b.st = st;
    if (threadIdx.x == 0) (void)xb_add(&bar[XB_XCNT(b.x)], 1u);
    return b;
}
__device__ __forceinline__ void xcd_barrier_complete(unsigned* bar, unsigned x, unsigned& nloc, unsigned& nx) {
    const unsigned G = gridDim.x * gridDim.y * gridDim.z;
    unsigned sum, cnt, mine, sp = 0u;
    for (;;) {
        sum = 0u; cnt = 0u; mine = 0u;
#pragma unroll
        for (unsigned j = 0; j < 16; ++j) { const unsigned c = xb_ld(&bar[XB_XCNT(j)]); sum += c; cnt += (c > 0u) ? 1u : 0u; mine = (j == x) ? c : mine; }
        if (sum == G) break;
        __builtin_amdgcn_s_sleep(1);
        if ((++sp & 255u) == 0u) { if (xb_ld(&bar[XB_TMO])) break; if (sp > XB_SPIN_CAP) { atomicAdd(&bar[XB_TMO], 1u); break; } }
    }
    nloc = mine > 0u ? mine : 1u; nx = cnt > 0u ? cnt : 1u;
}

__device__ __forceinline__ void xcd_barrier(const XcdBarrier& b) {
    asm volatile("s_waitcnt vmcnt(0)" ::: "memory");
    __syncthreads();
    if (threadIdx.x == 0) {
        unsigned* bar = b.bar;
        __builtin_amdgcn_s_waitcnt(0);
        unsigned nloc = b.st[0], nx = b.st[1];
        if (nloc == 0u) { xcd_barrier_complete(bar, b.x, nloc, nx); b.st[0] = nloc; b.st[1] = nx; }
        const unsigned old = xb_add(&bar[XB_XSUB(b.x)], 1u);
        const unsigned gen = old / nloc;
        if (old + 1u == (gen + 1u) * nloc) {
            __builtin_amdgcn_fence(__ATOMIC_RELEASE, "agent");
            asm volatile("s_waitcnt vmcnt(0)" ::: "memory");
            const unsigned og = xb_add(&bar[XB_TOP], 1u);
            const unsigned tg = og / nx;
            if (og + 1u == (tg + 1u) * nx) xb_add(&bar[XB_TOPGEN], 1u);
            else XB_SPIN(xb_ld(&bar[XB_TOPGEN]) == tg, bar);
            __builtin_amdgcn_fence(__ATOMIC_ACQUIRE, "agent");
            xb_add(&bar[XB_XGEN(b.x)], 1u);
            asm volatile("s_waitcnt vmcnt(0)" ::: "memory");
        } else {
            XB_SPIN(xb_ld(&bar[XB_XGEN(b.x)]) == gen, bar);
            __builtin_amdgcn_fence(__ATOMIC_ACQUIRE, "agent");
            asm volatile("s_waitcnt vmcnt(0)" ::: "memory");
        }
    }
    __syncthreads();
}

DI int gemm_count(int sub) { return (sub == S_GXR) ? 1 : (sub == S_GQK || sub == S_GAB || sub == S_GMIX) ? 2 : 0; }
DI GD get_gd(const Args& a, int l, int sub, int i) {
    unsigned char* ws = a.ws;
    u16* A0 = (u16*)ws; u16* A1 = (u16*)(ws + U); u16* A2 = (u16*)(ws + 2 * U); u16* A3 = (u16*)(ws + 3 * U); u16* A4 = (u16*)(ws + 4 * U); u16* A5 = (u16*)(ws + 5 * U); u16* A6 = (u16*)(ws + 6 * U);
    u16* WT = (u16*)(ws + WS_WT); u16* MEMN = (u16*)(ws + WS_MEMN); u16* KMEM = A3; u16* VTM = A3 + 2097152;
    float* SS = (float*)(ws + WS_SS);
    const size_t MW = (size_t)1024 * 1024;
    UE er = ue_bf16(nullptr, 1024, 0); er.perm = 1; er.kind = 3; er.ssp = (float*)(ws + WS_SSP); er.cnt = (unsigned*)(ws + WS_CNT) + (size_t)(l * 3 + (sub == S_GMIX ? 0 : sub == S_GWO ? 1 : 2)) * 64; er.Fin = (l == 0 && sub == S_GMIX) ? a.in[0] : a.out; er.F = a.out;
    switch (sub) {
    case S_GQK: { UE eo = ue_bf16(A1, 1024, 0); eo.ss = SS + (size_t)(l * 3) * T; eo.smode = 1; UE ev = ue_bf16(A2, T, 0); ev.ss = SS + (size_t)(l * 3) * T; ev.smode = 2;
        return i == 0 ? mkgd(A0, WT + 2 * MW, T, 1024, 1024, 0, eo) : mkgd(WT + 3 * MW, A0, 1024, T, 1024, 0, ev); }
    case S_GXR: { UE e = ue_bf16(A1, 1024, 1); e.ss = SS + (size_t)(l * 3) * T; e.smode = 1; return mkgd(A0, WT + 4 * MW, T, 4096, 1024, 0, e); }
    case S_GAB: { UE e1 = ue_bf16(nullptr, 1024, 0); e1.perm = 1; e1.kind = 1; e1.gate = A3; e1.O = A1; UE e2 = e1; e2.kind = 2; e2.gate = A4; e2.Fin = (const float*)A1; e2.O = A0;
        return i == 0 ? mkgd(A5, WT + 8 * MW, T, 1024, 1024, 0, e1) : mkgd(A6, WT + 9 * MW, T, 1024, 1024, 0, e2); }
    case S_GMIX: return i == 0 ? mkgd(MEMN, WT + MW, 2048, 1024, 1024, 0, ue_bf16(KMEM, 1024, 0)) : mkgd(WT + 2 * MW, MEMN, 1024, 2048, 1024, 64, ue_bf16(VTM, 2048, 0));
    case S_GWO: er.HBo = A0; er.sso = SS + (size_t)(l * 3 + 2) * T; er.Fin = (const float*)A1; er.rflags = 1; return mkgd(A2, WT + 3 * MW, T, 1024, 1024, 0, er);
    default: er.HBo = A0; er.sso = SS + (size_t)(l * 3 + 3) * T; er.Fin = (const float*)A0; er.rflags = 3; return mkgd(A4, WT + 11 * MW, T, 1024, 3072, 0, er);
    }
}
DI void cvt_set(int mk_tid, LAS unsigned char* lds, const Args& a, int l, int set, int vb = -2, int VG = 0) {
    if (vb == -2) { vb = (int)blockIdx.x; VG = (int)gridDim.x; }
    u16* WT = (u16*)(a.ws + WS_WT); const size_t MW = (size_t)1024 * 1024; int tb = 0; const int nj = set == 0 ? 8 : set == 1 ? 3 : 1;
    for (int j = 0; j < nj; ++j) {
        const float* W; int ldw, col0, ncols, K = 1024, il = 0; u16* dst; const float* gain = nullptr;
        if (set == 0) { const float* win = a.in[3] + (size_t)l * 1024 * 8200;
            if (j < 5) { W = win; ldw = 8200; col0 = (j == 0) ? 2048 : (j == 1) ? 5120 : (j == 2) ? 4096 : (j == 3) ? 0 : 6152; ncols = (j == 1 || j == 2) ? 1024 : 2048; dst = WT + ((j == 0) ? 0 : (j == 1) ? 2 : (j == 2) ? 3 : (j == 3) ? 4 : 6) * MW; gain = a.in[2] + l * 1024; }
            else { W = a.in[15 + (j - 5)] + l * MW; ldw = 1024; col0 = 0; ncols = 1024; dst = WT + (8 + (j - 5)) * MW; } }
        else if (set == 1) { W = (j == 0) ? a.in[19] + l * MW : (j == 1) ? a.in[20] + l * 2 * MW : a.in[21] + l * MW; ldw = (j == 1) ? 2048 : 1024; col0 = 0; ncols = (j == 1) ? 2048 : 1024; dst = WT + ((j == 0) ? 0 : (j == 1) ? 1 : 3) * MW; gain = (j == 0) ? a.in[18] + l * 1024 : nullptr; }
        else if (set == 2) { W = a.in[23] + (size_t)l * 6 * MW; ldw = 6144; col0 = 0; ncols = 6144; il = 1; dst = WT + 4 * MW; gain = a.in[22] + l * 1024; }
        else { W = a.in[26] + (size_t)l * 3 * MW; ldw = 1024; col0 = 0; ncols = 1024; K = 3072; dst = WT + 11 * MW; }
        cvt_w(mk_tid, lds, W, ldw, col0, ncols, K, dst, tb, il, gain, vb, VG);
    }
}
DI void ifg_rows(int mk_tid, LAS unsigned char* lds, const u16* hb, const float* ss, const float* win, const float* g, const float* ifb, float* ifg) {
    const int tid = mk_tid, lane = tid & 63, wid = tid >> 6;
    LAS float* sW = (LAS float*)lds;
    __syncthreads();
    for (int e = tid; e < 8192; e += 512) sW[e] = win[(size_t)(e >> 3) * 8200 + 6144 + (e & 7)] * g[e >> 3];
    __syncthreads();
    for (int r0 = blockIdx.x * 64; r0 < T; r0 += gridDim.x * 64) {
        u16 hv[8][16];
#pragma unroll
        for (int rr = 0; rr < 8; ++rr)
#pragma unroll
            for (int e = 0; e < 16; ++e) hv[rr][e] = hb[(size_t)(r0 + wid * 8 + rr) * 1024 + e * 64 + lane];
#pragma unroll
        for (int rr = 0; rr < 8; ++rr) { const int row = r0 + wid * 8 + rr;
            float a0 = 0, a1 = 0, a2 = 0, a3 = 0, a4 = 0, a5 = 0, a6 = 0, a7 = 0;
#pragma unroll
            for (int e = 0; e < 16; ++e) { const int k = e * 64 + lane; const float y = bf2f(hv[rr][e]); const LAS f32x4* wp = (const LAS f32x4*)(sW + k * 8); const f32x4 w0 = wp[0], w1 = wp[1];
                a0 += y * w0.x; a1 += y * w0.y; a2 += y * w0.z; a3 += y * w0.w; a4 += y * w1.x; a5 += y * w1.y; a6 += y * w1.z; a7 += y * w1.w; }
            a0 = wsum(a0); a1 = wsum(a1); a2 = wsum(a2); a3 = wsum(a3); a4 = wsum(a4); a5 = wsum(a5); a6 = wsum(a6); a7 = wsum(a7);
            if (lane == 0) { const float rs = rsqrtf(ss[row] * (1.f / 1024.f) + 1e-6f); float4 o0, o1; o0.x = a0 * rs + ifb[0]; o0.y = a1 * rs + ifb[1]; o0.z = a2 * rs + ifb[2]; o0.w = a3 * rs + ifb[3]; o1.x = a4 * rs + ifb[4]; o1.y = a5 * rs + ifb[5]; o1.z = a6 * rs + ifb[6]; o1.w = a7 * rs + ifb[7];
                *(float4*)(ifg + (size_t)row * 8) = o0; *(float4*)(ifg + (size_t)row * 8 + 4) = o1; }
            __builtin_amdgcn_sched_barrier(0); }
    }
    __syncthreads();
}
DI void raw_rows(int mk_tid, const float* src, u16* dst, float* ssout) {
    const int lane = mk_tid & 63, gw = blockIdx.x * 8 + (mk_tid >> 6), nw = gridDim.x * 8;
    for (int row = gw; row < T; row += nw) {
        float4 v[4]; float sq = 0.f;
#pragma unroll
        for (int i = 0; i < 4; ++i) { v[i] = *(const float4*)(src + (size_t)row * 1024 + i * 256 + lane * 4); sq += v[i].x * v[i].x + v[i].y * v[i].y + v[i].z * v[i].z + v[i].w * v[i].w; }
        sq = wsum(sq);
#pragma unroll
        for (int i = 0; i < 4; ++i) { u32x2 w; w.x = pk2(v[i].x, v[i].y); w.y = pk2(v[i].z, v[i].w); *(u32x2*)(dst + (size_t)row * 1024 + i * 256 + lane * 4) = w; }
        if (lane == 0) ssout[row] = sq;
    }
}
DI void resid_gemm(int mk_tid, LAS unsigned char* lds, const Args& a, int l, int which, const u16* A, const u16* Bt, int K, const float* Fin, u16* HBo, u16* HB2, int rflags) {
    unsigned char* ws = a.ws;
    Gemm g; g.A = A; g.Bt = Bt; g.M = T; g.N = 1024; g.K = K;
    UE3 e; e.perm = 1; e.Fin = Fin; e.F = a.out; e.HBo = HBo; e.HB2 = HB2; e.sso = (float*)(ws + WS_SS) + (size_t)(l * 3 + which + 1) * T; e.ssp = (float*)(ws + WS_SSP); e.cnt = (unsigned*)(ws + WS_CNT) + (size_t)(l * 3 + which) * 64; e.rflags = rflags;
    StaticOrder S; S.init(T, 1024, (int)gridDim.x, (int)blockIdx.x);
    for (int i = 0; ; ++i) { OneUnit O; if (!S.next(i, O.u)) break; __syncthreads(); gemm_phase<UE3, OneUnit, false>(mk_tid, lds, g, O, e, nullptr); }
}
DI void init_phase(int mk_tid, LAS unsigned char* lds, const Args& a) {
    unsigned char* ws = a.ws; float* SS = (float*)(ws + WS_SS);
    for (int i = blockIdx.x * 512 + mk_tid; i < 1024; i += gridDim.x * 512) ((unsigned*)(ws + WS_CNT))[i] = 0u;
    cvt_set(mk_tid, lds, a, 0, 0);
    raw_rows(mk_tid, a.in[0], (u16*)ws, SS);
    norm_rows(mk_tid, a.in[1], a.in[27], (u16*)(ws + WS_MEMN), 2048, nullptr, nullptr, nullptr);
}
DI void other_phase(int mk_tid, LAS unsigned char* lds, const Args& a, int l, int sub) {
    unsigned char* ws = a.ws;
    u16* A0 = (u16*)ws; u16* A1 = (u16*)(ws + U); u16* A2 = (u16*)(ws + 2 * U); u16* A3 = (u16*)(ws + 3 * U); u16* A4 = (u16*)(ws + 4 * U); u16* A5 = (u16*)(ws + 5 * U); u16* A6 = (u16*)(ws + 6 * U);
    u16* WT = (u16*)(ws + WS_WT); u16* KMEM = A3; u16* VTM = A3 + 2097152;
    float* IFG = (float*)(ws + WS_IFG); float* GZ = (float*)(ws + WS_GZ); float* GM = (float*)(ws + WS_GM); float* GE = (float*)(ws + WS_GE); float* GMS = (float*)(ws + WS_GMS); float* GML = (float*)(ws + WS_GML); float* NVEC = (float*)(ws + WS_NVEC);
    float* SS = (float*)(ws + WS_SS);
    const int tid = mk_tid, wid = tid >> 6;
    const size_t MW = (size_t)1024 * 1024;
    switch (sub) {
    case S_GQK: {
        ifg_rows(mk_tid, lds, A0, SS + (size_t)(l * 3) * T, a.in[3] + (size_t)l * 1024 * 8200, a.in[2] + l * 1024, a.in[13] + l * 8, IFG);
        Gemm g; g.A = A0; g.Bt = WT; g.M = T; g.N = 2048; g.K = 1024;
        UE6 e6; e6.perm = 0; e6.qc = A6; e6.kc = A5; e6.HB = (float*)(ws + WS_HBQ); e6.cw = a.in[11] + l * 8192; e6.cb = a.in[12] + l * 2048; e6.ss = SS + (size_t)(l * 3) * T;
        StaticOrder S; S.init(T, 2048, (int)gridDim.x, (int)blockIdx.x);
        for (int i = 0; ; ++i) { OneUnit O; if (!S.next(i, O.u)) break; __syncthreads(); gemm_phase<UE6, OneUnit, false>(mk_tid, lds, g, O, e6, nullptr); }
    } break;
    case S_STATE: mlstm_state_phase(mk_tid, lds, A5, A2, (float*)(ws + WS_GW), GMS, GML, A3, NVEC, IFG, GZ, GM, GE, (const float*)(ws + WS_HBQ), a.in[11] + l * 8192, a.in[12] + l * 2048); break;
    case S_OUT: mlstm_out_phase(mk_tid, lds, A6, A5, A2, A3, NVEC, A1, GZ, GM, GE, GMS, a.in[14] + l * 1024, 0, (const float*)(ws + WS_HBQ), a.in[11] + l * 8192, a.in[12] + l * 2048); break;
    case S_RG0: case S_RG1:
        if (sub == S_RG0) { cvt_set(mk_tid, lds, a, l, 1); __syncthreads(); }
        rglru_phase(mk_tid, lds, A1, A2, a.in[4] + l * 4096, a.in[5] + l * 1024, a.in[6] + l * 65536, a.in[7] + l * 1024, a.in[8] + l * 65536, a.in[9] + l * 1024, a.in[10] + l * 1024, A5, sub - S_RG0, (float*)(ws + WS_SUMA), (float*)(ws + WS_SUMH)); break;
    case S_GQKV: {
        Gemm g; g.A = A1; g.Bt = WT; g.M = T; g.N = 1024; g.K = 1024;
        UE eq = ue_bf16(A0, 1024, 0); eq.ss = SS + (size_t)(l * 3 + 1) * T; eq.smode = 1;
        StaticOrder S; S.init(T, 1024, (int)gridDim.x, (int)blockIdx.x);
        for (int i = 0; ; ++i) { OneUnit O; if (!S.next(i, O.u)) break; __syncthreads();
            gemm_phase<UE, OneUnit, false>(mk_tid, lds, g, O, eq, nullptr);
            asm volatile("s_waitcnt vmcnt(0)" ::: "memory"); __syncthreads();
            int t2 = mk_tid; asm volatile("" : "+v"(t2));
            xattn_pair(t2, lds, A0, KMEM, VTM, A2, O.u.pm >> 3, O.u.pn, (O.u.pm & 7) * 2); }
    } break;
    case S_GUP: {
        Gemm g; g.A = A0; g.Bt = WT + 4 * MW; g.M = T; g.N = 6144; g.K = 1024;
        UE5 e5; e5.perm = 0; e5.act = A4; e5.HB = (float*)A1; e5.cw = a.in[24] + l * 18432; e5.cb = a.in[25] + l * 6144; e5.ss = SS + (size_t)(l * 3 + 2) * T;
        StaticOrder S; S.init(T, 6144, (int)gridDim.x, (int)blockIdx.x);
        for (int i = 0; ; ++i) { OneUnit O; if (!S.next(i, O.u)) break; __syncthreads(); gemm_phase<UE5, OneUnit, false>(mk_tid, lds, g, O, e5, nullptr); }
    } break;
    case S_GDOWN: {
        if (l == 0) cvt_set(mk_tid, lds, a, 1, 0);
        StaticOrder S; S.init(T, 1024, (int)gridDim.x, (int)blockIdx.x);
        for (int i = 0; ; ++i) { Unit u; if (!S.next(i, u)) break; ffn_fix_tile(mk_tid, (const float*)A1, a.in[24] + l * 18432, a.in[25] + l * 6144, A4, u.pm); }
        asm volatile("s_waitcnt vmcnt(0)" ::: "memory"); __syncthreads();
        resid_gemm(mk_tid, lds, a, l, 2, A4, WT + 11 * MW, 3072, (const float*)A0, A0, (l == 0) ? (u16*)a.out : nullptr, 1);
    } break;
    case S_GMIX: {
        resid_gemm(mk_tid, lds, a, l, 0, A0, WT + 10 * MW, 1024, (l == 0) ? a.in[0] : a.out, A1, nullptr, (l == 0) ? 0 : 1);
        const int G = (int)gridDim.x, blk = (int)blockIdx.x; int vb = blk, VG = G;
        if (G >= 96) { VG = G - 64; vb = (blk < 32 || (blk >= G - 64 && blk < G - 32)) ? -1 : (blk < G - 64 ? blk - 32 : blk - 64); }
        __syncthreads(); cvt_set(mk_tid, lds, a, l, 2, vb, VG);
        __syncthreads(); cvt_set(mk_tid, lds, a, l, 3, vb, VG);
    } break;
    case S_GWO: resid_gemm(mk_tid, lds, a, l, 1, A2, WT + 3 * MW, 1024, (const float*)A1, A0, nullptr, 1); break;
    default: break;
    }
}

__global__ void __launch_bounds__(512, 2) mk_fwd(Args a) {
    extern __shared__ __attribute__((aligned(16))) unsigned char shm[];
    LAS unsigned char* lds = (LAS unsigned char*)shm;
    cg::grid_group grid = cg::this_grid();
    if (a.ph_hi < 0) grid.sync();
    volatile LAS unsigned* xst = (volatile LAS unsigned*)(lds + LDS_BYTES - 16);
    if (threadIdx.x == 0) { xst[0] = 0u; xst[1] = 0u; }
    __syncthreads();
    const XcdBarrier xbar = xcd_barrier_post((unsigned*)(a.ws + WS_BAR), xst);
    int tid0 = threadIdx.x;
    for (int ph = a.ph_lo; ph < a.ph_hi; ++ph) {
        if (ph > a.ph_lo) xcd_barrier(xbar);
        asm volatile("" : "+v"(tid0)); const int mk_tid = tid0;
        if (ph == 0) { init_phase(mk_tid, lds, a); continue; }
        if (ph == NPH - 1) { final_norm(mk_tid, (const u16*)a.ws, a.out, a.in[28]); continue; }
        const int l = (ph - 1) / PL, sub = (ph - 1) % PL;
        const int ng = gemm_count(sub);
        other_phase(mk_tid, lds, a, l, sub);
#if PROBE_DUP
        { const int bit = (sub == S_GQK || sub == S_GUP) ? 2 : (sub == S_STATE) ? 4 : (sub == S_RG0 || sub == S_RG1) ? 8 : (0) ? 16 : (sub == S_GDOWN) ? 32 : 0;
          if (PROBE_DUP & bit) { __syncthreads(); other_phase(mk_tid, lds, a, l, sub); } }
        if (PROBE_DUP & 128) xcd_barrier(xbar);
        if (PROBE_DUP & 1) for (int i = 0; i < ng; ++i) {
            GD d = get_gd(a, l, sub, i); d.e.kind = 4;
            __syncthreads();
            Gemm g; g.A = d.A; g.Bt = d.Bt; g.M = d.M; g.N = d.N; g.K = d.K;
            StaticOrder S; S.init(d.M, d.N, (int)gridDim.x, (int)((blockIdx.x + d.cshift) % gridDim.x));
            gemm_phase<UE, StaticOrder, false>(mk_tid, lds, g, S, d.e, nullptr);
        }
#endif
        for (int i = 0; i < ng; ++i) {
            GD d = get_gd(a, l, sub, i);
            __syncthreads();
            Gemm g; g.A = d.A; g.Bt = d.Bt; g.M = d.M; g.N = d.N; g.K = d.K;
            StaticOrder S; S.init(d.M, d.N, (int)gridDim.x, (int)((blockIdx.x + d.cshift) % gridDim.x));
            gemm_phase<UE, StaticOrder, false>(mk_tid, lds, g, S, d.e, nullptr);
        }
    }
}

extern "C" void kernel_launch(void* const* d_in, const int* in_sizes, int n_in, void* d_out, int out_size, void* d_ws, size_t ws_size, hipStream_t stream) {
    static int grid = 0;
    if (grid == 0) {
        if (n_in != 29 || out_size != T * 1024 || ws_size < WS_END) { fprintf(stderr, "kernel_launch: unexpected shapes (n_in %d out %d ws %zu need %zu)\n", n_in, out_size, ws_size, (size_t)WS_END); grid = -1; return; }
        int dev = 0, cus = 0, per_cu = 0;
        hipGetDevice(&dev); hipDeviceGetAttribute(&cus, hipDeviceAttributeMultiprocessorCount, dev);
        hipFuncSetAttribute((const void*)mk_fwd, hipFuncAttributeMaxDynamicSharedMemorySize, LDS_BYTES);
        hipOccupancyMaxActiveBlocksPerMultiprocessor(&per_cu, (const void*)mk_fwd, 512, LDS_BYTES);
        if (per_cu < 1) per_cu = 1;
        grid = cus * per_cu;
        (void)hipGetLastError();
    }
    if (grid < 0) return;
    Args a{};
    for (int i = 0; i < 29; ++i) a.in[i] = (const float*)d_in[i];
    a.out = (float*)d_out; a.ws = (unsigned char*)d_ws;
#if defined(MK_PER_PHASE)
    for (int ph = 0; ph < NPH; ++ph) { a.ph_lo = ph; a.ph_hi = ph + 1; hipLaunchKernelGGL(mk_fwd, dim3(grid), dim3(512), LDS_BYTES, stream, a); }
#else
    a.ph_lo = 0; a.ph_hi = NPH;
    (void)hipMemsetAsync((unsigned char*)d_ws + WS_BAR, 0, 16384, stream);
    void* args[] = {&a};
    hipError_t e = hipLaunchCooperativeKernel((void*)mk_fwd, dim3(grid), dim3(512), args, LDS_BYTES, stream);
    if (e != hipSuccess) fprintf(stderr, "cooperative launch failed: %s (grid %d)\n", hipGetErrorString(e), grid);
#endif
}
```

```cpp
#include <hip/hip_runtime.h>
#include <hip/hip_cooperative_groups.h>
#include <cstdio>
namespace cg = cooperative_groups;
namespace pg8 {
#define PG8_LAS __attribute__((address_space(3)))
typedef unsigned short bf16_t;
typedef short bf16x8 __attribute__((ext_vector_type(8)));
typedef float f32x4 __attribute__((ext_vector_type(4)));
typedef unsigned u32x4 __attribute__((ext_vector_type(4)));
constexpr int BM = 256, BK = 64, HALF = 128, HTB = HALF * BK * 2  , STAGE_BYTES = 8 * HTB, NXCD = 8, WGM = 8;

__host__ __device__ __forceinline__ int lds_byte(int r, int c) { const int st = (r >> 4) * 2 + (c >> 5), rr = r & 15, cc = c & 31, ob = rr * 64 + cc * 2; return st * 1024 + (ob ^ (((ob >> 9) & 1) << 5)); }
__host__ __device__ __forceinline__ void stage_rc(int b, int& R, int& C) { const int st = b / 1024, sb = b % 1024, swz = sb ^ (((sb >> 9) & 1) << 5); R = (st >> 1) * 16 + swz / 64; C = (st & 1) * 32 + (swz % 64) / 2; }
__host__ __device__ __forceinline__ int perm32(int rho) { const int n = rho >> 4, i = rho & 15; return 8 * (i >> 2) + 4 * n + (i & 3); }

struct Unit { int pm, pn; };
struct Gemm { const bf16_t* A; const bf16_t* Bt; int M, N, K; };

struct StaticOrder {
    int nM, nN, nwg, G, c;
    __host__ __device__ void init(int M, int N, int G_, int c_) { nM = M / BM; nN = N / BM; nwg = nM * nN; G = G_; c = c_; }
    __host__ __device__ bool next(int i, Unit& u) const {
        const long L = (long)i * G + c; if (L >= nwg) return false;
        int wgid = (int)L; { const int q = nwg / NXCD, r = nwg % NXCD, xcd = wgid % NXCD, off = wgid / NXCD; wgid = (xcd < r ? xcd * (q + 1) : r * (q + 1) + (xcd - r) * q) + off; }
        const int nig = WGM * nN, gid = wgid / nig, fm = gid * WGM, gsz = (nM - fm) < WGM ? (nM - fm) : WGM;
        u.pm = fm + ((wgid % nig) % gsz); u.pn = (wgid % nig) / gsz; return true;
    }
    __device__ __forceinline__ void a_ready(const Unit&) const {}
    __device__ __forceinline__ void done(const Unit&) const {}
};
__device__ __forceinline__ unsigned cvt_pk_bf16(float lo, float hi) { unsigned r; asm volatile("v_cvt_pk_bf16_f32 %0, %1, %2" : "=v"(r) : "v"(lo), "v"(hi)); return r; }
typedef float f32x2 __attribute__((ext_vector_type(2)));
template <class Epi, class Sched, bool STAMP = false>
__device__ __forceinline__ void gemm_phase(int mk_tid, PG8_LAS unsigned char* lds, const Gemm g, const Sched& S, const Epi& E, unsigned long long* stamps) {
    const int tid = mk_tid, wid = __builtin_amdgcn_readfirstlane(tid >> 6), lane = tid & 63, wr = wid >> 2, wc = wid & 3, fr = lane & 15, fq = lane >> 4;
    const int K = g.K, nt = K / BK;
    int ts_lo = 0, ts_hi = 0, nts = 0; const unsigned long long rt_entry = STAMP ? (unsigned long long)wall_clock64() : 0ull;
#define PG8_STAMP() do { if (STAMP && wid == 0 && nts < 64) { const unsigned long long _c = (unsigned long long)clock64(); \
        ts_lo = (lane == nts) ? (int)(unsigned)_c : ts_lo; ts_hi = (lane == nts) ? (int)(unsigned)(_c >> 32) : ts_hi; ++nts; } } while (0)
    PG8_STAMP();
    unsigned voffA[2], voffB[2];
#pragma unroll
    for (int i = 0; i < 2; ++i) { int R, C; stage_rc(tid * 16 + i * 8192, R, C); const int Rb = E.perm ? ((R & ~31) + perm32(R & 31)) : R;
        voffA[i] = (unsigned)(R * K + C) * 2u; voffB[i] = (unsigned)(Rb * K + C) * 2u; }
    const size_t kstep = (size_t)(BK * 2);
    const size_t hstep = (size_t)HALF * K * 2;
    const size_t tstep = 2 * hstep;
    const unsigned ldsw = (unsigned)wid * 1024u;
    const int aoff = lds_byte(wr * 64 + fr, fq * 8), boff = lds_byte(wc * 32 + fr, fq * 8);
#define PG8_SA(b, h) (((b) * 2 + (h)) * HTB)
#define PG8_SB(b, h) ((4 + (b) * 2 + (h)) * HTB)
#define PG8_STAGE(bufoff, gbase, voff) do { _Pragma("unroll") for (int _i = 0; _i < 2; ++_i) \
        __builtin_amdgcn_global_load_lds((const unsigned*)((const char*)(gbase) + (voff)[_i]), (PG8_LAS unsigned*)(lds + (bufoff) + ldsw + _i * 8192), 16, 0, 0); } while (0)
#define PG8_LDA(dst, b, h) do { _Pragma("unroll") for (int m = 0; m < 4; ++m) _Pragma("unroll") for (int k = 0; k < 2; ++k) dst[m][k] = *(const PG8_LAS bf16x8*)(lds + PG8_SA(b, h) + aoff + m * 2048 + k * 1024); } while (0)
#define PG8_LDB(dst, b, h) do { _Pragma("unroll") for (int n = 0; n < 2; ++n) _Pragma("unroll") for (int k = 0; k < 2; ++k) dst[n][k] = *(const PG8_LAS bf16x8*)(lds + PG8_SB(b, h) + boff + n * 2048 + k * 1024); } while (0)
#define PG8_MMA(ai, bj, At, Bt) do { __builtin_amdgcn_s_setprio(1); _Pragma("unroll") for (int m = 0; m < 4; ++m) _Pragma("unroll") for (int n = 0; n < 2; ++n) _Pragma("unroll") for (int k = 0; k < 2; ++k) \
        acc[ai][bj][m][n] = __builtin_amdgcn_mfma_f32_16x16x32_bf16(Bt[n][k], At[m][k], acc[ai][bj][m][n], 0, 0, 0); __builtin_amdgcn_s_setprio(0); } while (0)
#define PG8_WAIT_V(n) asm volatile("s_waitcnt vmcnt(" #n ")" ::: "memory")
#define PG8_WAIT_L(n) asm volatile("s_waitcnt lgkmcnt(" #n ")" ::: "memory")
#define PG8_BAR __builtin_amdgcn_s_barrier()
#define PG8_SCHED __builtin_amdgcn_sched_barrier(0)
    Unit cur, nxt; int ui = 0;
    if (!S.next(0, cur)) return;
    f32x4 acc[2][2][4][2];
#pragma unroll
    for (int a = 0; a < 2; ++a)
#pragma unroll
        for (int b = 0; b < 2; ++b)
#pragma unroll
            for (int m = 0; m < 4; ++m)
#pragma unroll
                for (int n = 0; n < 2; ++n) acc[a][b][m][n] = (f32x4){0.f, 0.f, 0.f, 0.f};
    bf16x8 At[4][2], B0[2][2], B1[2][2];
    const char* cA = (const char*)g.A + (size_t)cur.pm * tstep; const char* cB = (const char*)g.Bt + (size_t)cur.pn * tstep;
    S.a_ready(cur);
    PG8_STAGE(PG8_SB(0, 0), cB, voffB); PG8_STAGE(PG8_SA(0, 0), cA, voffA); PG8_STAGE(PG8_SB(0, 1), cB + hstep, voffB); PG8_STAGE(PG8_SA(0, 1), cA + hstep, voffA);
    if (wr == 1) PG8_BAR;
    PG8_WAIT_V(4); PG8_BAR;
    PG8_STAGE(PG8_SB(1, 0), cB + kstep, voffB); PG8_STAGE(PG8_SA(1, 0), cA + kstep, voffA); PG8_STAGE(PG8_SB(1, 1), cB + hstep + kstep, voffB);
    PG8_WAIT_V(6); PG8_BAR;
    PG8_STAMP();
    for (;;) {
        const bool has_next = S.next(ui + 1, nxt);
        const char* nA = has_next ? (const char*)g.A + (size_t)nxt.pm * tstep : cA; const char* nB = has_next ? (const char*)g.Bt + (size_t)nxt.pn * tstep : cB;
        for (int t = 0; t < nt; t += 2) {
            const bool last = (t == nt - 2);
            const char* a1 = cA + (size_t)(t + 1) * kstep;
            const char* a2 = last ? nA : cA + (size_t)(t + 2) * kstep; const char* b2 = last ? nB : cB + (size_t)(t + 2) * kstep;
            const char* a3 = a2 + kstep; const char* b3 = b2 + kstep;
            if (last && has_next) S.a_ready(nxt);
            PG8_LDB(B0, 0, 0); PG8_SCHED; PG8_LDA(At, 0, 0); PG8_STAGE(PG8_SA(1, 1), a1 + hstep, voffA);
            PG8_WAIT_L(8); PG8_BAR; PG8_WAIT_L(0); PG8_MMA(0, 0, At, B0); PG8_BAR; PG8_SCHED;
            PG8_LDB(B1, 0, 1); PG8_STAGE(PG8_SB(0, 0), b2, voffB);
            PG8_BAR; PG8_WAIT_L(0); PG8_MMA(0, 1, At, B1); PG8_BAR;
            PG8_LDA(At, 0, 1); PG8_STAGE(PG8_SA(0, 0), a2, voffA);
            PG8_BAR; PG8_WAIT_L(0); PG8_MMA(1, 0, At, B0); PG8_BAR; PG8_SCHED;
            PG8_STAGE(PG8_SB(0, 1), b2 + hstep, voffB);
            PG8_WAIT_V(6); PG8_BAR; PG8_MMA(1, 1, At, B1); PG8_BAR;
            PG8_LDB(B0, 1, 0); PG8_SCHED; PG8_LDA(At, 1, 0); PG8_STAGE(PG8_SA(0, 1), a2 + hstep, voffA);
            PG8_WAIT_L(8); PG8_BAR; PG8_WAIT_L(0); PG8_MMA(0, 0, At, B0); PG8_BAR; PG8_SCHED;
            PG8_LDB(B1, 1, 1); PG8_STAGE(PG8_SB(1, 0), b3, voffB);
            PG8_BAR; PG8_WAIT_L(0); PG8_MMA(0, 1, At, B1); PG8_BAR;
            PG8_LDA(At, 1, 1); PG8_STAGE(PG8_SA(1, 0), a3, voffA);
            PG8_BAR; PG8_WAIT_L(0); PG8_MMA(1, 0, At, B0); PG8_BAR; PG8_SCHED;
            PG8_STAGE(PG8_SB(1, 1), b3 + hstep, voffB);
            PG8_WAIT_V(6); PG8_BAR; PG8_MMA(1, 1, At, B1); PG8_BAR;
        }
        PG8_STAMP();
        if constexpr (!Epi::AFTER_DRAIN) { E(acc, cur, wr, wc, fr, fq); S.done(cur); }
        PG8_STAMP();
        if (!has_next) break;
#pragma unroll
        for (int a = 0; a < 2; ++a)
#pragma unroll
            for (int b = 0; b < 2; ++b)
#pragma unroll
                for (int m = 0; m < 4; ++m)
#pragma unroll
                    for (int n = 0; n < 2; ++n) acc[a][b][m][n] = (f32x4){0.f, 0.f, 0.f, 0.f};
        cur = nxt; cA = nA; cB = nB; ++ui;
    }
    PG8_WAIT_V(0);
    if (wr == 0) PG8_BAR;
    PG8_BAR;

    if constexpr (Epi::AFTER_DRAIN) { E.fused(acc, cur, wr, wc, fr, fq, lds, wid, lane); }
    PG8_STAMP();
    if (STAMP && wid == 0) { stamps[lane] = lane < nts ? (((unsigned long long)(unsigned)ts_hi << 32) | (unsigned)ts_lo) : 0ull;
        if (lane == 62) stamps[62] = rt_entry; if (lane == 63) stamps[63] = (unsigned long long)wall_clock64(); }
#undef PG8_STAMP
#undef PG8_SA
#undef PG8_SB
#undef PG8_STAGE
#undef PG8_LDA
#undef PG8_LDB
#undef PG8_MMA
#undef PG8_WAIT_V
#undef PG8_WAIT_L
#undef PG8_BAR
#undef PG8_SCHED
}
}

using namespace pg8;
#define DI __device__ __forceinline__
#define LAS PG8_LAS
typedef unsigned short u16;
typedef unsigned u32x2 __attribute__((ext_vector_type(2)));
typedef short s16x4 __attribute__((ext_vector_type(4)));

constexpr int T = 16384, SEQ = 2048;
constexpr int LDS_BYTES = 147456;
constexpr size_t U = (size_t)T * 1024 * 2;
constexpr size_t WS_WT = 7 * U;
constexpr size_t WS_MEMN = WS_WT + (size_t)14336 * 2048;
constexpr size_t WS_SS = WS_MEMN + 4194304;
constexpr size_t WS_SSP = WS_SS + (size_t)7 * T * 4;
constexpr size_t WS_CNT = WS_SSP + (size_t)T * 16 * 4;
constexpr size_t WS_IFG = WS_CNT + 4096;
constexpr size_t WS_GZ = WS_IFG + (size_t)T * 8 * 4;
constexpr size_t WS_GM = WS_GZ + 262144;
constexpr size_t WS_GE = WS_GM + 262144;
constexpr size_t WS_GMS = WS_GE + 262144;
constexpr size_t WS_GML = WS_GMS + 2048;
constexpr size_t WS_NVEC = WS_GML + 2048;
constexpr size_t WS_GW = WS_NVEC + 524288;
constexpr size_t WS_SUMA = WS_GW + 262144;
constexpr size_t WS_SUMH = WS_SUMA + 524288;
constexpr size_t WS_BAR = WS_SUMH + 524288;
constexpr size_t WS_HBQ = WS_BAR + 16384;
constexpr size_t WS_END = WS_HBQ + (size_t)64 * 6 * 2048 * 4;
enum { S_GQK = 0, S_STATE, S_OUT, S_GXR, S_RG0, S_RG1, S_GAB, S_GMIX, S_GQKV, S_GWO, S_GUP, S_GDOWN, PL };
constexpr int NPH = 2 * PL + 2;
#ifndef PROBE_DUP
#define PROBE_DUP 0
#endif

struct Args { const float* in[29]; float* out; unsigned char* ws; int ph_lo, ph_hi; };

DI float bf2f(u16 v) { return __uint_as_float(((unsigned)v) << 16); }
DI float bflo(unsigned v) { return __uint_as_float(v << 16); }
DI float bfhi(unsigned v) { return __uint_as_float(v & 0xffff0000u); }
DI u16 f2bf(float f) { unsigned r; asm("v_cvt_pk_bf16_f32 %0, %1, %1" : "=v"(r) : "v"(f)); return (u16)r; }
DI unsigned pk2(float lo, float hi) { unsigned r; asm("v_cvt_pk_bf16_f32 %0, %1, %2" : "=v"(r) : "v"(lo), "v"(hi)); return r; }
DI float sigm(float x) { return __builtin_amdgcn_rcpf(1.f + __expf(-x)); }
DI float gelu_t(float x) { const float u = 1.5957691216f * (x + 0.044715f * x * x * x); return x * __builtin_amdgcn_rcpf(1.f + __expf(-u)); }
DI float wsum(float v) { v += __shfl_xor(v, 1); v += __shfl_xor(v, 2); v += __shfl_xor(v, 4); v += __shfl_xor(v, 8); v += __shfl_xor(v, 16); v += __shfl_xor(v, 32); return v; }
DI void unpack8(const u32x4 r, float* f) { f[0] = bflo(r.x); f[1] = bfhi(r.x); f[2] = bflo(r.y); f[3] = bfhi(r.y); f[4] = bflo(r.z); f[5] = bfhi(r.z); f[6] = bflo(r.w); f[7] = bfhi(r.w); }
DI f32x4 mfma16(bf16x8 a, bf16x8 b, f32x4 c) { return __builtin_amdgcn_mfma_f32_16x16x32_bf16(a, b, c, 0, 0, 0); }

struct UE {
    static constexpr bool AFTER_DRAIN = false;
    int perm, kind; u16* O; int ldc, split; const u16* gate; float* F; const float* Fin; const float* ss; int smode; u16* HBo; float* sso; float* ssp; unsigned* cnt; int rflags;
    DI void operator()(const f32x4 (&acc)[2][2][4][2], const Unit& u, int wr, int wc, int fr, int fq) const {
        const int row0 = u.pm * 256 + wr * 64 + fr;
        if (kind == 4) return;
        const int col0 = u.pn * 256 + wc * 32 + 8 * fq;
        if (kind == 0) {
            float rs[2][4]; f32x4 cf[2][2];
#pragma unroll
            for (int ai = 0; ai < 2; ++ai)
#pragma unroll
                for (int m = 0; m < 4; ++m) rs[ai][m] = (smode == 1) ? ss[row0 + ai * 128 + m * 16] : 1024.f - 1e-6f * 1024.f;
#pragma unroll
            for (int bj = 0; bj < 2; ++bj)
#pragma unroll
                for (int n = 0; n < 2; ++n) cf[bj][n] = (smode == 2) ? *(const f32x4*)(ss + col0 + bj * 128 + n * 4) : (f32x4){1024.f - 1e-6f * 1024.f, 1024.f - 1e-6f * 1024.f, 1024.f - 1e-6f * 1024.f, 1024.f - 1e-6f * 1024.f};
#pragma unroll
            for (int ai = 0; ai < 2; ++ai)
#pragma unroll
                for (int m = 0; m < 4; ++m) rs[ai][m] = rsqrtf(rs[ai][m] * (1.f / 1024.f) + 1e-6f);
#pragma unroll
            for (int bj = 0; bj < 2; ++bj)
#pragma unroll
                for (int n = 0; n < 2; ++n)
#pragma unroll
                    for (int j = 0; j < 4; ++j) cf[bj][n][j] = rsqrtf(cf[bj][n][j] * (1.f / 1024.f) + 1e-6f);
            __builtin_amdgcn_sched_barrier(0);
#pragma unroll
            for (int ai = 0; ai < 2; ++ai)
#pragma unroll
                for (int m = 0; m < 4; ++m) { const int row = row0 + ai * 128 + m * 16;
#pragma unroll
                    for (int bj = 0; bj < 2; ++bj) { const int col = col0 + bj * 128;
                        u16* p = split ? O + (size_t)(col >> 10) * ((size_t)T * 1024) + (size_t)row * 1024 + (col & 1023) : O + (size_t)row * ldc + col;
                        const f32x4 v0 = acc[ai][bj][m][0] * rs[ai][m] * cf[bj][0], v1 = acc[ai][bj][m][1] * rs[ai][m] * cf[bj][1];
                        u32x4 w; w.x = cvt_pk_bf16(v0[0], v0[1]); w.y = cvt_pk_bf16(v0[2], v0[3]); w.z = cvt_pk_bf16(v1[0], v1[1]); w.w = cvt_pk_bf16(v1[2], v1[3]);
                        *(u32x4*)p = w; } }
        } else {
#pragma unroll
            for (int aim = 0; aim < 4; ++aim) { const int ai = aim >> 1, mb = (aim & 1) * 2;
                f32x4 ld[4][2][2];
#pragma unroll
                for (int m = mb; m < mb + 2; ++m)
#pragma unroll
                    for (int bj = 0; bj < 2; ++bj) { const size_t idx = (size_t)(row0 + ai * 128 + m * 16) * 1024 + col0 + bj * 128;
                        if (kind == 3) { if (rflags & 1) { ld[m][bj][0] = *(const f32x4*)((const u16*)Fin + idx); ld[m][bj][1] = (f32x4){0.f, 0.f, 0.f, 0.f}; } else { ld[m][bj][0] = *(const f32x4*)(Fin + idx); ld[m][bj][1] = *(const f32x4*)(Fin + idx + 4); } }
                        else { ld[m][bj][0] = *(const f32x4*)(gate + idx); ld[m][bj][1] = (kind == 2) ? *(const f32x4*)((const u16*)Fin + idx) : (f32x4){0.f, 0.f, 0.f, 0.f}; } }
                __builtin_amdgcn_sched_barrier(0);
#pragma unroll
                for (int m = mb; m < mb + 2; ++m) { const int row = row0 + ai * 128 + m * 16; float psq = 0.f;
#pragma unroll
                    for (int bj = 0; bj < 2; ++bj) { const size_t idx = (size_t)row * 1024 + col0 + bj * 128; const f32x4 v0 = acc[ai][bj][m][0], v1 = acc[ai][bj][m][1];
                        if (kind == 3) { f32x4 b0 = ld[m][bj][0], b1 = ld[m][bj][1];
                            if (rflags & 1) { const u32x4 rb = __builtin_bit_cast(u32x4, ld[m][bj][0]); b0 = (f32x4){bflo(rb.x), bfhi(rb.x), bflo(rb.y), bfhi(rb.y)}; b1 = (f32x4){bflo(rb.z), bfhi(rb.z), bflo(rb.w), bfhi(rb.w)}; }
                            const f32x4 h0 = b0 + v0, h1 = b1 + v1; if (rflags & 2) { *(f32x4*)(F + idx) = h0; *(f32x4*)(F + idx + 4) = h1; }
                            u32x4 hw; hw.x = cvt_pk_bf16(h0[0], h0[1]); hw.y = cvt_pk_bf16(h0[2], h0[3]); hw.z = cvt_pk_bf16(h1[0], h1[1]); hw.w = cvt_pk_bf16(h1[2], h1[3]); *(u32x4*)(HBo + idx) = hw;
                            psq += (h0[0] * h0[0] + h0[1] * h0[1]) + (h0[2] * h0[2] + h0[3] * h0[3]) + (h1[0] * h1[0] + h1[1] * h1[1]) + (h1[2] * h1[2] + h1[3] * h1[3]); }
                        else { const u32x4 gr = __builtin_bit_cast(u32x4, ld[m][bj][0]);
                            f32x4 s0, s1; s0[0] = sigm(bflo(gr.x)); s0[1] = sigm(bfhi(gr.x)); s0[2] = sigm(bflo(gr.y)); s0[3] = sigm(bfhi(gr.y)); s1[0] = sigm(bflo(gr.z)); s1[1] = sigm(bfhi(gr.z)); s1[2] = sigm(bflo(gr.w)); s1[3] = sigm(bfhi(gr.w));
                            f32x4 r0 = s0 * v0, r1 = s1 * v1;
                            if (kind == 2) { const u32x4 yb = __builtin_bit_cast(u32x4, ld[m][bj][1]);
                                r0[0] += bflo(yb.x); r0[1] += bfhi(yb.x); r0[2] += bflo(yb.y); r0[3] += bfhi(yb.y); r1[0] += bflo(yb.z); r1[1] += bfhi(yb.z); r1[2] += bflo(yb.w); r1[3] += bfhi(yb.w); }
                            u32x4 w; w.x = cvt_pk_bf16(r0[0], r0[1]); w.y = cvt_pk_bf16(r0[2], r0[3]); w.z = cvt_pk_bf16(r1[0], r1[1]); w.w = cvt_pk_bf16(r1[2], r1[3]);
                            *(u32x4*)(O + idx) = w; } }
                    if (kind == 3) { psq += __shfl_xor(psq, 16); psq += __shfl_xor(psq, 32); if (fq == 0) __hip_atomic_store(ssp + (size_t)row * 16 + u.pn * 4 + wc, psq, __ATOMIC_RELAXED, __HIP_MEMORY_SCOPE_AGENT); } }
                __builtin_amdgcn_sched_barrier(0);
            }
            if (kind == 3) {
                asm volatile("s_waitcnt vmcnt(0)" ::: "memory");
                const int lane = fq * 16 + fr; unsigned old = 0u;
                if (lane == 0) old = __hip_atomic_fetch_add(cnt + u.pm, 1u, __ATOMIC_RELAXED, __HIP_MEMORY_SCOPE_AGENT);
                old = (unsigned)__builtin_amdgcn_readfirstlane((int)old);
                if (old == 31u) {
                    for (int r = lane; r < 256; r += 64) { const size_t row = (size_t)u.pm * 256 + r; float t = 0.f;
#pragma unroll 4
                        for (int k = 0; k < 16; ++k) t += __hip_atomic_load(ssp + row * 16 + k, __ATOMIC_RELAXED, __HIP_MEMORY_SCOPE_AGENT);
                        sso[row] = t; } }
            }
        }
    }
};
struct UE3 {
    static constexpr bool AFTER_DRAIN = true;
    int perm; const float* Fin; float* F; u16* HBo; u16* HB2; float* sso; float* ssp; unsigned* cnt; int rflags;
    DI void operator()(const f32x4 (&)[2][2][4][2], const Unit&, int, int, int, int) const {}
    DI void fused(const f32x4 (&acc)[2][2][4][2], const Unit& u, int wr, int wc, int fr, int fq, LAS unsigned char* lds, int wid, int lane) const {
        LAS float* P = (LAS float*)lds;
        LAS unsigned* flag = (LAS unsigned*)(lds + 8192);
        const int tid = wid * 64 + lane, row0 = u.pm * 256 + wr * 64 + fr, col0 = u.pn * 256 + wc * 32 + 8 * fq;
#pragma unroll
        for (int aim = 0; aim < 4; ++aim) { const int ai = aim >> 1, mb = (aim & 1) * 2;
            f32x4 ld[4][2][2];
#pragma unroll
            for (int m = mb; m < mb + 2; ++m)
#pragma unroll
                for (int bj = 0; bj < 2; ++bj) { const size_t idx = (size_t)(row0 + ai * 128 + m * 16) * 1024 + col0 + bj * 128;
                    if (rflags & 1) { ld[m][bj][0] = *(const f32x4*)((const u16*)Fin + idx); ld[m][bj][1] = (f32x4){0.f, 0.f, 0.f, 0.f}; } else { ld[m][bj][0] = *(const f32x4*)(Fin + idx); ld[m][bj][1] = *(const f32x4*)(Fin + idx + 4); } }
            __builtin_amdgcn_sched_barrier(0);
#pragma unroll
            for (int m = mb; m < mb + 2; ++m) { const int row = row0 + ai * 128 + m * 16; float psq = 0.f;
#pragma unroll
                for (int bj = 0; bj < 2; ++bj) { const size_t idx = (size_t)row * 1024 + col0 + bj * 128; const f32x4 v0 = acc[ai][bj][m][0], v1 = acc[ai][bj][m][1];
                    f32x4 b0 = ld[m][bj][0], b1 = ld[m][bj][1];
                    if (rflags & 1) { const u32x4 rb = __builtin_bit_cast(u32x4, ld[m][bj][0]); b0 = (f32x4){bflo(rb.x), bfhi(rb.x), bflo(rb.y), bfhi(rb.y)}; b1 = (f32x4){bflo(rb.z), bfhi(rb.z), bflo(rb.w), bfhi(rb.w)}; }
                    const f32x4 h0 = b0 + v0, h1 = b1 + v1; if (rflags & 2) { *(f32x4*)(F + idx) = h0; *(f32x4*)(F + idx + 4) = h1; }
                    u32x4 hw; hw.x = cvt_pk_bf16(h0[0], h0[1]); hw.y = cvt_pk_bf16(h0[2], h0[3]); hw.z = cvt_pk_bf16(h1[0], h1[1]); hw.w = cvt_pk_bf16(h1[2], h1[3]); *(u32x4*)(HBo + idx) = hw; if (HB2) *(u32x4*)(HB2 + idx) = hw;
                    psq += (h0[0] * h0[0] + h0[1] * h0[1]) + (h0[2] * h0[2] + h0[3] * h0[3]) + (h1[0] * h1[0] + h1[1] * h1[1]) + (h1[2] * h1[2] + h1[3] * h1[3]); }
                psq += __shfl_xor(psq, 16); psq += __shfl_xor(psq, 32);
                if (fq == 0) P[(ai * 128 + wr * 64 + m * 16 + fr) * 4 + wc] = psq; }
            __builtin_amdgcn_sched_barrier(0);
        }
        __syncthreads();
        if (tid < 256) { const float t = (P[tid * 4] + P[tid * 4 + 1]) + (P[tid * 4 + 2] + P[tid * 4 + 3]); __hip_atomic_store(ssp + ((size_t)u.pm * 256 + tid) * 4 + u.pn, t, __ATOMIC_RELAXED, __HIP_MEMORY_SCOPE_AGENT); }
        asm volatile("s_waitcnt vmcnt(0)" ::: "memory");
        __syncthreads();
        if (tid == 0) flag[0] = __hip_atomic_fetch_add(cnt + u.pm, 1u, __ATOMIC_RELAXED, __HIP_MEMORY_SCOPE_AGENT);
        __syncthreads();
        if (flag[0] == 3u && tid < 256) { const size_t row = (size_t)u.pm * 256 + tid;
            const float t0 = __hip_atomic_load(ssp + row * 4, __ATOMIC_RELAXED, __HIP_MEMORY_SCOPE_AGENT), t1 = __hip_atomic_load(ssp + row * 4 + 1, __ATOMIC_RELAXED, __HIP_MEMORY_SCOPE_AGENT),
                        t2 = __hip_atomic_load(ssp + row * 4 + 2, __ATOMIC_RELAXED, __HIP_MEMORY_SCOPE_AGENT), t3 = __hip_atomic_load(ssp + row * 4 + 3, __ATOMIC_RELAXED, __HIP_MEMORY_SCOPE_AGENT);
            sso[row] = (t0 + t1) + (t2 + t3); }
        __syncthreads();
    }
};
struct OneUnit { Unit u; DI bool next(int i, Unit& o) const { if (i != 0) return false; o = u; return true; } DI void a_ready(const Unit&) const {} DI void done(const Unit&) const {} };
struct UE5 {
    static constexpr bool AFTER_DRAIN = true;
    int perm; u16* act; float* HB; const float* cw; const float* cb; const float* ss;
    DI void operator()(const f32x4 (&)[2][2][4][2], const Unit&, int, int, int, int) const {}
    DI void fused(const f32x4 (&acc)[2][2][4][2], const Unit& u, int wr, int wc, int fr, int fq, LAS unsigned char* lds, int wid, int lane) const {
        LAS float* tl = (LAS float*)lds;
        LAS float* side = (LAS float*)(lds + 133120);
        const int tid = wid * 64 + lane, q = tid & 31, rsub = tid >> 5, ch = u.pn * 128 + q * 4;
        const f32x4 g0 = *(const f32x4*)(cw + ch), g1 = *(const f32x4*)(cw + 6144 + ch), g2 = *(const f32x4*)(cw + 12288 + ch), gb = *(const f32x4*)(cb + ch);
        const f32x4 u0 = *(const f32x4*)(cw + 3072 + ch), u1 = *(const f32x4*)(cw + 6144 + 3072 + ch), u2 = *(const f32x4*)(cw + 12288 + 3072 + ch), ub = *(const f32x4*)(cb + 3072 + ch);
#pragma unroll
        for (int ai = 0; ai < 2; ++ai) {
            if (ai == 1) {
                __syncthreads();
            }
#pragma unroll
            for (int m = 0; m < 4; ++m) { const float rs = rsqrtf(ss[u.pm * 256 + ai * 128 + wr * 64 + m * 16 + fr] * (1.f / 1024.f) + 1e-6f);
#pragma unroll
                for (int bj = 0; bj < 2; ++bj)
#pragma unroll
                    for (int n = 0; n < 2; ++n) *(LAS f32x4*)(tl + (wr * 64 + m * 16 + fr) * 260 + bj * 128 + wc * 32 + n * 16 + 4 * fq) = acc[ai][bj][m][n] * rs; }
            __syncthreads();
            if (ai == 0) {
                if (tid < 128) { const int rr = tid >> 6, cq = tid & 63; const f32x4 v = *(const LAS f32x4*)(tl + rr * 260 + cq * 4);
                    *(f32x4*)(HB + ((size_t)u.pm * 4 + rr) * 6144 + (cq < 32 ? u.pn * 128 + cq * 4 : 3072 + u.pn * 128 + (cq - 32) * 4)) = v; }
            } else {
                if (tid < 128) { const int rr = tid >> 6, cq = tid & 63; const f32x4 v = *(const LAS f32x4*)(tl + (126 + rr) * 260 + cq * 4);
                    *(f32x4*)(HB + ((size_t)u.pm * 4 + 2 + rr) * 6144 + (cq < 32 ? u.pn * 128 + cq * 4 : 3072 + u.pn * 128 + (cq - 32) * 4)) = v; }
            }
#pragma unroll 2
            for (int it = 0; it < 8; ++it) {
                const int row = it * 16 + rsub;
                const f32x4 xg = *(const LAS f32x4*)(tl + row * 260 + q * 4), xu = *(const LAS f32x4*)(tl + row * 260 + 128 + q * 4);
                f32x4 p1g, p1u, p2g, p2u; bool ok = true;
                if (row >= 2) { p1g = *(const LAS f32x4*)(tl + (row - 1) * 260 + q * 4); p1u = *(const LAS f32x4*)(tl + (row - 1) * 260 + 128 + q * 4); p2g = *(const LAS f32x4*)(tl + (row - 2) * 260 + q * 4); p2u = *(const LAS f32x4*)(tl + (row - 2) * 260 + 128 + q * 4); }
                else if (ai == 1) {
                    if (row == 1) { p1g = *(const LAS f32x4*)(tl + q * 4); p1u = *(const LAS f32x4*)(tl + 128 + q * 4); p2g = *(const LAS f32x4*)(side + 260 + q * 4); p2u = *(const LAS f32x4*)(side + 260 + 128 + q * 4); }
                    else { p1g = *(const LAS f32x4*)(side + 260 + q * 4); p1u = *(const LAS f32x4*)(side + 260 + 128 + q * 4); p2g = *(const LAS f32x4*)(side + q * 4); p2u = *(const LAS f32x4*)(side + 128 + q * 4); }
                } else { ok = false; p1g = xg; p1u = xu; p2g = xg; p2u = xu; }
                const f32x4 gv = gb + g0 * p2g + g1 * p1g + g2 * xg, uv = ub + u0 * p2u + u1 * p1u + u2 * xu;
                if (ok) { u32x2 w; w.x = cvt_pk_bf16(gelu_t(gv[0]) * uv[0], gelu_t(gv[1]) * uv[1]); w.y = cvt_pk_bf16(gelu_t(gv[2]) * uv[2], gelu_t(gv[3]) * uv[3]);
                    *(u32x2*)(act + ((size_t)u.pm * 256 + ai * 128 + row) * 3072 + ch) = w; }
            }
            if (ai == 0) {
                if (tid < 128) { const int rr = tid >> 6, cq = tid & 63; *(LAS f32x4*)(side + rr * 260 + cq * 4) = *(const LAS f32x4*)(tl + (126 + rr) * 260 + cq * 4); }
            }
        }
        __syncthreads();
    }
};
DI void ffn_fix_tile(int mk_tid, const float* HB, const float* cw, const float* cb, u16* act, int pm) {
    for (int item = mk_tid; item < 2 * 768; item += 512) {
        const int cq = item % 768, j = item / 768, ch = cq * 4; const bool hp = (pm & 7) != 0;
        const f32x4 z4 = (f32x4){0.f, 0.f, 0.f, 0.f};
        const float* cur = HB + ((size_t)pm * 4 + j) * 6144 + ch; const float* f0 = HB + ((size_t)pm * 4) * 6144 + ch;
        const float* l0 = HB + ((size_t)(pm - 1) * 4 + 2) * 6144 + ch; const float* l1 = HB + ((size_t)(pm - 1) * 4 + 3) * 6144 + ch;
        const f32x4 xg = *(const f32x4*)cur, xu = *(const f32x4*)(cur + 3072);
        f32x4 p1g, p1u, p2g, p2u;
        if (j == 1) { p1g = *(const f32x4*)f0; p1u = *(const f32x4*)(f0 + 3072); p2g = hp ? *(const f32x4*)l1 : z4; p2u = hp ? *(const f32x4*)(l1 + 3072) : z4; }
        else { p1g = hp ? *(const f32x4*)l1 : z4; p1u = hp ? *(const f32x4*)(l1 + 3072) : z4; p2g = hp ? *(const f32x4*)l0 : z4; p2u = hp ? *(const f32x4*)(l0 + 3072) : z4; }
        const f32x4 wg0 = *(const f32x4*)(cw + ch), wg1 = *(const f32x4*)(cw + 6144 + ch), wg2 = *(const f32x4*)(cw + 12288 + ch), bg = *(const f32x4*)(cb + ch);
        const f32x4 wu0 = *(const f32x4*)(cw + 3072 + ch), wu1 = *(const f32x4*)(cw + 6144 + 3072 + ch), wu2 = *(const f32x4*)(cw + 12288 + 3072 + ch), bu = *(const f32x4*)(cb + 3072 + ch);
        const f32x4 gv = bg + wg0 * p2g + wg1 * p1g + wg2 * xg, uv = bu + wu0 * p2u + wu1 * p1u + wu2 * xu;
        u32x2 w; w.x = pk2(gelu_t(gv[0]) * uv[0], gelu_t(gv[1]) * uv[1]); w.y = pk2(gelu_t(gv[2]) * uv[2], gelu_t(gv[3]) * uv[3]);
        *(u32x2*)(act + ((size_t)pm * 256 + j) * 3072 + ch) = w;
    }
}

struct UE6 {
    static constexpr bool AFTER_DRAIN = true;
    int perm; u16* qc; u16* kc; float* HB; const float* cw; const float* cb; const float* ss;
    DI void operator()(const f32x4 (&)[2][2][4][2], const Unit&, int, int, int, int) const {}
    DI void fused(const f32x4 (&acc)[2][2][4][2], const Unit& u, int wr, int wc, int fr, int fq, LAS unsigned char* lds, int wid, int lane) const {
        LAS float* tl = (LAS float*)lds;
        LAS float* side = (LAS float*)(lds + 133120);
        const int tid = wid * 64 + lane, q = tid & 63, rsub = tid >> 6, ch = u.pn * 256 + q * 4;
        const f32x4 w0 = *(const f32x4*)(cw + ch), w1 = *(const f32x4*)(cw + 2048 + ch), w2 = *(const f32x4*)(cw + 4096 + ch), w3 = *(const f32x4*)(cw + 6144 + ch), bb = *(const f32x4*)(cb + ch);
        u16* dst = (ch < 1024) ? qc + ch : kc + (ch - 1024); const float sc = (ch < 1024) ? 1.f : 0.0625f;
#pragma unroll
        for (int ai = 0; ai < 2; ++ai) {
            if (ai == 1) __syncthreads();
#pragma unroll
            for (int m = 0; m < 4; ++m) { const float rs = rsqrtf(ss[u.pm * 256 + ai * 128 + wr * 64 + m * 16 + fr] * (1.f / 1024.f) + 1e-6f);
#pragma unroll
                for (int bj = 0; bj < 2; ++bj)
#pragma unroll
                    for (int n = 0; n < 2; ++n) *(LAS f32x4*)(tl + (wr * 64 + m * 16 + fr) * 260 + bj * 128 + wc * 32 + n * 16 + 4 * fq) = acc[ai][bj][m][n] * rs; }
            __syncthreads();
            if (tid < 192) { const int rr = tid >> 6, cq = tid & 63; const f32x4 v = *(const LAS f32x4*)(tl + ((ai == 0 ? 0 : 125) + rr) * 260 + cq * 4);
                *(f32x4*)(HB + ((size_t)u.pm * 6 + (ai == 0 ? 0 : 3) + rr) * 2048 + u.pn * 256 + cq * 4) = v; }
#pragma unroll 2
            for (int it = 0; it < 16; ++it) {
                const int row = it * 8 + rsub;
                const f32x4 x = *(const LAS f32x4*)(tl + row * 260 + q * 4);
                f32x4 p1, p2, p3; bool ok = true;
                if (row >= 3) { p1 = *(const LAS f32x4*)(tl + (row - 1) * 260 + q * 4); p2 = *(const LAS f32x4*)(tl + (row - 2) * 260 + q * 4); p3 = *(const LAS f32x4*)(tl + (row - 3) * 260 + q * 4); }
                else if (ai == 1) {
                    p1 = (row >= 1) ? *(const LAS f32x4*)(tl + (row - 1) * 260 + q * 4) : *(const LAS f32x4*)(side + 2 * 260 + q * 4);
                    p2 = (row >= 2) ? *(const LAS f32x4*)(tl + (row - 2) * 260 + q * 4) : *(const LAS f32x4*)(side + (1 + row) * 260 + q * 4);
                    p3 = *(const LAS f32x4*)(side + row * 260 + q * 4);
                } else { ok = false; p1 = x; p2 = x; p3 = x; }
                const f32x4 v = bb + w0 * p3 + w1 * p2 + w2 * p1 + w3 * x;
                if (ok) { u32x2 w; w.x = cvt_pk_bf16(sc * v[0] * sigm(v[0]), sc * v[1] * sigm(v[1])); w.y = cvt_pk_bf16(sc * v[2] * sigm(v[2]), sc * v[3] * sigm(v[3]));
                    *(u32x2*)(dst + ((size_t)u.pm * 256 + ai * 128 + row) * 1024) = w; }
            }
            if (ai == 0) { if (tid < 192) { const int rr = tid >> 6, cq = tid & 63; *(LAS f32x4*)(side + rr * 260 + cq * 4) = *(const LAS f32x4*)(tl + (125 + rr) * 260 + cq * 4); } }
        }
        __syncthreads();
    }
};
DI void qk_fix_local(int mk_tid, const float* HB, const float* cw, const float* cb, u16* dst, int chg, int pm0, int npm) {
    for (int item = mk_tid; item < npm * 3 * 64; item += 512) {
        const int cq = item & 63, rr = item >> 6, pmi = rr / 3, j = rr - pmi * 3, pm = pm0 + pmi, ch = chg + cq * 4; const bool hp = (pm & 7) != 0;
        const f32x4 z4 = (f32x4){0.f, 0.f, 0.f, 0.f};
        const float* me = HB + (size_t)pm * 6 * 2048 + ch; const float* pv = HB + (size_t)(pm - 1) * 6 * 2048 + ch;
        const f32x4 x = *(const f32x4*)(me + j * 2048);
        f32x4 p[3];
#pragma unroll
        for (int k = 1; k <= 3; ++k) { const int r = j - k; p[k - 1] = (r >= 0) ? *(const f32x4*)(me + r * 2048) : (hp ? *(const f32x4*)(pv + (6 + r) * 2048) : z4); }
        const f32x4 w0 = *(const f32x4*)(cw + ch), w1 = *(const f32x4*)(cw + 2048 + ch), w2 = *(const f32x4*)(cw + 4096 + ch), w3 = *(const f32x4*)(cw + 6144 + ch), bb = *(const f32x4*)(cb + ch);
        const f32x4 v = bb + w0 * p[2] + w1 * p[1] + w2 * p[0] + w3 * x;
        const float sc = (ch < 1024) ? 1.f : 0.0625f;
        u32x2 w; w.x = pk2(sc * v[0] * sigm(v[0]), sc * v[1] * sigm(v[1])); w.y = pk2(sc * v[2] * sigm(v[2]), sc * v[3] * sigm(v[3]));
        *(u32x2*)(dst + ((size_t)pm * 256 + j) * 1024 + (ch & 1023)) = w;
    }
}
DI void qk_fix_phase(int mk_tid, const float* HB, const float* cw, const float* cb, u16* qc, u16* kc) {
    const int gtid = blockIdx.x * 512 + mk_tid, nth = gridDim.x * 512;
    for (int item = gtid; item < 192 * 512; item += nth) {
        const int cq = item & 511, rr = item >> 9, pm = rr / 3, j = rr - pm * 3, ch = cq * 4; const bool hp = (pm & 7) != 0;
        const f32x4 z4 = (f32x4){0.f, 0.f, 0.f, 0.f};
        const float* me = HB + (size_t)pm * 6 * 2048 + ch; const float* pv = HB + (size_t)(pm - 1) * 6 * 2048 + ch;
        const f32x4 x = *(const f32x4*)(me + j * 2048);
        f32x4 p[3];
#pragma unroll
        for (int k = 1; k <= 3; ++k) { const int r = j - k; p[k - 1] = (r >= 0) ? *(const f32x4*)(me + r * 2048) : (hp ? *(const f32x4*)(pv + (6 + r) * 2048) : z4); }
        const f32x4 w0 = *(const f32x4*)(cw + ch), w1 = *(const f32x4*)(cw + 2048 + ch), w2 = *(const f32x4*)(cw + 4096 + ch), w3 = *(const f32x4*)(cw + 6144 + ch), bb = *(const f32x4*)(cb + ch);
        const f32x4 v = bb + w0 * p[2] + w1 * p[1] + w2 * p[0] + w3 * x;
        u16* dst = (ch < 1024) ? qc + ch : kc + (ch - 1024); const float sc = (ch < 1024) ? 1.f : 0.0625f;
        u32x2 w; w.x = pk2(sc * v[0] * sigm(v[0]), sc * v[1] * sigm(v[1])); w.y = pk2(sc * v[2] * sigm(v[2]), sc * v[3] * sigm(v[3]));
        *(u32x2*)(dst + ((size_t)pm * 256 + j) * 1024) = w;
    }
}

struct GD { const u16* A; const u16* Bt; int M, N, K, cshift; UE e; };

DI void cvt_w(int mk_tid, LAS unsigned char* lds, const float* W, int ldw, int col0, int ncols, int K, u16* dst, int& tb, int il, const float* gain, int vb, int VG) {
    LAS float* tile = (LAS float*)lds;
    const int tid = mk_tid, G = VG; const int ntn = ncols >> 8, nt = ntn * (K >> 6);
    int i0 = (vb - tb) % G; if (i0 < 0) i0 += G; if (vb < 0) i0 = nt;
    for (int i = i0; i < nt; i += G) {
        const int tn = i % ntn, tk = i / ntn;
        __syncthreads();
        const float* src = W + (size_t)(tk * 64) * ldw + col0 + (il ? tn * 128 : tn * 256);
#pragma unroll 16
        for (int e = tid; e < 16384; e += 512) { const int r = e >> 8, c = e & 255; const int cs = (il && c >= 128) ? c + 3072 - 128 : c; tile[r * 257 + c] = src[(size_t)r * ldw + cs]; }
        __syncthreads();
        u16* dp = dst + (size_t)(tn * 256) * K + tk * 64; const float gk0 = gain ? gain[tk * 64 + (tid & 31) * 2] : 1.f, gk1 = gain ? gain[tk * 64 + (tid & 31) * 2 + 1] : 1.f;
#pragma unroll 4
        for (int e = tid; e < 8192; e += 512) { const int n = e >> 5, k2 = (e & 31) * 2; *(unsigned*)(dp + (size_t)n * K + k2) = pk2(tile[k2 * 257 + n] * gk0, tile[(k2 + 1) * 257 + n] * gk1); }
    }
    tb = (tb + nt) % G;
}

DI void norm_rows(int mk_tid, const float* src, const float* g, u16* dst, int nrows, const LAS float* sW, const float* ifb, float* ifg) {
    const int lane = mk_tid & 63, gw = blockIdx.x * 8 + (mk_tid >> 6), nw = gridDim.x * 8;
    for (int row0 = gw; row0 < nrows; row0 += 4 * nw) {
        float4 v[4][4];
#pragma unroll
        for (int r = 0; r < 4; ++r) { const int row = row0 + r * nw; if (row < nrows) {
#pragma unroll
            for (int i = 0; i < 4; ++i) v[r][i] = *(const float4*)(src + (size_t)row * 1024 + i * 256 + lane * 4); } }
        float4 gv[4];
#pragma unroll
        for (int i = 0; i < 4; ++i) gv[i] = *(const float4*)(g + i * 256 + lane * 4);
#pragma unroll
        for (int r = 0; r < 4; ++r) { const int row = row0 + r * nw; if (row < nrows) {
            float ss = 0.f;
#pragma unroll
            for (int i = 0; i < 4; ++i) ss += v[r][i].x * v[r][i].x + v[r][i].y * v[r][i].y + v[r][i].z * v[r][i].z + v[r][i].w * v[r][i].w;
            ss = wsum(ss); const float rinv = rsqrtf(ss * (1.f / 1024.f) + 1e-6f);
#pragma unroll
            for (int i = 0; i < 4; ++i) { v[r][i].x *= rinv * gv[i].x; v[r][i].y *= rinv * gv[i].y; v[r][i].z *= rinv * gv[i].z; v[r][i].w *= rinv * gv[i].w;
                u32x2 w; w.x = pk2(v[r][i].x, v[r][i].y); w.y = pk2(v[r][i].z, v[r][i].w); *(u32x2*)(dst + (size_t)row * 1024 + i * 256 + lane * 4) = w; }
            if (sW) {
                float a0 = 0, a1 = 0, a2 = 0, a3 = 0, a4 = 0, a5 = 0, a6 = 0, a7 = 0;
#pragma unroll
                for (int i = 0; i < 4; ++i) { const float y[4] = {v[r][i].x, v[r][i].y, v[r][i].z, v[r][i].w};
#pragma unroll
                    for (int e = 0; e < 4; ++e) { const int k = i * 256 + lane * 4 + e; const LAS f32x4* wp = (const LAS f32x4*)(sW + k * 8); const f32x4 w0 = wp[0], w1 = wp[1];
                        a0 += y[e] * w0.x; a1 += y[e] * w0.y; a2 += y[e] * w0.z; a3 += y[e] * w0.w; a4 += y[e] * w1.x; a5 += y[e] * w1.y; a6 += y[e] * w1.z; a7 += y[e] * w1.w; } __builtin_amdgcn_sched_barrier(0); }
                a0 = wsum(a0); a1 = wsum(a1); a2 = wsum(a2); a3 = wsum(a3); a4 = wsum(a4); a5 = wsum(a5); a6 = wsum(a6); a7 = wsum(a7);
                if (lane == 0) { float4 o0, o1; o0.x = a0 + ifb[0]; o0.y = a1 + ifb[1]; o0.z = a2 + ifb[2]; o0.w = a3 + ifb[3]; o1.x = a4 + ifb[4]; o1.y = a5 + ifb[5]; o1.z = a6 + ifb[6]; o1.w = a7 + ifb[7];
                    *(float4*)(ifg + (size_t)row * 8) = o0; *(float4*)(ifg + (size_t)row * 8 + 4) = o1; }
            } } __builtin_amdgcn_sched_barrier(0); }
    }
}
DI void final_norm(int mk_tid, const u16* hb, float* out, const float* g) {
    const int lane = mk_tid & 63, gw = blockIdx.x * 8 + (mk_tid >> 6), nw = gridDim.x * 8;
    float4 gv[4];
#pragma unroll
    for (int i = 0; i < 4; ++i) gv[i] = *(const float4*)(g + i * 256 + lane * 4);
    for (int row0 = gw; row0 < T; row0 += 4 * nw) {
        u32x2 v[4][4];
#pragma unroll
        for (int r = 0; r < 4; ++r)
#pragma unroll
            for (int i = 0; i < 4; ++i) v[r][i] = *(const u32x2*)(hb + (size_t)(row0 + r * nw) * 1024 + i * 256 + lane * 4);
        __builtin_amdgcn_sched_barrier(0);
#pragma unroll
        for (int r = 0; r < 4; ++r) { float* p = out + (size_t)(row0 + r * nw) * 1024; float ss = 0.f; float4 f[4];
#pragma unroll
            for (int i = 0; i < 4; ++i) { f[i].x = bflo(v[r][i].x); f[i].y = bfhi(v[r][i].x); f[i].z = bflo(v[r][i].y); f[i].w = bfhi(v[r][i].y); ss += f[i].x * f[i].x + f[i].y * f[i].y + f[i].z * f[i].z + f[i].w * f[i].w; }
            ss = wsum(ss); const float rinv = rsqrtf(ss * (1.f / 1024.f) + 1e-6f);
#pragma unroll
            for (int i = 0; i < 4; ++i) { float4 o; o.x = f[i].x * rinv * gv[i].x; o.y = f[i].y * rinv * gv[i].y; o.z = f[i].z * rinv * gv[i].z; o.w = f[i].w * rinv * gv[i].w; *(float4*)(p + i * 256 + lane * 4) = o; } }
    }
}

DI void conv_qk_phase(int mk_tid, const u16* qk, const float* cw, const float* cb, u16* qc, u16* kc) {
    const int gtid = blockIdx.x * 512 + mk_tid, nth = gridDim.x * 512;
    for (int item = gtid; item < 256 * 1024; item += nth) {
        const int co = item & 255, tb = item >> 8, c0 = co * 8, t0 = tb * 16;
        float w0[8], w1[8], w2[8], w3[8], bb[8];
#pragma unroll
        for (int e = 0; e < 8; ++e) { w0[e] = cw[c0 + e]; w1[e] = cw[2048 + c0 + e]; w2[e] = cw[4096 + c0 + e]; w3[e] = cw[6144 + c0 + e]; bb[e] = cb[c0 + e]; }
        float x0[8], x1[8], x2[8], x3[8];
        if ((t0 & (SEQ - 1)) == 0) {
#pragma unroll
            for (int e = 0; e < 8; ++e) { x0[e] = 0.f; x1[e] = 0.f; x2[e] = 0.f; }
        } else {
            unpack8(*(const u32x4*)(qk + (size_t)(t0 - 3) * 2048 + c0), x0); unpack8(*(const u32x4*)(qk + (size_t)(t0 - 2) * 2048 + c0), x1); unpack8(*(const u32x4*)(qk + (size_t)(t0 - 1) * 2048 + c0), x2);
        }
        u16* dstp = (c0 < 1024) ? qc + c0 : kc + (c0 - 1024); const float sc = (c0 < 1024) ? 1.f : 0.0625f;
        for (int tt = 0; tt < 16; ++tt) {
            unpack8(*(const u32x4*)(qk + (size_t)(t0 + tt) * 2048 + c0), x3);
            float o[8];
#pragma unroll
            for (int e = 0; e < 8; ++e) { const float v = bb[e] + w0[e] * x0[e] + w1[e] * x1[e] + w2[e] * x2[e] + w3[e] * x3[e]; o[e] = sc * v * sigm(v); x0[e] = x1[e]; x1[e] = x2[e]; x2[e] = x3[e]; }
            u32x4 r; r.x = pk2(o[0], o[1]); r.y = pk2(o[2], o[3]); r.z = pk2(o[4], o[5]); r.w = pk2(o[6], o[7]);
            *(u32x4*)(dstp + (size_t)(t0 + tt) * 1024) = r;
        }
    }
}

DI float logsig(float x) { return fminf(x, 0.f) - log1pf(__expf(-fabsf(x))); }
DI void gate_prepass(int mk_tid, LAS unsigned char* lds, int bh, const float* ifg, float* gz, float* gM, float* gE, float* gms, float* gMl, float* gW) {
    const int lane = mk_tid & 63, wid = mk_tid >> 6, b = bh >> 2, h = bh & 3;
    LAS float* G = (LAS float*)lds; LAS float* CM = G + 16;
    float z0[2], z1[2], b0[2], b1[2], excm[2], incm[2];
    __syncthreads();
#pragma unroll
    for (int cc = 0; cc < 2; ++cc) { const int c = wid * 2 + cc;
        const int s0 = c * 128 + 2 * lane; const size_t t = (size_t)b * SEQ + s0;
        const float i0 = ifg[t * 8 + h], f0 = ifg[t * 8 + 4 + h], i1 = ifg[t * 8 + 8 + h], f1 = ifg[t * 8 + 12 + h];
        const float lf0 = logsig(f0), lf1 = logsig(f1), s1 = lf0 + lf1;
        float inc = s1;
#pragma unroll
        for (int d = 1; d < 64; d <<= 1) { const float o = __shfl_up(inc, d); if (lane >= d) inc += o; }
        const float exc = inc - s1; b0[cc] = exc + lf0; b1[cc] = exc + s1; z0[cc] = i0 - b0[cc]; z1[cc] = i1 - b1[cc];
        float im = fmaxf(z0[cc], z1[cc]);
#pragma unroll
        for (int d = 1; d < 64; d <<= 1) { const float o = __shfl_up(im, d); if (lane >= d) im = fmaxf(im, o); }
        float em = __shfl_up(im, 1); if (lane == 0) em = -3.0e38f;
        incm[cc] = im; excm[cc] = em;
        if (lane == 63) { G[c] = inc; CM[c] = im; }
    }
    __syncthreads();
    float m = 0.f, mst[2] = {0.f, 0.f};
    for (int c = 0; c < wid * 2; ++c) m = G[c] + fmaxf(m, CM[c]);
    mst[0] = m; m = G[wid * 2] + fmaxf(m, CM[wid * 2]); mst[1] = m;
#pragma unroll
    for (int cc = 0; cc < 2; ++cc) { const int c = wid * 2 + cc; const float m_st = mst[cc];
        const float M0 = fmaxf(m_st, fmaxf(excm[cc], z0[cc])), M1 = fmaxf(m_st, incm[cc]), Ml = fmaxf(m_st, CM[c]);
        const size_t gi = (size_t)bh * SEQ + c * 128 + 2 * lane;
        *(float2*)(gz + gi) = make_float2(z0[cc], z1[cc]); *(float2*)(gM + gi) = make_float2(M0, M1); *(float2*)(gE + gi) = make_float2(__expf(-(b0[cc] + M0)), __expf(-(b1[cc] + M1)));
        *(float2*)(gW + gi) = make_float2(__expf(z0[cc] - Ml), __expf(z1[cc] - Ml));
        if (lane == 0) { gms[bh * 16 + c] = m_st; gMl[bh * 16 + c] = Ml; }
    }
    __syncthreads();
}

DI void mlstm_state_phase(int mk_tid, LAS unsigned char* lds, u16* kc, const u16* vT, float* gW, float* gms, float* gMl, u16* CT, float* nvec,
                          const float* ifg, float* gz, float* gM, float* gE, const float* HBQ, const float* cw, const float* cb) {
    const int tid = mk_tid, lane = tid & 63, wid = tid >> 6, fr = lane & 15, fq = lane >> 4;
    LAS unsigned* slab = (LAS unsigned*)(lds + wid * 9216);
    const unsigned trbase = (unsigned)(size_t)slab + (unsigned)((8 * fq + (fr >> 2)) * 72 + 8 * (fr & 3));
    const int lr = lane >> 2, lp = lane & 3;
    for (int item = blockIdx.x; item < 256; item += gridDim.x) {
        const int bh = item >> 3, eb = item & 7, b = bh >> 2, h = bh & 3;
        gate_prepass(mk_tid, lds, bh, ifg, gz, gM, gE, gms, gMl, gW);
        qk_fix_local(mk_tid, HBQ, cw, cb, kc, 1024 + h * 256, b * 8, 8);
        asm volatile("s_waitcnt vmcnt(0)" ::: "memory"); __syncthreads();
        f32x4 acc[2][2], nac4[2] = {(f32x4){0.f, 0.f, 0.f, 0.f}, (f32x4){0.f, 0.f, 0.f, 0.f}};
        const bf16x8 ones8 = __builtin_bit_cast(bf16x8, (u32x4){0x3F803F80u, 0x3F803F80u, 0x3F803F80u, 0x3F803F80u});
#pragma unroll
        for (int dm = 0; dm < 2; ++dm)
#pragma unroll
            for (int en = 0; en < 2; ++en) acc[dm][en] = (f32x4){0.f, 0.f, 0.f, 0.f};
        u32x4 kreg[8], vreg[4][2]; float wrow[8];
        {   const size_t tbase = (size_t)b * SEQ;
#pragma unroll
            for (int i = 0; i < 8; ++i) { kreg[i] = *(const u32x4*)(kc + (tbase + i * 16 + lr) * 1024 + h * 256 + wid * 32 + lp * 8); wrow[i] = gW[(size_t)bh * SEQ + i * 16 + lr]; }
#pragma unroll
            for (int ks = 0; ks < 4; ++ks)
#pragma unroll
                for (int en = 0; en < 2; ++en) vreg[ks][en] = *(const u32x4*)(vT + (size_t)(h * 256 + eb * 32 + en * 16 + fr) * T + tbase + ks * 32 + 8 * fq); }
        for (int c = 0; c < 16; ++c) {
            u16* ct = CT + ((size_t)(bh * 16 + c) << 16);
#pragma unroll
            for (int dm = 0; dm < 2; ++dm) {
#pragma unroll
                for (int en = 0; en < 2; ++en) { const int e = eb * 32 + en * 16 + fr, d = wid * 32 + dm * 16 + 4 * fq; u32x2 w; w.x = pk2(acc[dm][en][0], acc[dm][en][1]); w.y = pk2(acc[dm][en][2], acc[dm][en][3]); *(u32x2*)(ct + e * 256 + d) = w; }
                if (eb == 0 && fr == 0) *(f32x4*)(nvec + (size_t)(bh * 16 + c) * 256 + wid * 32 + dm * 16 + 4 * fq) = nac4[dm];
            }
            if (c == 15) break;
#pragma unroll
            for (int i = 0; i < 8; ++i) { float kf[8]; unpack8(kreg[i], kf); const float w = wrow[i]; LAS unsigned* dp = slab + (i * 16 + lr) * 18 + lp * 4;
                u32x2 lo, hi; lo.x = pk2(kf[0] * w, kf[1] * w); lo.y = pk2(kf[2] * w, kf[3] * w); hi.x = pk2(kf[4] * w, kf[5] * w); hi.y = pk2(kf[6] * w, kf[7] * w);
                *(LAS u32x2*)dp = lo; *(LAS u32x2*)(dp + 2) = hi; }
            bf16x8 bfr[4][2];
#pragma unroll
            for (int ks = 0; ks < 4; ++ks)
#pragma unroll
                for (int en = 0; en < 2; ++en) bfr[ks][en] = __builtin_bit_cast(bf16x8, vreg[ks][en]);
            if (c + 1 < 15) { const size_t tbase = (size_t)b * SEQ + (c + 1) * 128;
#pragma unroll
                for (int i = 0; i < 8; ++i) { kreg[i] = *(const u32x4*)(kc + (tbase + i * 16 + lr) * 1024 + h * 256 + wid * 32 + lp * 8); wrow[i] = gW[(size_t)bh * SEQ + (c + 1) * 128 + i * 16 + lr]; }
#pragma unroll
                for (int ks = 0; ks < 4; ++ks)
#pragma unroll
                    for (int en = 0; en < 2; ++en) vreg[ks][en] = *(const u32x4*)(vT + (size_t)(h * 256 + eb * 32 + en * 16 + fr) * T + tbase + ks * 32 + 8 * fq); }
            const float dec = __expf(gms[bh * 16 + c] - gMl[bh * 16 + c]);
#pragma unroll
            for (int dm = 0; dm < 2; ++dm) { nac4[dm] *= dec;
#pragma unroll
                for (int en = 0; en < 2; ++en) acc[dm][en] *= dec; }
            __builtin_amdgcn_fence(__ATOMIC_RELEASE, "wavefront"); __builtin_amdgcn_wave_barrier(); __builtin_amdgcn_fence(__ATOMIC_ACQUIRE, "wavefront");
#pragma unroll
            for (int ks = 0; ks < 4; ++ks) {
                bf16x8 afr[2];
                {
                    s16x4 a00, a01, a10, a11; const unsigned ad = trbase + (unsigned)(ks * 32 * 72);
                    asm volatile("s_waitcnt lgkmcnt(0)\n\tds_read_b64_tr_b16 %0, %4\n\tds_read_b64_tr_b16 %1, %4 offset:288\n\tds_read_b64_tr_b16 %2, %4 offset:32\n\tds_read_b64_tr_b16 %3, %4 offset:320\n\ts_waitcnt lgkmcnt(0)"
                                 : "=&v"(a00), "=&v"(a01), "=&v"(a10), "=&v"(a11) : "v"(ad) : "memory");
                    afr[0] = __builtin_shufflevector(a00, a01, 0, 1, 2, 3, 4, 5, 6, 7); afr[1] = __builtin_shufflevector(a10, a11, 0, 1, 2, 3, 4, 5, 6, 7); }
                nac4[0] = mfma16(afr[0], ones8, nac4[0]); nac4[1] = mfma16(afr[1], ones8, nac4[1]);
#pragma unroll
                for (int dm = 0; dm < 2; ++dm)
#pragma unroll
                    for (int en = 0; en < 2; ++en) acc[dm][en] = mfma16(afr[dm], bfr[ks][en], acc[dm][en]);
            }
            __builtin_amdgcn_fence(__ATOMIC_RELEASE, "wavefront"); __builtin_amdgcn_wave_barrier(); __builtin_amdgcn_fence(__ATOMIC_ACQUIRE, "wavefront");
        }
    }
}

DI void mlstm_out_phase(int mk_tid, LAS unsigned char* lds, u16* qy, const u16* kc, const u16* vT, const u16* CT, const float* nvec, const u16* og,
                        const float* gz, const float* gM, const float* gE, const float* gms, const float* ng, int nostore, const float* HBQ, const float* cw, const float* cb) {
    const int tid = mk_tid, lane = tid & 63, wid = __builtin_amdgcn_readfirstlane(tid >> 6), fr = lane & 15, fq = lane >> 4;
    LAS u16* Ksh = (LAS u16*)lds;
    LAS u16* Vsh = (LAS u16*)(lds + 67584);
    for (int item = blockIdx.x; item < 512; item += gridDim.x) {
        const int bh = item >> 4, c = item & 15, b = bh >> 2, h = bh & 3; const size_t tbase = (size_t)b * SEQ + c * 128;
        if ((c & 1) == 0) qk_fix_local(mk_tid, HBQ, cw, cb, qy, h * 256, (int)(tbase >> 8), 1);
        __syncthreads();
        for (int e = tid; e < 4096; e += 512) { const int r = e >> 5, p = e & 31; *(LAS u32x4*)(Ksh + r * 264 + p * 8) = *(const u32x4*)(kc + (tbase + r) * 1024 + h * 256 + p * 8); }
        for (int e = tid; e < 4096; e += 512) { const int r = e >> 4, p = e & 15; *(LAS u32x4*)(Vsh + r * 136 + p * 8) = *(const u32x4*)(vT + (size_t)(h * 256 + r) * T + tbase + p * 8); }
        asm volatile("s_waitcnt vmcnt(0)" ::: "memory");
        __syncthreads();
        const int tl = wid * 16 + fr; const size_t tok = tbase + tl;
        bf16x8 qf[8];
#pragma unroll
        for (int ks = 0; ks < 8; ++ks) qf[ks] = *(const bf16x8*)(qy + tok * 1024 + h * 256 + ks * 32 + 8 * fq);
        const size_t gi = (size_t)bh * SEQ + c * 128;
        const float Mt = gM[gi + tl], en_t = gE[gi + tl], winter = __expf(gms[bh * 16 + c] - Mt);
        const u16* ct = CT + ((size_t)(bh * 16 + c) << 16);
        u32x4 cpre[8];
#pragma unroll
        for (int i = 0; i < 8; ++i) { const int e = tid + i * 512, r = e >> 5, p = e & 31; cpre[i] = *(const u32x4*)(ct + (size_t)r * 256 + p * 8); }
        bf16x8 pf[4]; float dsum = 0.f;
#pragma unroll
        for (int sp = 0; sp < 4; ++sp) {
            u32x4 pk = (u32x4){0u, 0u, 0u, 0u};
#pragma unroll
            for (int hh = 0; hh < 2; ++hh) { const int si = sp * 2 + hh;
                if (si <= wid) {
                    f32x4 st = (f32x4){0.f, 0.f, 0.f, 0.f};
#pragma unroll
                    for (int ks = 0; ks < 8; ++ks) { const bf16x8 a = *(const LAS bf16x8*)(Ksh + (si * 16 + fr) * 264 + ks * 32 + 8 * fq); st = mfma16(a, qf[ks], st); }
                    const float4 z = *(const float4*)(gz + gi + si * 16 + 4 * fq); const float zz[4] = {z.x, z.y, z.z, z.w}; float pv[4];
#pragma unroll
                    for (int j = 0; j < 4; ++j) { const int s = si * 16 + 4 * fq + j; const float p = (s <= tl) ? st[j] * __expf(zz[j] - Mt) : 0.f; dsum += p; pv[j] = p; }
                    if (hh == 0) { pk.x = pk2(pv[0], pv[1]); pk.y = pk2(pv[2], pv[3]); } else { pk.z = pk2(pv[0], pv[1]); pk.w = pk2(pv[2], pv[3]); }
                } }
            pf[sp] = __builtin_bit_cast(bf16x8, pk);
        }
        f32x4 o[16];
#pragma unroll
        for (int half = 0; half < 2; ++half) {
            __syncthreads();
#pragma unroll
            for (int i = 0; i < 8; ++i) { const int e = tid + i * 512, r = e >> 5, p = e & 31; *(LAS u32x4*)(Ksh + r * 264 + p * 8) = cpre[i]; }
            if (half == 0) {
#pragma unroll
                for (int i = 0; i < 8; ++i) { const int e = tid + i * 512, r = e >> 5, p = e & 31; cpre[i] = *(const u32x4*)(ct + (size_t)(128 + r) * 256 + p * 8); } }
            __syncthreads();
#pragma unroll
            for (int e8 = 0; e8 < 8; ++e8) { f32x4 a = (f32x4){0.f, 0.f, 0.f, 0.f};
#pragma unroll
                for (int ks = 0; ks < 8; ++ks) { const bf16x8 cf = *(const LAS bf16x8*)(Ksh + (e8 * 16 + fr) * 264 + ks * 32 + 8 * fq); a = mfma16(cf, qf[ks], a); }
                o[half * 8 + e8] = a * winter; __builtin_amdgcn_sched_barrier(0); }
        }
        const float* nv = nvec + (size_t)(bh * 16 + c) * 256; float qn = 0.f;
#pragma unroll
        for (int ks = 0; ks < 8; ++ks) { const float4 n0 = *(const float4*)(nv + ks * 32 + 8 * fq), n1 = *(const float4*)(nv + ks * 32 + 8 * fq + 4); const float nn[8] = {n0.x, n0.y, n0.z, n0.w, n1.x, n1.y, n1.z, n1.w};
#pragma unroll
            for (int j = 0; j < 8; ++j) qn += bf2f((u16)qf[ks][j]) * nn[j]; }
        qn += __shfl_xor(qn, 16); qn += __shfl_xor(qn, 32); dsum += __shfl_xor(dsum, 16); dsum += __shfl_xor(dsum, 32);
        const int nsp = (wid >> 1) + 1;
#pragma unroll
        for (int et = 0; et < 16; ++et) { __builtin_amdgcn_sched_barrier(0);
#pragma unroll
            for (int sp = 0; sp < 4; ++sp) if (sp < nsp) {
                const s16x4 lo = *(const LAS s16x4*)(Vsh + (et * 16 + fr) * 136 + sp * 32 + 4 * fq), hi = *(const LAS s16x4*)(Vsh + (et * 16 + fr) * 136 + sp * 32 + 16 + 4 * fq);
                const bf16x8 a = __builtin_shufflevector(lo, hi, 0, 1, 2, 3, 4, 5, 6, 7); o[et] = mfma16(a, pf[sp], o[et]); } }
        const float den = winter * qn + dsum, inv = 1.f / fmaxf(fabsf(den), en_t);
        float sum = 0.f;
#pragma unroll
        for (int et = 0; et < 16; ++et) { o[et] *= inv; sum += (o[et][0] + o[et][1]) + (o[et][2] + o[et][3]); }
        sum += __shfl_xor(sum, 16); sum += __shfl_xor(sum, 32); const float mu = sum * (1.f / 256.f);
        float var = 0.f;
#pragma unroll
        for (int et = 0; et < 16; ++et) { o[et] -= mu; var += (o[et][0] * o[et][0] + o[et][1] * o[et][1]) + (o[et][2] * o[et][2] + o[et][3] * o[et][3]); }
        var += __shfl_xor(var, 16); var += __shfl_xor(var, 32); const float rstd = rsqrtf(var * (1.f / 256.f) + 1e-6f);
        u32x2 ogr[16]; float4 gg[16];
#pragma unroll
        for (int et = 0; et < 16; ++et) { ogr[et] = *(const u32x2*)(og + tok * 1024 + h * 256 + et * 16 + 4 * fq); gg[et] = *(const float4*)(ng + h * 256 + et * 16 + 4 * fq); }
        __builtin_amdgcn_sched_barrier(0);
#pragma unroll
        for (int et = 0; et < 16; ++et) { const int e = h * 256 + et * 16 + 4 * fq; const float4 g4 = gg[et];
            u32x2 w; w.x = pk2(sigm(bflo(ogr[et].x)) * o[et][0] * rstd * g4.x, sigm(bfhi(ogr[et].x)) * o[et][1] * rstd * g4.y); w.y = pk2(sigm(bflo(ogr[et].y)) * o[et][2] * rstd * g4.z, sigm(bfhi(ogr[et].y)) * o[et][3] * rstd * g4.w);
            if (!nostore) *(u32x2*)(qy + tok * 1024 + e) = w; }
    }
}

DI void xattn_pair(int mk_tid, LAS unsigned char* lds, const u16* q, const u16* kmem, const u16* vTm, u16* ao, int b, int h, int qb0) {
    const int tid = mk_tid, lane = tid & 63, wid = tid >> 6, fr = lane & 15, fq = lane >> 4;
    LAS u16* Ksh = (LAS u16*)lds;
    {
        __syncthreads();
        for (int e = tid; e < 8192; e += 512) { const int r = e >> 5, p = e & 31; *(LAS u32x4*)(Ksh + r * 264 + p * 8) = *(const u32x4*)(kmem + (size_t)(b * 256 + r) * 1024 + h * 256 + p * 8); }
        __syncthreads();
        const size_t tok0 = (size_t)b * SEQ + qb0 * 128 + wid * 16 + fr, tok1 = tok0 + 128;
        bf16x8 qa[8], qb8[8];
#pragma unroll
        for (int ks = 0; ks < 8; ++ks) { qa[ks] = *(const bf16x8*)(q + tok0 * 1024 + h * 256 + ks * 32 + 8 * fq); qb8[ks] = *(const bf16x8*)(q + tok1 * 1024 + h * 256 + ks * 32 + 8 * fq); }
        float mx0 = -3.0e38f, mx1 = -3.0e38f;
#pragma unroll
        for (int mi = 0; mi < 16; ++mi) { f32x4 a = (f32x4){0.f, 0.f, 0.f, 0.f}, c = (f32x4){0.f, 0.f, 0.f, 0.f};
#pragma unroll
            for (int ks = 0; ks < 8; ++ks) { const bf16x8 kf = *(const LAS bf16x8*)(Ksh + (mi * 16 + fr) * 264 + ks * 32 + 8 * fq); a = mfma16(kf, qa[ks], a); c = mfma16(kf, qb8[ks], c); }
            mx0 = fmaxf(mx0, fmaxf(fmaxf(a[0], a[1]), fmaxf(a[2], a[3]))); mx1 = fmaxf(mx1, fmaxf(fmaxf(c[0], c[1]), fmaxf(c[2], c[3]))); __builtin_amdgcn_sched_barrier(0); }
        mx0 = fmaxf(mx0, __shfl_xor(mx0, 16)); mx0 = fmaxf(mx0, __shfl_xor(mx0, 32)); mx1 = fmaxf(mx1, __shfl_xor(mx1, 16)); mx1 = fmaxf(mx1, __shfl_xor(mx1, 32));
        bf16x8 pf0[8], pf1[8]; float sum0 = 0.f, sum1 = 0.f;
#pragma unroll
        for (int sp = 0; sp < 8; ++sp) { f32x4 a0 = (f32x4){0.f, 0.f, 0.f, 0.f}, a1 = a0, c0 = a0, c1 = a0;
#pragma unroll
            for (int ks = 0; ks < 8; ++ks) { const bf16x8 k0 = *(const LAS bf16x8*)(Ksh + (sp * 32 + fr) * 264 + ks * 32 + 8 * fq), k1 = *(const LAS bf16x8*)(Ksh + (sp * 32 + 16 + fr) * 264 + ks * 32 + 8 * fq);
                a0 = mfma16(k0, qa[ks], a0); a1 = mfma16(k1, qa[ks], a1); c0 = mfma16(k0, qb8[ks], c0); c1 = mfma16(k1, qb8[ks], c1); }
            float p[8], r[8];
#pragma unroll
            for (int j = 0; j < 4; ++j) { p[j] = __expf((a0[j] - mx0) * 0.0625f); p[4 + j] = __expf((a1[j] - mx0) * 0.0625f); sum0 += p[j] + p[4 + j];
                                          r[j] = __expf((c0[j] - mx1) * 0.0625f); r[4 + j] = __expf((c1[j] - mx1) * 0.0625f); sum1 += r[j] + r[4 + j]; }
            u32x4 pk; pk.x = pk2(p[0], p[1]); pk.y = pk2(p[2], p[3]); pk.z = pk2(p[4], p[5]); pk.w = pk2(p[6], p[7]); pf0[sp] = __builtin_bit_cast(bf16x8, pk);
            u32x4 rk; rk.x = pk2(r[0], r[1]); rk.y = pk2(r[2], r[3]); rk.z = pk2(r[4], r[5]); rk.w = pk2(r[6], r[7]); pf1[sp] = __builtin_bit_cast(bf16x8, rk); __builtin_amdgcn_sched_barrier(0); }
        sum0 += __shfl_xor(sum0, 16); sum0 += __shfl_xor(sum0, 32); sum1 += __shfl_xor(sum1, 16); sum1 += __shfl_xor(sum1, 32);
        const float iv0 = 1.f / sum0, iv1 = 1.f / sum1;
        __syncthreads();
        for (int e = tid; e < 8192; e += 512) { const int r = e >> 5, p = e & 31; *(LAS u32x4*)(Ksh + r * 264 + p * 8) = *(const u32x4*)(vTm + (size_t)(h * 256 + r) * 2048 + b * 256 + p * 8); }
        __syncthreads();
#pragma unroll 2
        for (int et = 0; et < 16; ++et) {
            f32x4 o0 = (f32x4){0.f, 0.f, 0.f, 0.f}, o1 = o0;
#pragma unroll
            for (int sp = 0; sp < 8; ++sp) { const s16x4 lo = *(const LAS s16x4*)(Ksh + (et * 16 + fr) * 264 + sp * 32 + 4 * fq), hi = *(const LAS s16x4*)(Ksh + (et * 16 + fr) * 264 + sp * 32 + 16 + 4 * fq);
                const bf16x8 a = __builtin_shufflevector(lo, hi, 0, 1, 2, 3, 4, 5, 6, 7); o0 = mfma16(a, pf0[sp], o0); o1 = mfma16(a, pf1[sp], o1); }
            u32x2 w0, w1; w0.x = pk2(o0[0] * iv0, o0[1] * iv0); w0.y = pk2(o0[2] * iv0, o0[3] * iv0); w1.x = pk2(o1[0] * iv1, o1[1] * iv1); w1.y = pk2(o1[2] * iv1, o1[3] * iv1);
            *(u32x2*)(ao + tok0 * 1024 + h * 256 + et * 16 + 4 * fq) = w0; *(u32x2*)(ao + tok1 * 1024 + h * 256 + et * 16 + 4 * fq) = w1; __builtin_amdgcn_sched_barrier(0); }
    }
}

DI void rglru_phase(int mk_tid, LAS unsigned char* lds, const u16* xr, const u16* gr, const float* cw, const float* cb, const float* wa, const float* ba, const float* wx, const float* bx, const float* lam, u16* ya, int pass, float* sumA, float* sumH) {
    const int tid = mk_tid, lane = tid & 63, wid = tid >> 6, fr = lane & 15, fq = lane >> 4;
    LAS u16* xs = (LAS u16*)(lds + wid * 8192);
    LAS float* xf = (LAS float*)(lds + wid * 8192 + 2560);
    const int tp = lane >> 3, co = lane & 7;
    for (int item = blockIdx.x * 8 + wid; item < 2048; item += gridDim.x * 8) {
        const int b = item >> 8, g = (item >> 4) & 15, seg = item & 15, ccol = g * 64 + co * 8;
        LAS u16* Wsh = (LAS u16*)(lds + 65536);
        __syncthreads();
        for (int e = tid; e < 4096; e += 512) { const int i = e >> 6, j = e & 63; Wsh[j * 72 + i] = f2bf(wa[(size_t)(g * 64 + i) * 64 + j]); Wsh[4608 + j * 72 + i] = f2bf(wx[(size_t)(g * 64 + i) * 64 + j]); }
        __syncthreads();
        if (pass == 0 && seg == 15) continue;
        float bav[4], bxv[4], c8[4], carry[4], aprod[4];
#pragma unroll
        for (int nt = 0; nt < 4; ++nt) { const int cch = g * 64 + nt * 16 + fr;
            bav[nt] = ba[cch]; bxv[nt] = bx[cch]; c8[nt] = -8.f * log1pf(__expf(-lam[cch])); carry[nt] = 0.f; aprod[nt] = 1.f;
            if (pass == 1) for (int s2 = 0; s2 < seg; ++s2) carry[nt] = sumA[(size_t)(b * 16 + s2) * 1024 + cch] * carry[nt] + sumH[(size_t)(b * 16 + s2) * 1024 + cch]; }
        float w0[8], w1[8], w2[8], w3[8], bb[8];
#pragma unroll
        for (int e = 0; e < 8; ++e) { w0[e] = cw[ccol + e]; w1[e] = cw[1024 + ccol + e]; w2[e] = cw[2048 + ccol + e]; w3[e] = cw[3072 + ccol + e]; bb[e] = cb[ccol + e]; }
        const size_t tb0 = (size_t)b * SEQ; const int sb = seg * 128;
        u32x4 rows[5]; u16 grv[4][4];
#pragma unroll
        for (int r = 0; r < 5; ++r) { const int srow = sb + 2 * tp - 3 + r; rows[r] = (srow >= 0) ? *(const u32x4*)(xr + (tb0 + srow) * 1024 + ccol) : (u32x4){0u, 0u, 0u, 0u}; }
#pragma unroll
        for (int nt = 0; nt < 4; ++nt)
#pragma unroll
            for (int j = 0; j < 4; ++j) grv[nt][j] = (pass == 1) ? gr[(tb0 + sb + 4 * fq + j) * 1024 + g * 64 + nt * 16 + fr] : (u16)0;
        for (int st = 0; st < 8; ++st) {
            u32x4 cur[5]; u16 gcur[4][4];
#pragma unroll
            for (int r = 0; r < 5; ++r) cur[r] = rows[r];
#pragma unroll
            for (int nt = 0; nt < 4; ++nt)
#pragma unroll
                for (int j = 0; j < 4; ++j) gcur[nt][j] = grv[nt][j];
            const int t0 = sb + st * 16;
            if (st + 1 < 8) {
#pragma unroll
                for (int r = 0; r < 5; ++r) rows[r] = *(const u32x4*)(xr + (tb0 + t0 + 16 + 2 * tp - 3 + r) * 1024 + ccol);
                if (pass == 1) {
#pragma unroll
                    for (int nt = 0; nt < 4; ++nt)
#pragma unroll
                        for (int j = 0; j < 4; ++j) grv[nt][j] = gr[(tb0 + t0 + 16 + 4 * fq + j) * 1024 + g * 64 + nt * 16 + fr]; }
            }
            float r0[8], r1[8], r2[8], r3[8], r4[8], oa[8], ob[8];
            unpack8(cur[0], r0); unpack8(cur[1], r1); unpack8(cur[2], r2); unpack8(cur[3], r3); unpack8(cur[4], r4);
#pragma unroll
            for (int e = 0; e < 8; ++e) { oa[e] = bb[e] + w0[e] * r0[e] + w1[e] * r1[e] + w2[e] * r2[e] + w3[e] * r3[e]; ob[e] = bb[e] + w0[e] * r1[e] + w1[e] * r2[e] + w2[e] * r3[e] + w3[e] * r4[e]; }
            { u32x4 pa, pb; pa.x = pk2(oa[0], oa[1]); pa.y = pk2(oa[2], oa[3]); pa.z = pk2(oa[4], oa[5]); pa.w = pk2(oa[6], oa[7]); pb.x = pk2(ob[0], ob[1]); pb.y = pk2(ob[2], ob[3]); pb.z = pk2(ob[4], ob[5]); pb.w = pk2(ob[6], ob[7]);
              *(LAS u32x4*)(xs + (2 * tp) * 72 + co * 8) = pa; *(LAS u32x4*)(xs + (2 * tp + 1) * 72 + co * 8) = pb;
              *(LAS f32x4*)(xf + (2 * tp) * 68 + co * 8) = (f32x4){oa[0], oa[1], oa[2], oa[3]}; *(LAS f32x4*)(xf + (2 * tp) * 68 + co * 8 + 4) = (f32x4){oa[4], oa[5], oa[6], oa[7]};
              *(LAS f32x4*)(xf + (2 * tp + 1) * 68 + co * 8) = (f32x4){ob[0], ob[1], ob[2], ob[3]}; *(LAS f32x4*)(xf + (2 * tp + 1) * 68 + co * 8 + 4) = (f32x4){ob[4], ob[5], ob[6], ob[7]}; }
            __builtin_amdgcn_fence(__ATOMIC_RELEASE, "wavefront"); __builtin_amdgcn_wave_barrier(); __builtin_amdgcn_fence(__ATOMIC_ACQUIRE, "wavefront");
            const bf16x8 af0 = *(const LAS bf16x8*)(xs + fr * 72 + 8 * fq), af1 = *(const LAS bf16x8*)(xs + fr * 72 + 32 + 8 * fq);
#pragma unroll
            for (int nt = 0; nt < 4; ++nt) {
                f32x4 aa = (f32x4){0.f, 0.f, 0.f, 0.f}, ax = (f32x4){0.f, 0.f, 0.f, 0.f};
                { const LAS u16* wp = Wsh + (nt * 16 + fr) * 72 + 8 * fq; const bf16x8 wa0 = *(const LAS bf16x8*)wp, wa1 = *(const LAS bf16x8*)(wp + 32), wx0 = *(const LAS bf16x8*)(wp + 4608), wx1 = *(const LAS bf16x8*)(wp + 4608 + 32);
                  aa = mfma16(af0, wa0, aa); aa = mfma16(af1, wa1, aa); ax = mfma16(af0, wx0, ax); ax = mfma16(af1, wx1, ax); }
                float hl[4], pa4[4]; float Al = 1.f, Hl = 0.f;
#pragma unroll
                for (int j = 0; j < 4; ++j) { const float xc = xf[(4 * fq + j) * 68 + nt * 16 + fr]; const float rr = sigm(aa[j] + bav[nt]), ii = sigm(ax[j] + bxv[nt]), la = c8[nt] * rr, av = __expf(la), x2 = 2.f * la;
                    const float om = (x2 > -0.02f) ? -x2 * (1.f + x2 * (0.5f + x2 * (1.f / 6.f))) : 1.f - av * av;
                    const float uu = __builtin_amdgcn_sqrtf(fmaxf(om, 0.f)) * ii * xc;
                    Hl = av * Hl + uu; Al *= av; hl[j] = Hl; pa4[j] = Al; }
                const float A0 = __shfl(Al, fr), H0 = __shfl(Hl, fr), A1 = __shfl(Al, fr + 16), H1 = __shfl(Hl, fr + 16), A2 = __shfl(Al, fr + 32), H2 = __shfl(Hl, fr + 32), A3 = __shfl(Al, fr + 48), H3 = __shfl(Hl, fr + 48);
                const float cin = carry[nt], c1 = A0 * cin + H0, c2 = A1 * c1 + H1, c3 = A2 * c2 + H2, c4 = A3 * c3 + H3;
                const float hin = (fq == 0) ? cin : (fq == 1) ? c1 : (fq == 2) ? c2 : c3;
                carry[nt] = c4; aprod[nt] *= (A0 * A1) * (A2 * A3);
                if (pass == 1) {
#pragma unroll
                    for (int j = 0; j < 4; ++j) { const float hv = hl[j] + pa4[j] * hin; ya[(tb0 + t0 + 4 * fq + j) * 1024 + g * 64 + nt * 16 + fr] = f2bf(gelu_t(bf2f(gcur[nt][j])) * hv); } }
            }
            __builtin_amdgcn_fence(__ATOMIC_RELEASE, "wavefront"); __builtin_amdgcn_wave_barrier(); __builtin_amdgcn_fence(__ATOMIC_ACQUIRE, "wavefront");
        }
        if (pass == 0 && fq == 0) {
#pragma unroll
            for (int nt = 0; nt < 4; ++nt) { sumA[(size_t)(b * 16 + seg) * 1024 + g * 64 + nt * 16 + fr] = aprod[nt]; sumH[(size_t)(b * 16 + seg) * 1024 + g * 64 + nt * 16 + fr] = carry[nt]; } }
    }
}

DI void ffn_act_phase(int mk_tid, const u16* up, const float* cw, const float* cb, u16* act, int part) {
    const int gtid = blockIdx.x * 512 + mk_tid, nth = gridDim.x * 512;
    for (int item = gtid; item < 192 * 1024; item += nth) {
        const int co = item % 192, tb = item / 192, c0 = co * 8, t0 = tb * 16, gc = part * 1536 + c0;
        float wg0[8], wg1[8], wg2[8], wu0[8], wu1[8], wu2[8], bg[8], bu[8];
#pragma unroll
        for (int e = 0; e < 8; ++e) { wg0[e] = cw[gc + e]; wg1[e] = cw[6144 + gc + e]; wg2[e] = cw[12288 + gc + e]; wu0[e] = cw[3072 + gc + e]; wu1[e] = cw[6144 + 3072 + gc + e]; wu2[e] = cw[12288 + 3072 + gc + e]; bg[e] = cb[gc + e]; bu[e] = cb[3072 + gc + e]; }
        float g0[8], g1[8], g2[8], u0[8], u1[8], u2[8];
        if ((t0 & (SEQ - 1)) == 0) {
#pragma unroll
            for (int e = 0; e < 8; ++e) { g0[e] = 0.f; g1[e] = 0.f; u0[e] = 0.f; u1[e] = 0.f; }
        } else {
            unpack8(*(const u32x4*)(up + (size_t)(t0 - 2) * 3072 + c0), g0); unpack8(*(const u32x4*)(up + (size_t)(t0 - 1) * 3072 + c0), g1);
            unpack8(*(const u32x4*)(up + (size_t)(t0 - 2) * 3072 + 1536 + c0), u0); unpack8(*(const u32x4*)(up + (size_t)(t0 - 1) * 3072 + 1536 + c0), u1);
        }
        for (int tt = 0; tt < 16; ++tt) {
            unpack8(*(const u32x4*)(up + (size_t)(t0 + tt) * 3072 + c0), g2); unpack8(*(const u32x4*)(up + (size_t)(t0 + tt) * 3072 + 1536 + c0), u2);
            float o[8];
#pragma unroll
            for (int e = 0; e < 8; ++e) { const float gv = bg[e] + wg0[e] * g0[e] + wg1[e] * g1[e] + wg2[e] * g2[e], uv = bu[e] + wu0[e] * u0[e] + wu1[e] * u1[e] + wu2[e] * u2[e]; o[e] = gelu_t(gv) * uv; g0[e] = g1[e]; g1[e] = g2[e]; u0[e] = u1[e]; u1[e] = u2[e]; }
            u32x4 r; r.x = pk2(o[0], o[1]); r.y = pk2(o[2], o[3]); r.z = pk2(o[4], o[5]); r.w = pk2(o[6], o[7]);
            *(u32x4*)(act + (size_t)(t0 + tt) * 3072 + gc) = r;
        }
    }
}

DI UE ue_bf16(u16* O, int ldc, int split) { UE e; e.perm = 1; e.kind = 0; e.O = O; e.ldc = ldc; e.split = split; e.gate = nullptr; e.F = nullptr; e.Fin = nullptr; e.ss = nullptr; e.smode = 0; e.HBo = nullptr; e.sso = nullptr; e.ssp = nullptr; e.cnt = nullptr; e.rflags = 0; return e; }
DI GD mkgd(const u16* A, const u16* Bt, int M, int N, int K, int cshift, UE e) { GD d; d.A = A; d.Bt = Bt; d.M = M; d.N = N; d.K = K; d.cshift = cshift; d.e = e; return d; }

#define XB_TMO      128
#define XB_XCNT(j)  (256  + 64 * (j))
#define XB_XSUB(j)  (1280 + 64 * (j))
#define XB_XGEN(j)  (2304 + 64 * (j))
#define XB_TOP      3328
#define XB_TOPGEN   3392
#define XCD_BAR_WORDS 3456
#define XB_SPIN_CAP (1u << 18)

__device__ __forceinline__ unsigned xb_ld(unsigned* p)              { return __hip_atomic_load(p, __ATOMIC_RELAXED, __HIP_MEMORY_SCOPE_AGENT); }
__device__ __forceinline__ unsigned xb_add(unsigned* p, unsigned v) { return __hip_atomic_fetch_add(p, v, __ATOMIC_RELAXED, __HIP_MEMORY_SCOPE_AGENT); }
__device__ __forceinline__ unsigned xb_xcc_id() { return (unsigned)__builtin_amdgcn_s_getreg((3 << 11) | 20) & 0xFu; }
#define XB_SPIN(cond, bar) do { unsigned _sp = 0; while (cond) { __builtin_amdgcn_s_sleep(1); \
    if ((++_sp & 255u) == 0u) { if (xb_ld(&(bar)[XB_TMO])) break; if (_sp > XB_SPIN_CAP) { atomicAdd(&(bar)[XB_TMO], 1u); break; } } } } while (0)

struct XcdBarrier {
    unsigned* bar; unsigned x;
    volatile LAS unsigned* st;
};

__device__ __forceinline__ XcdBarrier xcd_barrier_post(unsigned* bar, volatile LAS unsigned* st) {
    XcdBarrier b; b.bar = bar; b.x = xb_xcc_id(); b.st = st;
    if (threadIdx.x == 0) (void)xb_add(&bar[XB_XCNT(b.x)], 1u);
    return b;
}
__device__ __forceinline__ void xcd_barrier_complete(unsigned* bar, unsigned x, unsigned& nloc, unsigned& nx) {
    const unsigned G = gridDim.x * gridDim.y * gridDim.z;
    unsigned sum, cnt, mine, sp = 0u;
    for (;;) {
        sum = 0u; cnt = 0u; mine = 0u;
#pragma unroll
        for (unsigned j = 0; j < 16; ++j) { const unsigned c = xb_ld(&bar[XB_XCNT(j)]); sum += c; cnt += (c > 0u) ? 1u : 0u; mine = (j == x) ? c : mine; }
        if (sum == G) break;
        __builtin_amdgcn_s_sleep(1);
        if ((++sp & 255u) == 0u) { if (xb_ld(&bar[XB_TMO])) break; if (sp > XB_SPIN_CAP) { atomicAdd(&bar[XB_TMO], 1u); break; } }
    }
    nloc = mine > 0u ? mine : 1u; nx = cnt > 0u ? cnt : 1u;
}

__device__ __forceinline__ void xcd_barrier(const XcdBarrier& b) {
    asm volatile("s_waitcnt vmcnt(0)" ::: "memory");
    __syncthreads();
    if (threadIdx.x == 0) {
        unsigned* bar = b.bar;
        __builtin_amdgcn_s_waitcnt(0);
        unsigned nloc = b.st[0], nx = b.st[1];
        if (nloc == 0u) { xcd_barrier_complete(bar, b.x, nloc, nx); b.st[0] = nloc; b.st[1] = nx; }
        const unsigned old = xb_add(&bar[XB_XSUB(b.x)], 1u);
        const unsigned gen = old / nloc;
        if (old + 1u == (gen + 1u) * nloc) {
            __builtin_amdgcn_fence(__ATOMIC_RELEASE, "agent");
            asm volatile("s_waitcnt vmcnt(0)" ::: "memory");
            const unsigned og = xb_add(&bar[XB_TOP], 1u);
            const unsigned tg = og / nx;
            if (og + 1u == (tg + 1u) * nx) xb_add(&bar[XB_TOPGEN], 1u);
            else XB_SPIN(xb_ld(&bar[XB_TOPGEN]) == tg, bar);
            __builtin_amdgcn_fence(__ATOMIC_ACQUIRE, "agent");
            xb_add(&bar[XB_XGEN(b.x)], 1u);
            asm volatile("s_waitcnt vmcnt(0)" ::: "memory");
        } else {
            XB_SPIN(xb_ld(&bar[XB_XGEN(b.x)]) == gen, bar);
            __builtin_amdgcn_fence(__ATOMIC_ACQUIRE, "agent");
            asm volatile("s_waitcnt vmcnt(0)" ::: "memory");
        }
    }
    __syncthreads();
}

DI int gemm_count(int sub) { return (sub == S_GXR) ? 1 : (sub == S_GQK || sub == S_GAB || sub == S_GMIX) ? 2 : 0; }
DI GD get_gd(const Args& a, int l, int sub, int i) {
    unsigned char* ws = a.ws;
    u16* A0 = (u16*)ws; u16* A1 = (u16*)(ws + U); u16* A2 = (u16*)(ws + 2 * U); u16* A3 = (u16*)(ws + 3 * U); u16* A4 = (u16*)(ws + 4 * U); u16* A5 = (u16*)(ws + 5 * U); u16* A6 = (u16*)(ws + 6 * U);
    u16* WT = (u16*)(ws + WS_WT); u16* MEMN = (u16*)(ws + WS_MEMN); u16* KMEM = A3; u16* VTM = A3 + 2097152;
    float* SS = (float*)(ws + WS_SS);
    const size_t MW = (size_t)1024 * 1024;
    UE er = ue_bf16(nullptr, 1024, 0); er.perm = 1; er.kind = 3; er.ssp = (float*)(ws + WS_SSP); er.cnt = (unsigned*)(ws + WS_CNT) + (size_t)(l * 3 + (sub == S_GMIX ? 0 : sub == S_GWO ? 1 : 2)) * 64; er.Fin = (l == 0 && sub == S_GMIX) ? a.in[0] : a.out; er.F = a.out;
    switch (sub) {
    case S_GQK: { UE eo = ue_bf16(A1, 1024, 0); eo.ss = SS + (size_t)(l * 3) * T; eo.smode = 1; UE ev = ue_bf16(A2, T, 0); ev.ss = SS + (size_t)(l * 3) * T; ev.smode = 2;
        return i == 0 ? mkgd(A0, WT + 2 * MW, T, 1024, 1024, 0, eo) : mkgd(WT + 3 * MW, A0, 1024, T, 1024, 0, ev); }
    case S_GXR: { UE e = ue_bf16(A1, 1024, 1); e.ss = SS + (size_t)(l * 3) * T; e.smode = 1; return mkgd(A0, WT + 4 * MW, T, 4096, 1024, 0, e); }
    case S_GAB: { UE e1 = ue_bf16(nullptr, 1024, 0); e1.perm = 1; e1.kind = 1; e1.gate = A3; e1.O = A1; UE e2 = e1; e2.kind = 2; e2.gate = A4; e2.Fin = (const float*)A1; e2.O = A0;
        return i == 0 ? mkgd(A5, WT + 8 * MW, T, 1024, 1024, 0, e1) : mkgd(A6, WT + 9 * MW, T, 1024, 1024, 0, e2); }
    case S_GMIX: return i == 0 ? mkgd(MEMN, WT + MW, 2048, 1024, 1024, 0, ue_bf16(KMEM, 1024, 0)) : mkgd(WT + 2 * MW, MEMN, 1024, 2048, 1024, 64, ue_bf16(VTM, 2048, 0));
    case S_GWO: er.HBo = A0; er.sso = SS + (size_t)(l * 3 + 2) * T; er.Fin = (const float*)A1; er.rflags = 1; return mkgd(A2, WT + 3 * MW, T, 1024, 1024, 0, er);
    default: er.HBo = A0; er.sso = SS + (size_t)(l * 3 + 3) * T; er.Fin = (const float*)A0; er.rflags = 3; return mkgd(A4, WT + 11 * MW, T, 1024, 3072, 0, er);
    }
}
DI void cvt_set(int mk_tid, LAS unsigned char* lds, const Args& a, int l, int set, int vb = -2, int VG = 0) {
    if (vb == -2) { vb = (int)blockIdx.x; VG = (int)gridDim.x; }
    u16* WT = (u16*)(a.ws + WS_WT); const size_t MW = (size_t)1024 * 1024; int tb = 0; const int nj = set == 0 ? 8 : set == 1 ? 3 : 1;
    for (int j = 0; j < nj; ++j) {
        const float* W; int ldw, col0, ncols, K = 1024, il = 0; u16* dst; const float* gain = nullptr;
        if (set == 0) { const float* win = a.in[3] + (size_t)l * 1024 * 8200;
            if (j < 5) { W = win; ldw = 8200; col0 = (j == 0) ? 2048 : (j == 1) ? 5120 : (j == 2) ? 4096 : (j == 3) ? 0 : 6152; ncols = (j == 1 || j == 2) ? 1024 : 2048; dst = WT + ((j == 0) ? 0 : (j == 1) ? 2 : (j == 2) ? 3 : (j == 3) ? 4 : 6) * MW; gain = a.in[2] + l * 1024; }
            else { W = a.in[15 + (j - 5)] + l * MW; ldw = 1024; col0 = 0; ncols = 1024; dst = WT + (8 + (j - 5)) * MW; } }
        else if (set == 1) { W = (j == 0) ? a.in[19] + l * MW : (j == 1) ? a.in[20] + l * 2 * MW : a.in[21] + l * MW; ldw = (j == 1) ? 2048 : 1024; col0 = 0; ncols = (j == 1) ? 2048 : 1024; dst = WT + ((j == 0) ? 0 : (j == 1) ? 1 : 3) * MW; gain = (j == 0) ? a.in[18] + l * 1024 : nullptr; }
        else if (set == 2) { W = a.in[23] + (size_t)l * 6 * MW; ldw = 6144; col0 = 0; ncols = 6144; il = 1; dst = WT + 4 * MW; gain = a.in[22] + l * 1024; }
        else { W = a.in[26] + (size_t)l * 3 * MW; ldw = 1024; col0 = 0; ncols = 1024; K = 3072; dst = WT + 11 * MW; }
        cvt_w(mk_tid, lds, W, ldw, col0, ncols, K, dst, tb, il, gain, vb, VG);
    }
}
DI void ifg_rows(int mk_tid, LAS unsigned char* lds, const u16* hb, const float* ss, const float* win, const float* g, const float* ifb, float* ifg) {
    const int tid = mk_tid, lane = tid & 63, wid = tid >> 6;
    LAS float* sW = (LAS float*)lds;
    __syncthreads();
    for (int e = tid; e < 8192; e += 512) sW[e] = win[(size_t)(e >> 3) * 8200 + 6144 + (e & 7)] * g[e >> 3];
    __syncthreads();
    for (int r0 = blockIdx.x * 64; r0 < T; r0 += gridDim.x * 64) {
        u16 hv[8][16];
#pragma unroll
        for (int rr = 0; rr < 8; ++rr)
#pragma unroll
            for (int e = 0; e < 16; ++e) hv[rr][e] = hb[(size_t)(r0 + wid * 8 + rr) * 1024 + e * 64 + lane];
#pragma unroll
        for (int rr = 0; rr < 8; ++rr) { const int row = r0 + wid * 8 + rr;
            float a0 = 0, a1 = 0, a2 = 0, a3 = 0, a4 = 0, a5 = 0, a6 = 0, a7 = 0;
#pragma unroll
            for (int e = 0; e < 16; ++e) { const int k = e * 64 + lane; const float y = bf2f(hv[rr][e]); const LAS f32x4* wp = (const LAS f32x4*)(sW + k * 8); const f32x4 w0 = wp[0], w1 = wp[1];
                a0 += y * w0.x; a1 += y * w0.y; a2 += y * w0.z; a3 += y * w0.w; a4 += y * w1.x; a5 += y * w1.y; a6 += y * w1.z; a7 += y * w1.w; }
            a0 = wsum(a0); a1 = wsum(a1); a2 = wsum(a2); a3 = wsum(a3); a4 = wsum(a4); a5 = wsum(a5); a6 = wsum(a6); a7 = wsum(a7);
            if (lane == 0) { const float rs = rsqrtf(ss[row] * (1.f / 1024.f) + 1e-6f); float4 o0, o1; o0.x = a0 * rs + ifb[0]; o0.y = a1 * rs + ifb[1]; o0.z = a2 * rs + ifb[2]; o0.w = a3 * rs + ifb[3]; o1.x = a4 * rs + ifb[4]; o1.y = a5 * rs + ifb[5]; o1.z = a6 * rs + ifb[6]; o1.w = a7 * rs + ifb[7];
                *(float4*)(ifg + (size_t)row * 8) = o0; *(float4*)(ifg + (size_t)row * 8 + 4) = o1; }
            __builtin_amdgcn_sched_barrier(0); }
    }
    __syncthreads();
}
DI void raw_rows(int mk_tid, const float* src, u16* dst, float* ssout) {
    const int lane = mk_tid & 63, gw = blockIdx.x * 8 + (mk_tid >> 6), nw = gridDim.x * 8;
    for (int row = gw; row < T; row += nw) {
        float4 v[4]; float sq = 0.f;
#pragma unroll
        for (int i = 0; i < 4; ++i) { v[i] = *(const float4*)(src + (size_t)row * 1024 + i * 256 + lane * 4); sq += v[i].x * v[i].x + v[i].y * v[i].y + v[i].z * v[i].z + v[i].w * v[i].w; }
        sq = wsum(sq);
#pragma unroll
        for (int i = 0; i < 4; ++i) { u32x2 w; w.x = pk2(v[i].x, v[i].y); w.y = pk2(v[i].z, v[i].w); *(u32x2*)(dst + (size_t)row * 1024 + i * 256 + lane * 4) = w; }
        if (lane == 0) ssout[row] = sq;
    }
}
DI void resid_gemm(int mk_tid, LAS unsigned char* lds, const Args& a, int l, int which, const u16* A, const u16* Bt, int K, const float* Fin, u16* HBo, u16* HB2, int rflags) {
    unsigned char* ws = a.ws;
    Gemm g; g.A = A; g.Bt = Bt; g.M = T; g.N = 1024; g.K = K;
    UE3 e; e.perm = 1; e.Fin = Fin; e.F = a.out; e.HBo = HBo; e.HB2 = HB2; e.sso = (float*)(ws + WS_SS) + (size_t)(l * 3 + which + 1) * T; e.ssp = (float*)(ws + WS_SSP); e.cnt = (unsigned*)(ws + WS_CNT) + (size_t)(l * 3 + which) * 64; e.rflags = rflags;
    StaticOrder S; S.init(T, 1024, (int)gridDim.x, (int)blockIdx.x);
    for (int i = 0; ; ++i) { OneUnit O; if (!S.next(i, O.u)) break; __syncthreads(); gemm_phase<UE3, OneUnit, false>(mk_tid, lds, g, O, e, nullptr); }
}
DI void init_phase(int mk_tid, LAS unsigned char* lds, const Args& a) {
    unsigned char* ws = a.ws; float* SS = (float*)(ws + WS_SS);
    for (int i = blockIdx.x * 512 + mk_tid; i < 1024; i += gridDim.x * 512) ((unsigned*)(ws + WS_CNT))[i] = 0u;
    cvt_set(mk_tid, lds, a, 0, 0);
    raw_rows(mk_tid, a.in[0], (u16*)ws, SS);
    norm_rows(mk_tid, a.in[1], a.in[27], (u16*)(ws + WS_MEMN), 2048, nullptr, nullptr, nullptr);
}
DI void other_phase(int mk_tid, LAS unsigned char* lds, const Args& a, int l, int sub) {
    unsigned char* ws = a.ws;
    u16* A0 = (u16*)ws; u16* A1 = (u16*)(ws + U); u16* A2 = (u16*)(ws + 2 * U); u16* A3 = (u16*)(ws + 3 * U); u16* A4 = (u16*)(ws + 4 * U); u16* A5 = (u16*)(ws + 5 * U); u16* A6 = (u16*)(ws + 6 * U);
    u16* WT = (u16*)(ws + WS_WT); u16* KMEM = A3; u16* VTM = A3 + 2097152;
    float* IFG = (float*)(ws + WS_IFG); float* GZ = (float*)(ws + WS_GZ); float* GM = (float*)(ws + WS_GM); float* GE = (float*)(ws + WS_GE); float* GMS = (float*)(ws + WS_GMS); float* GML = (float*)(ws + WS_GML); float* NVEC = (float*)(ws + WS_NVEC);
    float* SS = (float*)(ws + WS_SS);
    const int tid = mk_tid, wid = tid >> 6;
    const size_t MW = (size_t)1024 * 1024;
    switch (sub) {
    case S_GQK: {
        ifg_rows(mk_tid, lds, A0, SS + (size_t)(l * 3) * T, a.in[3] + (size_t)l * 1024 * 8200, a.in[2] + l * 1024, a.in[13] + l * 8, IFG);
        Gemm g; g.A = A0; g.Bt = WT; g.M = T; g.N = 2048; g.K = 1024;
        UE6 e6; e6.perm = 0; e6.qc = A6; e6.kc = A5; e6.HB = (float*)(ws + WS_HBQ); e6.cw = a.in[11] + l * 8192; e6.cb = a.in[12] + l * 2048; e6.ss = SS + (size_t)(l * 3) * T;
        StaticOrder S; S.init(T, 2048, (int)gridDim.x, (int)blockIdx.x);
        for (int i = 0; ; ++i) { OneUnit O; if (!S.next(i, O.u)) break; __syncthreads(); gemm_phase<UE6, OneUnit, false>(mk_tid, lds, g, O, e6, nullptr); }
    } break;
    case S_STATE: mlstm_state_phase(mk_tid, lds, A5, A2, (float*)(ws + WS_GW), GMS, GML, A3, NVEC, IFG, GZ, GM, GE, (const float*)(ws + WS_HBQ), a.in[11] + l * 8192, a.in[12] + l * 2048); break;
    case S_OUT: mlstm_out_phase(mk_tid, lds, A6, A5, A2, A3, NVEC, A1, GZ, GM, GE, GMS, a.in[14] + l * 1024, 0, (const float*)(ws + WS_HBQ), a.in[11] + l * 8192, a.in[12] + l * 2048); break;
    case S_RG0: case S_RG1:
        if (sub == S_RG0) { cvt_set(mk_tid, lds, a, l, 1); __syncthreads(); }
        rglru_phase(mk_tid, lds, A1, A2, a.in[4] + l * 4096, a.in[5] + l * 1024, a.in[6] + l * 65536, a.in[7] + l * 1024, a.in[8] + l * 65536, a.in[9] + l * 1024, a.in[10] + l * 1024, A5, sub - S_RG0, (float*)(ws + WS_SUMA), (float*)(ws + WS_SUMH)); break;
    case S_GQKV: {
        Gemm g; g.A = A1; g.Bt = WT; g.M = T; g.N = 1024; g.K = 1024;
        UE eq = ue_bf16(A0, 1024, 0); eq.ss = SS + (size_t)(l * 3 + 1) * T; eq.smode = 1;
        StaticOrder S; S.init(T, 1024, (int)gridDim.x, (int)blockIdx.x);
        for (int i = 0; ; ++i) { OneUnit O; if (!S.next(i, O.u)) break; __syncthreads();
            gemm_phase<UE, OneUnit, false>(mk_tid, lds, g, O, eq, nullptr);
            asm volatile("s_waitcnt vmcnt(0)" ::: "memory"); __syncthreads();
            int t2 = mk_tid; asm volatile("" : "+v"(t2));
            xattn_pair(t2, lds, A0, KMEM, VTM, A2, O.u.pm >> 3, O.u.pn, (O.u.pm & 7) * 2); }
    } break;
    case S_GUP: {
        Gemm g; g.A = A0; g.Bt = WT + 4 * MW; g.M = T; g.N = 6144; g.K = 1024;
        UE5 e5; e5.perm = 0; e5.act = A4; e5.HB = (float*)A1; e5.cw = a.in[24] + l * 18432; e5.cb = a.in[25] + l * 6144; e5.ss = SS + (size_t)(l * 3 + 2) * T;
        StaticOrder S; S.init(T, 6144, (int)gridDim.x, (int)blockIdx.x);
        for (int i = 0; ; ++i) { OneUnit O; if (!S.next(i, O.u)) break; __syncthreads(); gemm_phase<UE5, OneUnit, false>(mk_tid, lds, g, O, e5, nullptr); }
    } break;
    case S_GDOWN: {
        if (l == 0) cvt_set(mk_tid, lds, a, 1, 0);
        StaticOrder S; S.init(T, 1024, (int)gridDim.x, (int)blockIdx.x);
        for (int i = 0; ; ++i) { Unit u; if (!S.next(i, u)) break; ffn_fix_tile(mk_tid, (const float*)A1, a.in[24] + l * 18432, a.in[25] + l * 6144, A4, u.pm); }
        asm volatile("s_waitcnt vmcnt(0)" ::: "memory"); __syncthreads();
        resid_gemm(mk_tid, lds, a, l, 2, A4, WT + 11 * MW, 3072, (const float*)A0, A0, (l == 0) ? (u16*)a.out : nullptr, 1);
    } break;
    case S_GMIX: {
        resid_gemm(mk_tid, lds, a, l, 0, A0, WT + 10 * MW, 1024, (l == 0) ? a.in[0] : a.out, A1, nullptr, (l == 0) ? 0 : 1);
        const int G = (int)gridDim.x, blk = (int)blockIdx.x; int vb = blk, VG = G;
        if (G >= 96) { VG = G - 64; vb = (blk < 32 || (blk >= G - 64 && blk < G - 32)) ? -1 : (blk < G - 64 ? blk - 32 : blk - 64); }
        __syncthreads(); cvt_set(mk_tid, lds, a, l, 2, vb, VG);
        __syncthreads(); cvt_set(mk_tid, lds, a, l, 3, vb, VG);
    } break;
    case S_GWO: resid_gemm(mk_tid, lds, a, l, 1, A2, WT + 3 * MW, 1024, (const float*)A1, A0, nullptr, 1); break;
    default: break;
    }
}

__global__ void __launch_bounds__(512, 2) mk_fwd(Args a) {
    extern __shared__ __attribute__((aligned(16))) unsigned char shm[];
    LAS unsigned char* lds = (LAS unsigned char*)shm;
    cg::grid_group grid = cg::this_grid();
    if (a.ph_hi < 0) grid.sync();
    volatile LAS unsigned* xst = (volatile LAS unsigned*)(lds + LDS_BYTES - 16);
    if (threadIdx.x == 0) { xst[0] = 0u; xst[1] = 0u; }
    __syncthreads();
    const XcdBarrier xbar = xcd_barrier_post((unsigned*)(a.ws + WS_BAR), xst);
    int tid0 = threadIdx.x;
    for (int ph = a.ph_lo; ph < a.ph_hi; ++ph) {
        if (ph > a.ph_lo) xcd_barrier(xbar);
        asm volatile("" : "+v"(tid0)); const int mk_tid = tid0;
        if (ph == 0) { init_phase(mk_tid, lds, a); continue; }
        if (ph == NPH - 1) { final_norm(mk_tid, (const u16*)a.ws, a.out, a.in[28]); continue; }
        const int l = (ph - 1) / PL, sub = (ph - 1) % PL;
        const int ng = gemm_count(sub);
        other_phase(mk_tid, lds, a, l, sub);
#if PROBE_DUP
        { const int bit = (sub == S_GQK || sub == S_GUP) ? 2 : (sub == S_STATE) ? 4 : (sub == S_RG0 || sub == S_RG1) ? 8 : (0) ? 16 : (sub == S_GDOWN) ? 32 : 0;
          if (PROBE_DUP & bit) { __syncthreads(); other_phase(mk_tid, lds, a, l, sub); } }
        if (PROBE_DUP & 128) xcd_barrier(xbar);
        if (PROBE_DUP & 1) for (int i = 0; i < ng; ++i) {
            GD d = get_gd(a, l, sub, i); d.e.kind = 4;
            __syncthreads();
            Gemm g; g.A = d.A; g.Bt = d.Bt; g.M = d.M; g.N = d.N; g.K = d.K;
            StaticOrder S; S.init(d.M, d.N, (int)gridDim.x, (int)((blockIdx.x + d.cshift) % gridDim.x));
            gemm_phase<UE, StaticOrder, false>(mk_tid, lds, g, S, d.e, nullptr);
        }
#endif
        for (int i = 0; i < ng; ++i) {
            GD d = get_gd(a, l, sub, i);
            __syncthreads();
            Gemm g; g.A = d.A; g.Bt = d.Bt; g.M = d.M; g.N = d.N; g.K = d.K;
            StaticOrder S; S.init(d.M, d.N, (int)gridDim.x, (int)((blockIdx.x + d.cshift) % gridDim.x));
            gemm_phase<UE, StaticOrder, false>(mk_tid, lds, g, S, d.e, nullptr);
        }
    }
}

extern "C" void kernel_launch(void* const* d_in, const int* in_sizes, int n_in, void* d_out, int out_size, void* d_ws, size_t ws_size, hipStream_t stream) {
    static int grid = 0;
    if (grid == 0) {
        if (n_in != 29 || out_size != T * 1024 || ws_size < WS_END) { fprintf(stderr, "kernel_launch: unexpected shapes (n_in %d out %d ws %zu need %zu)\n", n_in, out_size, ws_size, (size_t)WS_END); grid = -1; return; }
        int dev = 0, cus = 0, per_cu = 0;
        hipGetDevice(&dev); hipDeviceGetAttribute(&cus, hipDeviceAttributeMultiprocessorCount, dev);
        hipFuncSetAttribute((const void*)mk_fwd, hipFuncAttributeMaxDynamicSharedMemorySize, LDS_BYTES);
        hipOccupancyMaxActiveBlocksPerMultiprocessor(&per_cu, (const void*)mk_fwd, 512, LDS_BYTES);
        if (per_cu < 1) per_cu = 1;
        grid = cus * per_cu;
        (void)hipGetLastError();
    }
    if (grid < 0) return;
    Args a{};
    for (int i = 0; i < 29; ++i) a.in[i] = (const float*)d_in[i];
    a.out = (float*)d_out; a.ws = (unsigned char*)d_ws;
#if defined(MK_PER_PHASE)
    for (int ph = 0; ph < NPH; ++ph) { a.ph_lo = ph; a.ph_hi = ph + 1; hipLaunchKernelGGL(mk_fwd, dim3(grid), dim3(512), LDS_BYTES, stream, a); }
#else
    a.ph_lo = 0; a.ph_hi = NPH;
    (void)hipMemsetAsync((unsigned char*)d_ws + WS_BAR, 0, 16384, stream);
    void* args[] = {&a};
    hipError_t e = hipLaunchCooperativeKernel((void*)mk_fwd, dim3(grid), dim3(512), args, LDS_BYTES, stream);
    if (e != hipSuccess) fprintf(stderr, "cooperative launch failed: %s (grid %d)\n", hipGetErrorString(e), grid);
#endif
}
```
